# Optimizing an MI355X kernel written in HIP

```python
import math
import jax, jax.numpy as jnp
from jax import lax
import numpy as np

D_MODEL = 1024
BATCH = 8
SEQ = 2048
DEPTH = 2

EPS = 1e-6
HEAD_DIM = 64
BRANCH_W = 512
N_BRANCH = 4
HG_HEADS = 8
HG_DK = 64
HG_DV = 64
HG_CHUNK = 64
MLA_HEADS = 8
MLA_Q_RANK = 256
MLA_KV_RANK = 128
MLA_NOPE = 64
MLA_ROPE = 32
MLA_V = 64
ROPE_BASE = 10000.0
MAX_POS_OFFSET = 4096
DIFF_HEADS = 4
DIFF_QK = 64
DIFF_V = 128
SWA_Q_HEADS = 8
SWA_KV_HEADS = 2
SWA_WINDOW = 128
Q_BLOCK = 128
N_EXPERTS = 16
N_GROUPS = 4
TOP_K = 2
D_FF_EXPERT = 256

IN_SPLITS = (
    HG_HEADS * HG_DK, HG_HEADS * HG_DK, HG_HEADS * HG_DV, HG_HEADS * HG_DV,
    MLA_Q_RANK, MLA_KV_RANK, MLA_ROPE,
    DIFF_HEADS * 2 * DIFF_QK, DIFF_HEADS * 2 * DIFF_QK, DIFF_HEADS * DIFF_V,
    SWA_Q_HEADS * HEAD_DIM, SWA_KV_HEADS * HEAD_DIM, SWA_KV_HEADS * HEAD_DIM,
    N_BRANCH * D_MODEL,
)
N_IN = sum(IN_SPLITS)
SPLIT_POINTS = tuple(sum(IN_SPLITS[:i + 1]) for i in range(len(IN_SPLITS) - 1))

kernel_name = 'hybrid_gated_hgrn2_mla_diff_swa_moe'


def rmsnorm(x, gain):
    xf = x.astype(jnp.float32)
    xf = xf * lax.rsqrt(jnp.mean(xf * xf, axis=-1, keepdims=True) + EPS)
    return xf.astype(x.dtype) * gain


def modulate(h, shift, scale):
    return h * (1 + scale[:, None, :]) + shift[:, None, :]


def apply_rope(x, cos, sin):
    half = x.shape[-1] // 2
    x1, x2 = x[..., :half], x[..., half:]
    return jnp.concatenate([x1 * cos - x2 * sin, x1 * sin + x2 * cos], axis=-1)


def causal_probs(q_blk, k, q_start, scale):
    s = jnp.einsum('bqhd,bkhd->bhqk', q_blk, k).astype(jnp.float32) * scale
    q_pos = q_start + jnp.arange(q_blk.shape[1])
    k_pos = jnp.arange(k.shape[1])
    s = jnp.where(k_pos[None, :] <= q_pos[:, None], s, -jnp.inf)
    return jax.nn.softmax(s, axis=-1)


def sweep_query_blocks(body, q):
    B, S = q.shape[:2]
    nb = S // Q_BLOCK
    qb = jnp.moveaxis(q.reshape((B, nb, Q_BLOCK) + q.shape[2:]), 1, 0)
    starts = jnp.arange(nb, dtype=jnp.int32) * Q_BLOCK
    out = lax.map(lambda a: body(a[0], a[1]), (qb, starts))
    out = jnp.moveaxis(out, 0, 1)
    return out.reshape((B, S) + out.shape[3:])


def hgrn2_mixer(q_raw, f_raw, i_raw, g_raw, lb, o_gain):
    B, S, _ = q_raw.shape
    nc = S // HG_CHUNK
    f32 = jnp.float32
    lbf = lb.astype(f32)
    logf = jnp.logaddexp(jnp.log(lbf), jnp.log1p(-lbf) + jax.nn.log_sigmoid(f_raw.astype(f32)))
    k = -jnp.expm1(logf)
    q = jax.nn.silu(q_raw.astype(f32))
    v = i_raw.astype(f32)

    def to_chunks(t, d):
        t = t.reshape(B, nc, HG_CHUNK, HG_HEADS, d)
        return jnp.transpose(t, (1, 0, 3, 2, 4))

    qc, kc, vc, lfc = to_chunks(q, HG_DK), to_chunks(k, HG_DK), to_chunks(v, HG_DV), to_chunks(logf, HG_DK)
    tri = jnp.tril(jnp.ones((HG_CHUNK, HG_CHUNK), dtype=bool))[None, None, :, :, None]

    def step(state, inp):
        qt, kt, vt, lf = inp
        b = jnp.cumsum(lf, axis=2)
        o_inter = jnp.einsum('bhck,bhkv->bhcv', qt * jnp.exp(b), state)
        diff = b[:, :, :, None, :] - b[:, :, None, :, :]
        decay = jnp.exp(jnp.where(tri, diff, -jnp.inf))
        attn = jnp.einsum('bhtk,bhtsk,bhsk->bhts', qt, decay, kt)
        o_intra = jnp.einsum('bhts,bhsv->bhtv', attn, vt)
        b_last = b[:, :, -1:, :]
        new_state = jnp.exp(b_last[:, :, 0, :])[..., None] * state + \
            jnp.einsum('bhck,bhcv->bhkv', kt * jnp.exp(b_last - b), vt)
        return new_state, o_inter + o_intra

    state0 = jnp.zeros((B, HG_HEADS, HG_DK, HG_DV), f32)
    _, o = lax.scan(step, state0, (qc, kc, vc, lfc))
    o = jnp.transpose(o, (1, 0, 3, 2, 4)).reshape(B, S, HG_HEADS, HG_DV)
    o = rmsnorm(o, o_gain).astype(g_raw.dtype).reshape(B, S, HG_HEADS * HG_DV)
    return o * jax.nn.silu(g_raw)


def mla_mixer(c_q, c_kv, k_rope, q_norm_g, kv_norm_g, w_uq, w_ukv, qk_g, cos, sin):
    B, S, _ = c_q.shape
    q = (rmsnorm(c_q, q_norm_g) @ w_uq).reshape(B, S, MLA_HEADS, MLA_NOPE + MLA_ROPE)
    kv = (rmsnorm(c_kv, kv_norm_g) @ w_ukv).reshape(B, S, MLA_HEADS, MLA_NOPE + MLA_V)
    k_nope, v = kv[..., :MLA_NOPE], kv[..., MLA_NOPE:]
    k = jnp.concatenate([k_nope, jnp.broadcast_to(k_rope[:, :, None, :], (B, S, MLA_HEADS, MLA_ROPE))], axis=-1)
    q = rmsnorm(q, qk_g[0])
    k = rmsnorm(k, qk_g[1])
    q = jnp.concatenate([q[..., :MLA_NOPE], apply_rope(q[..., MLA_NOPE:], cos, sin)], axis=-1)
    k = jnp.concatenate([k[..., :MLA_NOPE], apply_rope(k[..., MLA_NOPE:], cos, sin)], axis=-1)
    scale = (MLA_NOPE + MLA_ROPE) ** -0.5

    def body(q_blk, start):
        p = causal_probs(q_blk, k, start, scale)
        return jnp.einsum('bhqk,bkhd->bqhd', p.astype(v.dtype), v)

    o = sweep_query_blocks(body, q)
    return o.reshape(B, S, MLA_HEADS * MLA_V)


def diff_mixer(q, k, v, qk_g, lam_p, o_g, lam_init):
    B, S, _ = q.shape
    q = rmsnorm(q.reshape(B, S, DIFF_HEADS, 2, DIFF_QK), qk_g[0])
    k = rmsnorm(k.reshape(B, S, DIFF_HEADS, 2, DIFF_QK), qk_g[1])
    v = v.reshape(B, S, DIFF_HEADS, DIFF_V)
    k1, k2 = k[:, :, :, 0], k[:, :, :, 1]
    lp = lam_p.astype(jnp.float32)
    lam = jnp.exp(jnp.sum(lp[0] * lp[1])) - jnp.exp(jnp.sum(lp[2] * lp[3])) + lam_init
    scale = DIFF_QK ** -0.5

    def body(q_blk, start):
        p1 = causal_probs(q_blk[:, :, :, 0], k1, start, scale)
        p2 = causal_probs(q_blk[:, :, :, 1], k2, start, scale)
        return jnp.einsum('bhqk,bkhd->bqhd', (p1 - lam * p2).astype(v.dtype), v)

    o = sweep_query_blocks(body, q)
    o = rmsnorm(o, o_g) * (1.0 - lam_init)
    return o.reshape(B, S, DIFF_HEADS * DIFF_V)


def swa_mixer(q, k, v, qk_g, sinks):
    B, S, _ = q.shape
    G = SWA_Q_HEADS // SWA_KV_HEADS
    W = SWA_WINDOW
    nb = S // W
    q = rmsnorm(q.reshape(B, S, SWA_KV_HEADS, G, HEAD_DIM), qk_g[0])
    k = rmsnorm(k.reshape(B, S, SWA_KV_HEADS, HEAD_DIM), qk_g[1])
    v = v.reshape(B, S, SWA_KV_HEADS, HEAD_DIM)

    def band(t):
        tp = jnp.pad(t, ((0, 0), (W, 0), (0, 0), (0, 0)))
        tb = tp.reshape(B, nb + 1, W, SWA_KV_HEADS, HEAD_DIM)
        return jnp.concatenate([tb[:, :-1], tb[:, 1:]], axis=2)

    kw, vw = band(k), band(v)
    qb = q.reshape(B, nb, W, SWA_KV_HEADS, G, HEAD_DIM)
    s = jnp.einsum('bnqhgd,bnkhd->bnhgqk', qb, kw).astype(jnp.float32) * HEAD_DIM ** -0.5
    qi = jnp.arange(W)[:, None]
    kj = jnp.arange(2 * W)[None, :]
    delta = qi + W - kj
    blk = jnp.arange(nb)[:, None, None]
    valid = (delta >= 0) & (delta < W) & (blk * W + kj[None] - W >= 0)
    s = jnp.where(valid[None, :, None, None], s, -jnp.inf)
    sink = jnp.broadcast_to(sinks.astype(jnp.float32).reshape(1, 1, SWA_KV_HEADS, G, 1, 1), s.shape[:-1] + (1,))
    p = jax.nn.softmax(jnp.concatenate([s, sink], axis=-1), axis=-1)[..., :-1]
    o = jnp.einsum('bnhgqk,bnkhd->bnqhgd', p.astype(v.dtype), vw)
    return o.reshape(B, S, SWA_Q_HEADS * HEAD_DIM)


def moe(h, router_w, router_bias, w_gate, w_up, w_down):
    B, S, _ = h.shape
    f32 = jnp.float32
    per = N_EXPERTS // N_GROUPS
    scores = jax.nn.sigmoid(jnp.einsum('bsd,de->bse', h, router_w).astype(f32))
    sel = scores + router_bias.astype(f32)
    grp = lax.top_k(sel.reshape(B, S, N_GROUPS, per), TOP_K)[0].sum(-1)
    g_idx = jnp.argmax(grp, axis=-1)
    in_grp = (jnp.arange(N_EXPERTS) // per)[None, None, :] == g_idx[..., None]
    _, e_idx = lax.top_k(jnp.where(in_grp, sel, -jnp.inf), TOP_K)
    w = jnp.take_along_axis(scores, e_idx, axis=-1)
    w = w / jnp.sum(w, axis=-1, keepdims=True)
    combine = jnp.sum(jax.nn.one_hot(e_idx, N_EXPERTS, dtype=f32) * w[..., None], axis=-2)
    hid = jax.nn.silu(jnp.einsum('bsd,edf->bsef', h, w_gate)) * jnp.einsum('bsd,edf->bsef', h, w_up)
    return jnp.einsum('bsef,bse,efd->bsd', hid, combine.astype(h.dtype), w_down)


def setup_inputs(seed: int = 0) -> dict:
    key = jax.random.key(seed)
    ks = jax.random.split(key, 32)
    f32 = jnp.float32
    L, D = DEPTH, D_MODEL

    def nrm(k, shape, scale):
        return jax.random.normal(k, shape, f32) * scale

    def gain(k, shape):
        return 1.0 + 0.02 * jax.random.normal(k, shape, f32)

    offs = jax.random.randint(ks[2], (BATCH, 1), 0, MAX_POS_OFFSET, dtype=jnp.int32)
    return {
        'x': nrm(ks[0], (BATCH, SEQ, D), 1.0),
        'c': nrm(ks[1], (BATCH, D), 1.0),
        'positions': offs + jnp.arange(SEQ, dtype=jnp.int32)[None, :],
        'ada_w': nrm(ks[3], (L, D, 6 * D), 0.5 * D ** -0.5),
        'ada_b': nrm(ks[4], (L, 6 * D), 0.02),
        'norm_mix': gain(ks[5], (L, D)),
        'norm_ffn': gain(ks[6], (L, D)),
        'w_in': nrm(ks[7], (L, D, N_IN), D ** -0.5),
        'hg_lb_logits': nrm(ks[8], (L, HG_HEADS * HG_DK), 1.0),
        'hg_onorm': gain(ks[9], (L, HG_DV)),
        'mla_q_norm': gain(ks[10], (L, MLA_Q_RANK)),
        'mla_kv_norm': gain(ks[11], (L, MLA_KV_RANK)),
        'mla_w_uq': nrm(ks[12], (L, MLA_Q_RANK, MLA_HEADS * (MLA_NOPE + MLA_ROPE)), MLA_Q_RANK ** -0.5),
        'mla_w_ukv': nrm(ks[13], (L, MLA_KV_RANK, MLA_HEADS * (MLA_NOPE + MLA_V)), MLA_KV_RANK ** -0.5),
        'mla_qk_norm': gain(ks[14], (L, 2, MLA_NOPE + MLA_ROPE)),
        'diff_qk_norm': gain(ks[15], (L, 2, DIFF_QK)),
        'diff_lam': nrm(ks[16], (L, 4, DIFF_QK), 0.1),
        'diff_onorm': gain(ks[17], (L, DIFF_V)),
        'swa_qk_norm': gain(ks[18], (L, 2, HEAD_DIM)),
        'swa_sinks': nrm(ks[19], (L, SWA_Q_HEADS), 1.0),
        'w_branch': nrm(ks[20], (L, N_BRANCH, BRANCH_W, D), BRANCH_W ** -0.5),
        'w_out': nrm(ks[21], (L, D, D), D ** -0.5),
        'router_w': nrm(ks[22], (D, N_EXPERTS), D ** -0.5),
        'router_bias': nrm(ks[23], (N_EXPERTS,), 0.01),
        'moe_w_gate': nrm(ks[24], (L, N_EXPERTS, D, D_FF_EXPERT), D ** -0.5),
        'moe_w_up': nrm(ks[25], (L, N_EXPERTS, D, D_FF_EXPERT), D ** -0.5),
        'moe_w_down': nrm(ks[26], (L, N_EXPERTS, D_FF_EXPERT, D), D_FF_EXPERT ** -0.5),
    }


def reference(x, c, positions, ada_w, ada_b, norm_mix, norm_ffn, w_in, hg_lb_logits, hg_onorm,
              mla_q_norm, mla_kv_norm, mla_w_uq, mla_w_ukv, mla_qk_norm, diff_qk_norm, diff_lam,
              diff_onorm, swa_qk_norm, swa_sinks, w_branch, w_out, router_w, router_bias,
              moe_w_gate, moe_w_up, moe_w_down):
    B, S, D = x.shape
    f32 = jnp.float32
    inv_freq = ROPE_BASE ** (-jnp.arange(0, MLA_ROPE, 2, dtype=f32) / MLA_ROPE)
    ang = positions.astype(f32)[..., None] * inv_freq
    cos = jnp.cos(ang)[:, :, None, :].astype(x.dtype)
    sin = jnp.sin(ang)[:, :, None, :].astype(x.dtype)
    lb_all = jnp.cumsum(jax.nn.softmax(hg_lb_logits.astype(f32), axis=0), axis=0)
    lb_all = lb_all - lb_all[0]
    c_act = jax.nn.silu(c)

    for l in range(DEPTH):
        mod = c_act @ ada_w[l] + ada_b[l]
        sh1, sc1, gt1, sh2, sc2, gt2 = jnp.split(mod, 6, axis=-1)
        h = modulate(rmsnorm(x, norm_mix[l]), sh1, sc1)
        proj = h @ w_in[l]
        (hq, hf, hi, hg, mcq, mckv, mkr, dq, dk, dv, sq, sk, sv, gates) = jnp.split(proj, SPLIT_POINTS, axis=-1)
        y_a = hgrn2_mixer(hq, hf, hi, hg, lb_all[l], hg_onorm[l])
        y_b = mla_mixer(mcq, mckv, mkr, mla_q_norm[l], mla_kv_norm[l], mla_w_uq[l], mla_w_ukv[l],
                        mla_qk_norm[l], cos, sin)
        lam_init = 0.8 - 0.6 * math.exp(-0.3 * l)
        y_c = diff_mixer(dq, dk, dv, diff_qk_norm[l], diff_lam[l], diff_onorm[l], lam_init)
        y_d = swa_mixer(sq, sk, sv, swa_qk_norm[l], swa_sinks[l])
        ys = jnp.stack([y_a, y_b, y_c, y_d], axis=2)
        branch = jnp.einsum('bsnw,nwd->bsnd', ys, w_branch[l])
        gate = jax.nn.sigmoid(gates.reshape(B, S, N_BRANCH, D))
        merged = jnp.sum(gate * branch, axis=2)
        x = x + gt1[:, None, :] * (merged @ w_out[l])
        h2 = modulate(rmsnorm(x, norm_ffn[l]), sh2, sc2)
        x = x + gt2[:, None, :] * moe(h2, router_w, router_bias, moe_w_gate[l], moe_w_up[l], moe_w_down[l])
    return x
```

```cpp
#include <hip/hip_runtime.h>
#include <hip/hip_bf16.h>
#include <cstdio>
#include <cstdint>

#ifndef MK_PER_PHASE
#define MK_PER_PHASE 0
#endif

#ifndef PHASE_MASK
#define PHASE_MASK 0x3ff
#endif
#define PH_ON(k) ((PHASE_MASK >> (k)) & 1)
#ifndef UNIT_MASK
#define UNIT_MASK 15
#endif
#define UNIT_ON(k) ((UNIT_MASK >> (k)) & 1)
#define LAS __attribute__((address_space(3)))
#define GAS __attribute__((address_space(1)))
typedef unsigned short bf16_t;
typedef short bf16x8 __attribute__((ext_vector_type(8)));
typedef short s16x4 __attribute__((ext_vector_type(4)));
typedef float f32x4 __attribute__((ext_vector_type(4)));
typedef float f32x16 __attribute__((ext_vector_type(16)));
typedef unsigned u32x4 __attribute__((ext_vector_type(4)));
typedef unsigned u32x2 __attribute__((ext_vector_type(2)));
typedef GAS unsigned gu32;

constexpr int NB = 8, SEQ = 2048, DM = 1024, M = NB * SEQ, DEPTH = 2;
constexpr int NPROJ = 4864;
constexpr int NGATE = 4096;
constexpr int NBIG = NGATE + NPROJ;
constexpr int W_IN_COLS = 8864;
constexpr int PC_HQ = 0, PC_HF = 512, PC_HI = 1024, PC_HG = 1536, PC_CQ = 2048, PC_CKV = 2304, PC_KR = 2432,
              PC_DQ = 2464, PC_DK = 2976, PC_DV = 3488, PC_SQ = 4000, PC_SK = 4512, PC_SV = 4640;
constexpr float EPS = 1e-6f;
constexpr float LOG2E = 1.4426950408889634f;

constexpr size_t MiB = 1u << 20;
constexpr size_t WS_CTL = 0, CTL_ZERO_BYTES = 1 * MiB;
constexpr size_t WS_MOD = 1 * MiB;
constexpr size_t WS_ROPE = 2 * MiB;
constexpr size_t WS_LIST = 4 * MiB;
constexpr size_t WS_TOKW = 6 * MiB;
constexpr size_t WS_UQT = 8 * MiB;
constexpr size_t WS_UKVT = 8 * MiB + 512 * 1024;
constexpr size_t WS_BRT = 9 * MiB;
constexpr size_t WS_OUTT = 13 * MiB;
constexpr size_t WS_PROJ = 16 * MiB;
constexpr size_t WS_GUT = 16 * MiB;
constexpr size_t WS_DT = 32 * MiB;
constexpr size_t WS_HID = 40 * MiB;
constexpr size_t WS_GATE8 = 168 * MiB;
constexpr size_t WS_X = 232 * MiB;
constexpr size_t WS_H = WS_X;
constexpr size_t WS_WINT = WS_X + 32 * MiB;
constexpr size_t WS_MLAQ = WS_X;
constexpr size_t WS_MLAK = WS_X + 24 * MiB;
constexpr size_t WS_MLAV = WS_X + 48 * MiB;
constexpr size_t WS_MERGED = WS_X + 24 * MiB;
constexpr size_t WS_END = 296 * MiB;
constexpr int HID_ROWS = 22528;

constexpr int CW_BAR = 4096;
constexpr int CW_QUEUE = 8192;
constexpr int CW_CNT = 8448;
constexpr int NPHASE = 1 + 9 * DEPTH;

constexpr int RING_BYTES = 131072;
constexpr int MISC_OFF = RING_BYTES;
constexpr int LDS_BYTES = 147456;

#define LDS_WAIT() asm volatile("s_waitcnt lgkmcnt(0)" ::: "memory")
#define VM_WAIT() asm volatile("s_waitcnt vmcnt(0)" ::: "memory")
#define RLX_AGENT __ATOMIC_RELAXED, __HIP_MEMORY_SCOPE_AGENT
__device__ __forceinline__ unsigned f2bf(float f) { unsigned u = __builtin_bit_cast(unsigned, f); return (u + 0x7fffu + ((u >> 16) & 1u)) >> 16; }
__device__ __forceinline__ unsigned pk2(float lo, float hi) { return f2bf(lo) | (f2bf(hi) << 16); }
__device__ __forceinline__ float bf2f(unsigned short b) { return __builtin_bit_cast(float, (unsigned)b << 16); }
__device__ __forceinline__ float bflo(unsigned w) { return __builtin_bit_cast(float, w << 16); }
__device__ __forceinline__ float bfhi(unsigned w) { return __builtin_bit_cast(float, w & 0xffff0000u); }
__device__ __forceinline__ float fsigmoid(float x) { return 1.0f / (1.0f + __expf(-x)); }
__device__ __forceinline__ float fsilu(float x) { return x / (1.0f + __expf(-x)); }
__device__ __forceinline__ int crow(int r, int hi) { return (r & 3) + 8 * (r >> 2) + 4 * hi; }
__device__ __forceinline__ float shx(float v, int m, int lane) { return __builtin_bit_cast(float, __builtin_amdgcn_ds_bpermute((lane ^ m) << 2, __builtin_bit_cast(int, v))); }
__device__ __forceinline__ float wave_sum(float v, int lane) {
#pragma unroll
    for (int o = 1; o < 64; o <<= 1) v += shx(v, o, lane);
    return v;
}

#define XB_TMO      128
#define XB_XCNT(j)  (256  + 64 * (j))
#define XB_XSUB(j)  (1280 + 64 * (j))
#define XB_XGEN(j)  (2304 + 64 * (j))
#define XB_TOP      3328
#define XB_TOPGEN   3392
#define XCD_BAR_WORDS 3456
#define XB_SPIN_CAP (1u << 22)
__device__ __forceinline__ unsigned xb_ld(unsigned* p)              { return __hip_atomic_load(p, __ATOMIC_RELAXED, __HIP_MEMORY_SCOPE_AGENT); }
__device__ __forceinline__ unsigned xb_add(unsigned* p, unsigned v) { return __hip_atomic_fetch_add(p, v, __ATOMIC_RELAXED, __HIP_MEMORY_SCOPE_AGENT); }
__device__ __forceinline__ unsigned xb_xcc_id() { return (unsigned)__builtin_amdgcn_s_getreg((3 << 11) | 20) & 0xFu; }
#define XB_SPIN(cond, bar) do { unsigned _sp = 0; while (cond) { __builtin_amdgcn_s_sleep(1); \
    if ((++_sp & 255u) == 0u) { if (xb_ld(&(bar)[XB_TMO])) break; if (_sp > XB_SPIN_CAP) { atomicAdd(&(bar)[XB_TMO], 1u); break; } } } } while (0)
struct XcdBarrier { unsigned* bar; unsigned x; volatile LAS unsigned* st; };
__device__ __forceinline__ XcdBarrier xcd_barrier_post(unsigned* bar, volatile LAS unsigned* st) {
    XcdBarrier b; b.bar = bar; b.x = xb_xcc_id(); b.st = st;
    if (threadIdx.x == 0) (void)xb_add(&bar[XB_XCNT(b.x)], 1u);
    return b;
}
__device__ __forceinline__ void xcd_barrier_complete(unsigned* bar, unsigned x, unsigned& nloc, unsigned& nx) {
    const unsigned G = gridDim.x * gridDim.y * gridDim.z;
    unsigned sum, cnt, mine, sp = 0u;
    for (;;) {
        sum = 0u; cnt = 0u; mine = 0u;
#pragma unroll
        for (unsigned j = 0; j < 16; ++j) { const unsigned c = xb_ld(&bar[XB_XCNT(j)]); sum += c; cnt += (c > 0u) ? 1u : 0u; mine = (j == x) ? c : mine; }
        if (sum == G) break;
        __builtin_amdgcn_s_sleep(1);
        if ((++sp & 255u) == 0u) { if (xb_ld(&bar[XB_TMO])) break; if (sp > XB_SPIN_CAP) { atomicAdd(&bar[XB_TMO], 1u); break; } }
    }
    nloc = mine > 0u ? mine : 1u; nx = cnt > 0u ? cnt : 1u;
}
__device__ __forceinline__ void xcd_barrier(const XcdBarrier& b) {
    asm volatile("s_waitcnt vmcnt(0)" ::: "memory");
    __syncthreads();
    if (threadIdx.x == 0) {
        unsigned* bar = b.bar;
        __builtin_amdgcn_s_waitcnt(0);
        unsigned nloc = b.st[0], nx = b.st[1];
        if (nloc == 0u) { xcd_barrier_complete(bar, b.x, nloc, nx); b.st[0] = nloc; b.st[1] = nx; }
        const unsigned old = xb_add(&bar[XB_XSUB(b.x)], 1u);
        const unsigned gen = old / nloc;
        if (old + 1u == (gen + 1u) * nloc) {
            __builtin_amdgcn_fence(__ATOMIC_RELEASE, "agent");
            asm volatile("s_waitcnt vmcnt(0)" ::: "memory");
            const unsigned og = xb_add(&bar[XB_TOP], 1u);
            const unsigned tg = og / nx;
            if (og + 1u == (tg + 1u) * nx) xb_add(&bar[XB_TOPGEN], 1u);
            else XB_SPIN(xb_ld(&bar[XB_TOPGEN]) == tg, bar);
            __builtin_amdgcn_fence(__ATOMIC_ACQUIRE, "agent");
            xb_add(&bar[XB_XGEN(b.x)], 1u);
            asm volatile("s_waitcnt vmcnt(0)" ::: "memory");
        } else {
            XB_SPIN(xb_ld(&bar[XB_XGEN(b.x)]) == gen, bar);
            __builtin_amdgcn_fence(__ATOMIC_ACQUIRE, "agent");
            asm volatile("s_waitcnt vmcnt(0)" ::: "memory");
        }
    }
    __syncthreads();
}

namespace pg8 {
constexpr int BM = 256, BK = 64, HALF = 128, HTB = HALF * BK * 2, NXCD = 8, WGM = 8;
__host__ __device__ __forceinline__ int lds_byte(int r, int c) { const int st = (r >> 4) * 2 + (c >> 5), rr = r & 15, cc = c & 31, ob = rr * 64 + cc * 2; return st * 1024 + (ob ^ (((ob >> 9) & 1) << 5)); }
__host__ __device__ __forceinline__ void stage_rc(int b, int& R, int& C) { const int st = b / 1024, sb = b % 1024, swz = sb ^ (((sb >> 9) & 1) << 5); R = (st >> 1) * 16 + swz / 64; C = (st & 1) * 32 + (swz % 64) / 2; }
__host__ __device__ __forceinline__ int perm32(int rho) { const int n = rho >> 4, i = rho & 15; return 8 * (i >> 2) + 4 * n + (i & 3); }

struct Unit {
    int pm, pn, aux;
    const char* a;
    const char* b0; const char* b1;
    const int* ridx;
    int nvalid;
};
__device__ __forceinline__ void tile_order(int wgid, int nM, int nN, int& pm, int& pn) {
    const int nwg = nM * nN;
    { const int q = nwg / NXCD, r = nwg % NXCD, xcd = wgid % NXCD, off = wgid / NXCD; wgid = (xcd < r ? xcd * (q + 1) : r * (q + 1) + (xcd - r) * q) + off; }
    const int nig = WGM * nN, gid = wgid / nig, fm = gid * WGM, gsz = (nM - fm) < WGM ? (nM - fm) : WGM;
    pm = fm + ((wgid % nig) % gsz); pn = (wgid % nig) / gsz;
}
__device__ __forceinline__ unsigned cvt_pk_bf16(float lo, float hi) { unsigned r; asm volatile("v_cvt_pk_bf16_f32 %0, %1, %2" : "=v"(r) : "v"(lo), "v"(hi)); return r; }

template <bool GATHER, class Epi, class Sched>
__device__ __forceinline__ void gemm_phase(LAS unsigned char* lds, const int nt, const int ldb  , const Sched& S, const Epi& E) {
    int tid = threadIdx.x; asm volatile("" : "+v"(tid));
    const int wid = __builtin_amdgcn_readfirstlane(tid >> 6), lane = tid & 63, wr = wid >> 2, wc = wid & 3, fr = lane & 15, fq = lane >> 4;
    unsigned voffB[2];
#pragma unroll
    for (int i = 0; i < 2; ++i) { int R, C; stage_rc(tid * 16 + i * 8192, R, C); const int Rb = Epi::PERM ? ((R & ~31) + perm32(R & 31)) : R;
        voffB[i] = (unsigned)(Rb * ldb + C * 2); }
    const size_t hstepB = (size_t)HALF * ldb;
    const unsigned ldsw = (unsigned)wid * 1024u;
    const int aoff = lds_byte(wr * 64 + fr, fq * 8), boff = lds_byte(wc * 32 + fr, fq * 8);
#define PG8_SA(b, h) (((b) * 2 + (h)) * HTB)
#define PG8_SB(b, h) ((4 + (b) * 2 + (h)) * HTB)
#define PG8_GLDS(bufoff, gptr, i_) __builtin_amdgcn_global_load_lds((const unsigned*)(gptr), (LAS unsigned*)(lds + (bufoff) + ldsw + (i_) * 8192), 16, 0, 0)
#define PG8_STAGE_B(bufoff, gbase) do { PG8_GLDS(bufoff, (const char*)(gbase) + voffB[0], 0); PG8_GLDS(bufoff, (const char*)(gbase) + voffB[1], 1); } while (0)
#define PG8_STAGE_A(bufoff, gbase, v0, v1) do { PG8_GLDS(bufoff, (const char*)(gbase) + (v0), 0); PG8_GLDS(bufoff, (const char*)(gbase) + (v1), 1); } while (0)
#define PG8_LDA(dst, b, h) do { _Pragma("unroll") for (int m = 0; m < 4; ++m) _Pragma("unroll") for (int k = 0; k < 2; ++k) dst[m][k] = *(const LAS bf16x8*)(lds + PG8_SA(b, h) + aoff + m * 2048 + k * 1024); } while (0)
#define PG8_LDB(dst, b, h) do { _Pragma("unroll") for (int n = 0; n < 2; ++n) _Pragma("unroll") for (int k = 0; k < 2; ++k) dst[n][k] = *(const LAS bf16x8*)(lds + PG8_SB(b, h) + boff + n * 2048 + k * 1024); } while (0)
#define PG8_MMA(ai, bj, At, Bt) do { __builtin_amdgcn_s_setprio(1); _Pragma("unroll") for (int m = 0; m < 4; ++m) _Pragma("unroll") for (int n = 0; n < 2; ++n) _Pragma("unroll") for (int k = 0; k < 2; ++k) \
        acc[ai][bj][m][n] = __builtin_amdgcn_mfma_f32_16x16x32_bf16(Bt[n][k], At[m][k], acc[ai][bj][m][n], 0, 0, 0); __builtin_amdgcn_s_setprio(0); } while (0)
#define PG8_WAIT_V(n) asm volatile("s_waitcnt vmcnt(" #n ")" ::: "memory")
#define PG8_WAIT_L(n) asm volatile("s_waitcnt lgkmcnt(" #n ")" ::: "memory")
#define PG8_BAR __builtin_amdgcn_s_barrier()
#define PG8_SCHED __builtin_amdgcn_sched_barrier(0)
    Unit cur, nxt; int ui = 0;
    if (!S.next(0, cur)) return;
    constexpr int NH = GATHER ? 2 : 1;
    unsigned vA[2][NH], vN[2][NH];
#define PG8_VOFF2(u, v) do { int t3_ = threadIdx.x; asm volatile("" : "+v"(t3_)); _Pragma("unroll") for (int i_ = 0; i_ < 2; ++i_) { int R_, C_; stage_rc(t3_ * 16 + i_ * 8192, R_, C_); \
        _Pragma("unroll") for (int h_ = 0; h_ < NH; ++h_) { const int r_ = R_ + HALF * h_; \
        if (GATHER) { const int rr_ = (r_ < (u).nvalid) ? (u).ridx[r_] : 0; v[i_][h_] = (unsigned)(rr_ * S.lda(u) + C_ * 2); } \
        else v[i_][h_] = (unsigned)(R_ * S.lda(u) + C_ * 2); } } } while (0)
#define PG8_HS(u) (GATHER ? (size_t)0 : (size_t)HALF * (size_t)S.lda(u))
    PG8_VOFF2(cur, vA);
    f32x4 acc[2][2][4][2];
#pragma unroll
    for (int a = 0; a < 2; ++a)
#pragma unroll
        for (int b = 0; b < 2; ++b)
#pragma unroll
            for (int m = 0; m < 4; ++m)
#pragma unroll
                for (int n = 0; n < 2; ++n) acc[a][b][m][n] = (f32x4){0.f, 0.f, 0.f, 0.f};
    bf16x8 At[4][2], B0[2][2], B1[2][2];
    PG8_STAGE_B(PG8_SB(0, 0), cur.b0); PG8_STAGE_B(PG8_SB(0, 1), cur.b0 + hstepB); PG8_STAGE_A(PG8_SA(0, 0), cur.a, vA[0][0], vA[1][0]); PG8_STAGE_A(PG8_SA(0, 1), cur.a + PG8_HS(cur), vA[0][NH - 1], vA[1][NH - 1]);
    if (wr == 1) PG8_BAR;
    PG8_WAIT_V(2); PG8_BAR;
    PG8_STAGE_B(PG8_SB(1, 0), cur.b0 + BK * 2); PG8_STAGE_A(PG8_SA(1, 0), cur.a + S.akstep(cur), vA[0][0], vA[1][0]); PG8_STAGE_B(PG8_SB(1, 1), cur.b0 + hstepB + BK * 2);
    PG8_WAIT_V(6); PG8_BAR;
    for (;;) {
        const bool has_next = S.next(ui + 1, nxt);
        if (has_next) { PG8_VOFF2(nxt, vN); } else { _Pragma("unroll") for (int i_ = 0; i_ < 2; ++i_) _Pragma("unroll") for (int h_ = 0; h_ < NH; ++h_) vN[i_][h_] = vA[i_][h_]; nxt = cur; }
        for (int t = 0; t < nt; t += 2) {
            const bool last = (t == nt - 2);
            const char* a1 = cur.a + (size_t)(t + 1) * S.akstep(cur);
            const char* a2 = last ? nxt.a : cur.a + (size_t)(t + 2) * S.akstep(cur);
            const char* a3 = a2 + (last ? S.akstep(nxt) : S.akstep(cur));
            const size_t hs1 = PG8_HS(cur), hs2 = last ? PG8_HS(nxt) : PG8_HS(cur);
            const char* b2 = last ? nxt.b0 : S.btile(cur, t + 2);
            const char* b3 = b2 + BK * 2;
            const unsigned x00 = last ? vN[0][0] : vA[0][0], x10 = last ? vN[1][0] : vA[1][0], x01 = last ? vN[0][NH - 1] : vA[0][NH - 1], x11 = last ? vN[1][NH - 1] : vA[1][NH - 1];
            PG8_LDB(B0, 0, 0); PG8_LDB(B1, 0, 1); PG8_SCHED; PG8_LDA(At, 0, 0); PG8_STAGE_A(PG8_SA(1, 1), a1 + hs1, vA[0][NH - 1], vA[1][NH - 1]);
            PG8_WAIT_V(8); PG8_WAIT_L(0); PG8_BAR; PG8_MMA(0, 0, At, B0); PG8_MMA(0, 1, At, B1); PG8_BAR; PG8_SCHED;
            PG8_LDA(At, 0, 1); PG8_STAGE_B(PG8_SB(0, 0), b2); PG8_STAGE_B(PG8_SB(0, 1), b2 + hstepB); PG8_STAGE_A(PG8_SA(0, 0), a2, x00, x10);
            PG8_WAIT_V(8); PG8_WAIT_L(0); PG8_BAR; PG8_MMA(1, 0, At, B0); PG8_MMA(1, 1, At, B1); PG8_BAR; PG8_SCHED;
            PG8_LDB(B0, 1, 0); PG8_LDB(B1, 1, 1); PG8_SCHED; PG8_LDA(At, 1, 0); PG8_STAGE_A(PG8_SA(0, 1), a2 + hs2, x01, x11);
            PG8_WAIT_V(8); PG8_WAIT_L(0); PG8_BAR; PG8_MMA(0, 0, At, B0); PG8_MMA(0, 1, At, B1); PG8_BAR; PG8_SCHED;
            PG8_LDA(At, 1, 1); PG8_STAGE_B(PG8_SB(1, 0), b3); PG8_STAGE_B(PG8_SB(1, 1), b3 + hstepB); PG8_STAGE_A(PG8_SA(1, 0), a3, x00, x10);
            PG8_WAIT_V(8); PG8_WAIT_L(0); PG8_BAR; PG8_MMA(1, 0, At, B0); PG8_MMA(1, 1, At, B1); PG8_BAR; PG8_SCHED;
        }
        if (wr == 0) PG8_BAR;
        { int t2 = threadIdx.x; asm volatile("" : "+v"(t2)); const int l2 = t2 & 63; E(acc, cur, wr, wc, l2 & 15, l2 >> 4); }
        if (!has_next) break;
#pragma unroll
        for (int a = 0; a < 2; ++a)
#pragma unroll
            for (int b = 0; b < 2; ++b)
#pragma unroll
                for (int m = 0; m < 4; ++m)
#pragma unroll
                    for (int n = 0; n < 2; ++n) acc[a][b][m][n] = (f32x4){0.f, 0.f, 0.f, 0.f};
        cur = nxt; _Pragma("unroll") for (int i_ = 0; i_ < 2; ++i_) _Pragma("unroll") for (int h_ = 0; h_ < NH; ++h_) vA[i_][h_] = vN[i_][h_]; ++ui;
        if (wr == 1) PG8_BAR;
    }
    PG8_WAIT_V(0);
    PG8_BAR;
#undef PG8_SA
#undef PG8_SB
#undef PG8_GLDS
#undef PG8_STAGE_A
#undef PG8_STAGE_B
#undef PG8_LDA
#undef PG8_LDB
#undef PG8_MMA
#undef PG8_WAIT_V
#undef PG8_WAIT_L
#undef PG8_BAR
#undef PG8_SCHED
#undef PG8_VOFF2
#undef PG8_HS
}
}

struct Args {
    const float* x; const float* c; const int* pos; const float* ada_w; const float* ada_b; const float* norm_mix; const float* norm_ffn;
    const float* w_in; const float* hg_lb; const float* hg_onorm; const float* mla_q_norm; const float* mla_kv_norm; const float* mla_w_uq;
    const float* mla_w_ukv; const float* mla_qk_norm; const float* diff_qk_norm; const float* diff_lam; const float* diff_onorm;
    const float* swa_qk_norm; const float* swa_sinks; const float* w_branch; const float* w_out; const float* router_w; const float* router_bias;
    const float* moe_w_gate; const float* moe_w_up; const float* moe_w_down;
    float* out; unsigned char* ws; int ph_lo, ph_hi;
};
typedef const __attribute__((address_space(4))) Args* kargs_ptr;
__device__ __forceinline__ Args load_args() {
#if defined(__HIP_DEVICE_COMPILE__)
    kargs_ptr ap = (kargs_ptr)__builtin_amdgcn_kernarg_segment_ptr(); asm volatile("" : "+s"(ap)); Args r; __builtin_memcpy(&r, ap, sizeof(Args)); return r;
#else
    return Args{};
#endif
}
struct Frame {
    LAS unsigned char* lds; unsigned char* ldsg;
    volatile LAS unsigned* MISC; gu32* ctl;
    int tid, lane, wave, vcu, G;
};

__device__ __forceinline__ Frame fresh(const Frame& F0) {
    Frame F = F0; int t = threadIdx.x; asm volatile("" : "+v"(t)); F.tid = t; F.lane = t & 63; F.wave = __builtin_amdgcn_readfirstlane(t >> 6);
    unsigned lb = 0; asm volatile("" : "+s"(lb)); F.lds = (LAS unsigned char*)(F0.lds + lb); F.MISC = (volatile LAS unsigned*)(F.lds + MISC_OFF); return F;
}
__device__ __forceinline__ void conv_item(const float* W, int ld, int c0, int K, bf16_t* WT, int row0, LAS float* scr, int item, int nblk, int lane) {
    const int kb = item / nblk, nb = item % nblk, k0 = 64 * kb, n0 = 32 * nb;
#pragma unroll 8
    for (int i = 0; i < 32; ++i) { const int kk = 2 * i + (lane >> 5); scr[kk * 33 + (lane & 31)] = W[(size_t)(k0 + kk) * ld + c0 + n0 + (lane & 31)]; }
    LDS_WAIT(); asm volatile("" ::: "memory");
    const int c = lane & 7;
#pragma unroll
    for (int j = 0; j < 4; ++j) { const int n = (lane >> 3) + 8 * j; const LAS float* s = scr + (8 * c) * 33 + n;
        u32x4 o; o.x = pk2(s[0 * 33], s[1 * 33]); o.y = pk2(s[2 * 33], s[3 * 33]); o.z = pk2(s[4 * 33], s[5 * 33]); o.w = pk2(s[6 * 33], s[7 * 33]);
        *(GAS u32x4*)(WT + (size_t)(row0 + n0 + n) * K + k0 + 8 * c) = o; }
    LDS_WAIT(); asm volatile("" ::: "memory");
}
__device__ __forceinline__ void conv_layer_main(const Frame& F0, int l) {
    const Args A = load_args(); const Frame F = fresh(F0);
    LAS float* scr = (LAS float*)(F.lds + F.wave * 16384);
    const int gw = F.vcu * 8 + F.wave, NGW = F.G * 8;
    bf16_t* WINT = (bf16_t*)(A.ws + WS_WINT); bf16_t* UQT = (bf16_t*)(A.ws + WS_UQT); bf16_t* UKVT = (bf16_t*)(A.ws + WS_UKVT);
    bf16_t* BRT = (bf16_t*)(A.ws + WS_BRT); bf16_t* OUTT = (bf16_t*)(A.ws + WS_OUTT);
    const float* w_in = A.w_in + (size_t)l * DM * W_IN_COLS;
    constexpr int I_G = 16 * 128, I_P = 16 * 149, I_UQ = 4 * 24, I_UKV = 2 * 32, I_BR = 4 * 8 * 32, I_OUT = 16 * 32;
    constexpr int NIT = I_G + I_P + I_UQ + I_UKV + I_BR + I_OUT;
    for (int it = gw; it < NIT; it += NGW) {
        int r = it;
        if (r < I_G) { conv_item(w_in, W_IN_COLS, 4768, DM, WINT, 0, scr, r, 128, F.lane); continue; } r -= I_G;
        if (r < I_P) { conv_item(w_in, W_IN_COLS, 0, DM, WINT, NGATE, scr, r, 149, F.lane); continue; } r -= I_P;
        if (r < I_UQ) { conv_item(A.mla_w_uq + (size_t)l * 256 * 768, 768, 0, 256, UQT, 0, scr, r, 24, F.lane); continue; } r -= I_UQ;
        if (r < I_UKV) { conv_item(A.mla_w_ukv + (size_t)l * 128 * 1024, 1024, 0, 128, UKVT, 0, scr, r, 32, F.lane); continue; } r -= I_UKV;
        if (r < I_BR) { const int b = r / 256; conv_item(A.w_branch + ((size_t)l * 4 + b) * 512 * 1024, 1024, 0, 512, BRT, b * 1024, scr, r % 256, 32, F.lane); continue; } r -= I_BR;
        conv_item(A.w_out + (size_t)l * DM * DM, DM, 0, DM, OUTT, 0, scr, r, 32, F.lane);
    }
    { unsigned z0 = 0u; asm volatile("" : "+v"(z0)); u32x4 z = {z0, z0, z0, z0}; GAS u32x4* p = (GAS u32x4*)(WINT + (size_t)(NGATE + 4768) * DM);
      for (int i = (F.vcu * 512 + F.tid); i < 96 * DM / 8; i += F.G * 512) p[i] = z; }
}
__device__ __forceinline__ void conv_layer_moe(const Frame& F0, int l) {
    const Args A = load_args(); const Frame F = fresh(F0);
    LAS float* scr = (LAS float*)(F.lds + F.wave * 16384);
    const int gw = F.vcu * 8 + F.wave, NGW = F.G * 8;
    bf16_t* GUT = (bf16_t*)(A.ws + WS_GUT); bf16_t* DT = (bf16_t*)(A.ws + WS_DT);
    constexpr int I_GU = 16 * 256, I_D = 16 * 128;
    for (int it = gw; it < I_GU + I_D; it += NGW) {
        if (it < I_GU) { const int e = it >> 8, j = (it >> 6) & 3, item = it & 63, q = j >> 1, isup = j & 1;
            const float* src = (isup ? A.moe_w_up : A.moe_w_gate) + ((size_t)l * 16 + e) * DM * 256;
            conv_item(src, 256, q * 128, DM, GUT, e * 512 + q * 256 + isup * 128, scr, item, 4, F.lane);
        } else { const int r = it - I_GU, e = r >> 7, item = r & 127;
            conv_item(A.moe_w_down + ((size_t)l * 16 + e) * 256 * DM, DM, 0, 256, DT, e * 1024, scr, item, 32, F.lane); }
    }
}

__device__ __forceinline__ void p0_mod_rope(const Frame& F0) {
    const Args A = load_args(); const Frame F = fresh(F0);
    { float* rope = (float*)(A.ws + WS_ROPE);
      for (int idx = F.vcu * 512 + F.tid; idx < M * 16; idx += F.G * 512) { const int m = idx >> 4, i = idx & 15;
          const float inv = powf(10000.0f, -(float)(2 * i) / 32.0f); const float ang = (float)A.pos[m] * inv; float sn, cs; sincosf(ang, &sn, &cs);
          rope[m * 32 + i] = cs; rope[m * 32 + 16 + i] = sn; } }
    LAS float* cact = (LAS float*)(F.lds);
    LAS float* part = (LAS float*)(F.lds + 32768);
    for (int i = F.tid; i < 8 * DM; i += 512) { const int b = i >> 10, k = i & 1023; cact[k * 8 + b] = fsilu(A.c[b * DM + k]); }
    __syncthreads();
    float* mod = (float*)(A.ws + WS_MOD);
    for (int u = F.vcu; u < 2 * 96; u += F.G) {
        const int l = u / 96, n0 = (u % 96) * 64;
        const float* w = A.ada_w + (size_t)l * DM * 6144 + n0 + F.lane;
        float acc[8];
#pragma unroll
        for (int b = 0; b < 8; ++b) acc[b] = 0.f;
        const int k0 = F.wave * 128;
#pragma unroll 4
        for (int k = 0; k < 128; ++k) { const float wv = w[(size_t)(k0 + k) * 6144]; const f32x4 c0 = *(const LAS f32x4*)(cact + (k0 + k) * 8), c1 = *(const LAS f32x4*)(cact + (k0 + k) * 8 + 4);
            acc[0] += c0[0] * wv; acc[1] += c0[1] * wv; acc[2] += c0[2] * wv; acc[3] += c0[3] * wv; acc[4] += c1[0] * wv; acc[5] += c1[1] * wv; acc[6] += c1[2] * wv; acc[7] += c1[3] * wv; }
#pragma unroll
        for (int b = 0; b < 8; ++b) part[(F.wave * 8 + b) * 64 + F.lane] = acc[b];
        __syncthreads();
        { const int b = F.tid >> 6, n = F.tid & 63; float s = 0.f;
#pragma unroll
          for (int w8 = 0; w8 < 8; ++w8) s += part[(w8 * 8 + b) * 64 + n];
          mod[((size_t)l * 8 + b) * 6144 + n0 + n] = s + A.ada_b[l * 6144 + n0 + n]; }
        __syncthreads();
    }
}

__device__ __forceinline__ void norm_row(const float* xrow, const float* g, const float* sh, const float* sc, int lane, f32x4 (&v)[4]) {
    const GAS f32x4* xr = (const GAS f32x4*)xrow + lane; float s = 0.f;
#pragma unroll
    for (int j = 0; j < 4; ++j) { v[j] = xr[64 * j]; s += (v[j].x * v[j].x + v[j].y * v[j].y) + (v[j].z * v[j].z + v[j].w * v[j].w); }
    const float rstd = rsqrtf(wave_sum(s, lane) * (1.f / DM) + EPS);
#pragma unroll
    for (int j = 0; j < 4; ++j) { const f32x4 gg = ((const GAS f32x4*)g)[lane + 64 * j], s1 = ((const GAS f32x4*)sc)[lane + 64 * j], s0 = ((const GAS f32x4*)sh)[lane + 64 * j];
        v[j] = v[j] * rstd * gg * (s1 + 1.0f) + s0; }
}
__device__ __forceinline__ void store_row_bf16(bf16_t* orow, int lane, const f32x4 (&v)[4]) {
    GAS unsigned long long* o8 = (GAS unsigned long long*)orow + lane;
#pragma unroll
    for (int j = 0; j < 4; ++j) o8[64 * j] = (unsigned long long)pk2(v[j].x, v[j].y) | ((unsigned long long)pk2(v[j].z, v[j].w) << 32);
}
__device__ __forceinline__ void phase_norm1(const Frame& F0, int l) {
    const Args A = load_args(); const Frame F = fresh(F0);
    const float* xin = (l == 0) ? A.x : A.out; bf16_t* H = (bf16_t*)(A.ws + WS_H); const float* mod = (const float*)(A.ws + WS_MOD) + (size_t)l * 8 * 6144;
    const int gw = F.vcu * 8 + F.wave, NGW = F.G * 8;
    for (int m = gw; m < M; m += NGW) { const int b = m >> 11; f32x4 v[4];
        norm_row(xin + (size_t)m * DM, A.norm_mix + l * DM, mod + b * 6144 + 0, mod + b * 6144 + 1024, F.lane, v);
        store_row_bf16(H + (size_t)m * DM, F.lane, v); }
}
__device__ __forceinline__ void phase_norm2_router(const Frame& F0, int l) {
    const Args A = load_args(); const Frame F = fresh(F0);
    bf16_t* H = (bf16_t*)(A.ws + WS_H); const float* mod = (const float*)(A.ws + WS_MOD) + (size_t)l * 8 * 6144;
    int* list = (int*)(A.ws + WS_LIST); float* tokw = (float*)(A.ws + WS_TOKW); unsigned* cnt = (unsigned*)(A.ws + WS_CTL) + CW_CNT + 64 * l;
    const int gw = F.vcu * 8 + F.wave, NGW = F.G * 8;
    for (int m = gw; m < M; m += NGW) { const int b = m >> 11; f32x4 v[4];
        norm_row(A.out + (size_t)m * DM, A.norm_ffn + l * DM, mod + b * 6144 + 3072, mod + b * 6144 + 4096, F.lane, v);
        store_row_bf16(H + (size_t)m * DM, F.lane, v);
        float lg[16];
#pragma unroll
        for (int e = 0; e < 16; ++e) lg[e] = 0.f;
#pragma unroll
        for (int j = 0; j < 4; ++j)
#pragma unroll
            for (int i = 0; i < 4; ++i) { const float hv = v[j][i]; const GAS f32x4* rw = (const GAS f32x4*)(A.router_w + (size_t)(4 * F.lane + 256 * j + i) * 16);
                const f32x4 r0 = rw[0], r1 = rw[1], r2 = rw[2], r3 = rw[3];
                lg[0] += hv * r0[0]; lg[1] += hv * r0[1]; lg[2] += hv * r0[2]; lg[3] += hv * r0[3]; lg[4] += hv * r1[0]; lg[5] += hv * r1[1]; lg[6] += hv * r1[2]; lg[7] += hv * r1[3];
                lg[8] += hv * r2[0]; lg[9] += hv * r2[1]; lg[10] += hv * r2[2]; lg[11] += hv * r2[3]; lg[12] += hv * r3[0]; lg[13] += hv * r3[1]; lg[14] += hv * r3[2]; lg[15] += hv * r3[3]; }
#pragma unroll
        for (int e = 0; e < 16; ++e) lg[e] = wave_sum(lg[e], F.lane);
        if (F.lane == 0) {
            float sc[16], sel[16];
#pragma unroll
            for (int e = 0; e < 16; ++e) { sc[e] = fsigmoid(lg[e]); sel[e] = sc[e] + A.router_bias[e]; }
            int bg = 0, bi1 = 0, bi2 = 1; float bgs = -1e30f, bw1 = 0.f, bw2 = 0.f;
#pragma unroll
            for (int g = 0; g < 4; ++g) { int i1 = 0; float s1 = sel[g * 4], w1 = sc[g * 4];
#pragma unroll
                for (int i = 1; i < 4; ++i) { const float sv = sel[g * 4 + i]; if (sv > s1) { s1 = sv; i1 = i; w1 = sc[g * 4 + i]; } }
                int i2 = -1; float s2 = -1e30f, w2 = 0.f;
#pragma unroll
                for (int i = 0; i < 4; ++i) { const float sv = sel[g * 4 + i]; if (i != i1 && sv > s2) { s2 = sv; i2 = i; w2 = sc[g * 4 + i]; } }
                const float gs = s1 + s2; if (gs > bgs) { bgs = gs; bg = g; bi1 = i1; bi2 = i2; bw1 = w1; bw2 = w2; } }
            const int ia = bi1 < bi2 ? bi1 : bi2, ib = bi1 < bi2 ? bi2 : bi1;
            const float wa0 = bi1 < bi2 ? bw1 : bw2, wb0 = bi1 < bi2 ? bw2 : bw1, inv = 1.0f / (wa0 + wb0);
            const int pidx = (ia == 0) ? (ib - 1) : (ia == 1 ? ib + 1 : 5);
            const int pair = bg * 6 + pidx;
            const unsigned p = atomicAdd(cnt + pair, 1u);
            list[pair * 16384 + (int)p] = m; tokw[2 * m] = wa0 * inv; tokw[2 * m + 1] = wb0 * inv;
        }
    }
}
__device__ __forceinline__ void pair_experts(int pair, int& ea, int& eb) { const int g = pair / 6, pi = pair % 6;
    const int ia = pi < 3 ? 0 : (pi < 5 ? 1 : 2); const int ib = pi < 3 ? pi + 1 : (pi < 5 ? pi - 1 : 3); ea = g * 4 + ia; eb = g * 4 + ib; }

__device__ __forceinline__ void mla_prep_unit(const Frame& F0, int l, int unit) {
    const Args A = load_args(); const Frame F = fresh(F0);
    const int tid = F.tid, lane = F.lane, w = F.wave, r32 = lane & 31, hi = lane >> 5;
    LAS unsigned char* lds = F.lds;
    constexpr int XQ_OFF = 0, XQ_ST = 528, XKV_OFF = 64 * 528, XKV_ST = 272, XR_OFF = XKV_OFF + 64 * 272;
    const bf16_t* proj = (const bf16_t*)(A.ws + WS_PROJ);
    const int m0 = unit * 64;
    { const float* gq = A.mla_q_norm + l * 256; const float* gkv = A.mla_kv_norm + l * 128;
      const f32x4 g4 = *(const f32x4*)(gq + 4 * lane); const float g2a = gkv[2 * lane], g2b = gkv[2 * lane + 1];
#pragma unroll 2
      for (int j = 0; j < 8; ++j) { const int t = w * 8 + j; const bf16_t* row = proj + (size_t)(m0 + t) * NPROJ;
          const u32x2 cq = *(const u32x2*)(row + PC_CQ + 4 * lane); const unsigned ckv = *(const unsigned*)(row + PC_CKV + 2 * lane);
          const float q0 = bflo(cq.x), q1 = bfhi(cq.x), q2 = bflo(cq.y), q3 = bfhi(cq.y), k0 = bflo(ckv), k1 = bfhi(ckv);
          const float sq = wave_sum(q0 * q0 + q1 * q1 + q2 * q2 + q3 * q3, lane), sk = wave_sum(k0 * k0 + k1 * k1, lane);
          const float rq = rsqrtf(sq * (1.f / 256.f) + EPS), rk = rsqrtf(sk * (1.f / 128.f) + EPS);
          u32x2 o; o.x = pk2(q0 * rq * g4[0], q1 * rq * g4[1]); o.y = pk2(q2 * rq * g4[2], q3 * rq * g4[3]);
          *(LAS u32x2*)(lds + XQ_OFF + t * XQ_ST + lane * 8) = o;
          *(LAS unsigned*)(lds + XKV_OFF + t * XKV_ST + lane * 4) = pk2(k0 * rk * g2a, k1 * rk * g2b);
          if (lane < 32) *(LAS float*)(lds + XR_OFF + (t * 32 + lane) * 4) = bf2f(row[PC_KR + lane]); } }
    __syncthreads();
    const bf16_t* UQT = (const bf16_t*)(A.ws + WS_UQT); const bf16_t* UKVT = (const bf16_t*)(A.ws + WS_UKVT);
    const float* rope = (const float*)(A.ws + WS_ROPE);
    bf16_t* MQ = (bf16_t*)(A.ws + WS_MLAQ); bf16_t* MK = (bf16_t*)(A.ws + WS_MLAK); bf16_t* MV = (bf16_t*)(A.ws + WS_MLAV);
    const float* gqk = A.mla_qk_norm + l * 192;
    const int h = w;
#pragma unroll 1
    for (int tb = 0; tb < 2; ++tb) {
        const int m = m0 + tb * 32 + r32, tl = tb * 32 + r32;
        float csn[8], ssn[8];
#pragma unroll
        for (int r = 0; r < 8; ++r) { const int i = crow(r, hi); csn[r] = rope[m * 32 + i]; ssn[r] = rope[m * 32 + 16 + i]; }
        {
            f32x16 acc[3];
#pragma unroll
            for (int nt = 0; nt < 3; ++nt) acc[nt] = (f32x16){0};
#pragma unroll 4
            for (int ks = 0; ks < 16; ++ks) {
                const bf16x8 x0 = *(const LAS bf16x8*)(lds + XQ_OFF + tl * XQ_ST + ks * 32 + hi * 16);
#pragma unroll
                for (int nt = 0; nt < 3; ++nt) { const bf16x8 wf = *(const bf16x8*)(UQT + (size_t)(h * 96 + nt * 32 + r32) * 256 + ks * 16 + hi * 8);
                    acc[nt] = __builtin_amdgcn_mfma_f32_32x32x16_bf16(wf, x0, acc[nt], 0, 0, 0); }
            }
            float ss = 0.f;
#pragma unroll
            for (int nt = 0; nt < 3; ++nt)
#pragma unroll
                for (int r = 0; r < 16; ++r) ss += acc[nt][r] * acc[nt][r];
            ss += shx(ss, 32, lane);
            const float rstd = rsqrtf(ss * (1.f / 96.f) + EPS);
#pragma unroll
            for (int nt = 0; nt < 3; ++nt)
#pragma unroll
                for (int r = 0; r < 16; ++r) acc[nt][r] = acc[nt][r] * rstd * gqk[nt * 32 + crow(r, hi)];
#pragma unroll
            for (int r = 0; r < 8; ++r) { const float x1 = acc[2][r], x2 = acc[2][r + 8]; acc[2][r] = x1 * csn[r] - x2 * ssn[r]; acc[2][r + 8] = x1 * ssn[r] + x2 * csn[r]; }
            bf16_t* orow = MQ + (size_t)m * 768 + h * 96;
#pragma unroll
            for (int nt = 0; nt < 3; ++nt)
#pragma unroll
                for (int g = 0; g < 4; ++g) { u32x2 o; o.x = pk2(acc[nt][4 * g], acc[nt][4 * g + 1]); o.y = pk2(acc[nt][4 * g + 2], acc[nt][4 * g + 3]);
                    *(u32x2*)(orow + nt * 32 + 8 * g + 4 * hi) = o; }
        }
        {
            f32x16 acc[4];
#pragma unroll
            for (int nt = 0; nt < 4; ++nt) acc[nt] = (f32x16){0};
#pragma unroll 2
            for (int ks = 0; ks < 8; ++ks) {
                const bf16x8 x0 = *(const LAS bf16x8*)(lds + XKV_OFF + tl * XKV_ST + ks * 32 + hi * 16);
#pragma unroll
                for (int nt = 0; nt < 4; ++nt) { const bf16x8 wf = *(const bf16x8*)(UKVT + (size_t)(h * 128 + nt * 32 + r32) * 128 + ks * 16 + hi * 8);
                    acc[nt] = __builtin_amdgcn_mfma_f32_32x32x16_bf16(wf, x0, acc[nt], 0, 0, 0); }
            }
            f32x16 kr;
#pragma unroll
            for (int r = 0; r < 16; ++r) kr[r] = *(const LAS float*)(lds + XR_OFF + (tl * 32 + crow(r, hi)) * 4);
            float ss = 0.f;
#pragma unroll
            for (int nt = 0; nt < 2; ++nt)
#pragma unroll
                for (int r = 0; r < 16; ++r) ss += acc[nt][r] * acc[nt][r];
#pragma unroll
            for (int r = 0; r < 16; ++r) ss += kr[r] * kr[r];
            ss += shx(ss, 32, lane);
            const float rstd = rsqrtf(ss * (1.f / 96.f) + EPS);
#pragma unroll
            for (int nt = 0; nt < 2; ++nt)
#pragma unroll
                for (int r = 0; r < 16; ++r) acc[nt][r] = acc[nt][r] * rstd * gqk[96 + nt * 32 + crow(r, hi)];
#pragma unroll
            for (int r = 0; r < 16; ++r) kr[r] = kr[r] * rstd * gqk[96 + 64 + crow(r, hi)];
#pragma unroll
            for (int r = 0; r < 8; ++r) { const float x1 = kr[r], x2 = kr[r + 8]; kr[r] = x1 * csn[r] - x2 * ssn[r]; kr[r + 8] = x1 * ssn[r] + x2 * csn[r]; }
            bf16_t* krow = MK + (size_t)m * 768 + h * 96;
#pragma unroll
            for (int nt = 0; nt < 2; ++nt)
#pragma unroll
                for (int g = 0; g < 4; ++g) { u32x2 o; o.x = pk2(acc[nt][4 * g], acc[nt][4 * g + 1]); o.y = pk2(acc[nt][4 * g + 2], acc[nt][4 * g + 3]);
                    *(u32x2*)(krow + nt * 32 + 8 * g + 4 * hi) = o; }
#pragma unroll
            for (int g = 0; g < 4; ++g) { u32x2 o; o.x = pk2(kr[4 * g], kr[4 * g + 1]); o.y = pk2(kr[4 * g + 2], kr[4 * g + 3]);
                *(u32x2*)(krow + 64 + 8 * g + 4 * hi) = o; }
            bf16_t* vrow = MV + (size_t)m * 512 + h * 64;
#pragma unroll
            for (int nt = 0; nt < 2; ++nt)
#pragma unroll
                for (int g = 0; g < 4; ++g) { u32x2 o; o.x = pk2(acc[2 + nt][4 * g], acc[2 + nt][4 * g + 1]); o.y = pk2(acc[2 + nt][4 * g + 2], acc[2 + nt][4 * g + 3]);
                    *(u32x2*)(vrow + nt * 32 + 8 * g + 4 * hi) = o; }
        }
    }
    __syncthreads();
}

struct AttnWaveCfg {
    const bf16_t* q; int qstride;
    int qpos0;
    int kcoloff;
};
template <int DQK, int DV, int KC, bool NORM, int WINDOW>
struct AttnBody {
    static constexpr int KST = KC * 2 + 16, VST = DV * 2 + 64, KBUF = 64 * KST, VBUF = 64 * VST;
    static constexpr int K_OFF = 0, V_OFF = 2 * KBUF, SCR_OFF = 2 * KBUF + 2 * VBUF;
    static constexpr int NKC = KC / 8, NKCH = 64 * NKC, NKR = (NKCH + 511) / 512;
    static constexpr int NVC = DV / 8, NVCH = 64 * NVC, NVR = (NVCH + 511) / 512;
    static constexpr int NKS = DQK / 16, ND0 = DV / 32;
    __device__ static __forceinline__ void run(const Frame& F, const AttnWaveCfg& W, const bf16_t* Kg, int kstride, const bf16_t* Vg, int vstride,
                                               int kt_lo, int kt_hi, float c2, const float* gq, const float* gk, bool use_sink, float sink_l2, f32x16 (&o)[ND0]) {
        const int tid = F.tid, lane = F.lane, r32 = lane & 31, hi = lane >> 5;
        LAS unsigned char* lds = F.lds;
        LAS float* wsf = (LAS float*)(lds + SCR_OFF + F.wave * 256);
        bf16x8 qf[NKS];
        {
            float qv[NKS][8]; float ss = 0.f;
#pragma unroll
            for (int ks = 0; ks < NKS; ++ks) { const u32x4 raw = *(const u32x4*)(W.q + (size_t)r32 * W.qstride + ks * 16 + hi * 8);
#pragma unroll
                for (int j = 0; j < 4; ++j) { qv[ks][2 * j] = bflo(raw[j]); qv[ks][2 * j + 1] = bfhi(raw[j]); }
#pragma unroll
                for (int j = 0; j < 8; ++j) ss += qv[ks][j] * qv[ks][j]; }
            if (NORM) { ss += shx(ss, 32, lane); const float rstd = rsqrtf(ss * (1.f / DQK) + EPS);
#pragma unroll
                for (int ks = 0; ks < NKS; ++ks)
#pragma unroll
                    for (int j = 0; j < 8; ++j) qv[ks][j] *= rstd * gq[ks * 16 + hi * 8 + j]; }
#pragma unroll
            for (int ks = 0; ks < NKS; ++ks) { u32x4 p; p.x = pk2(qv[ks][0], qv[ks][1]); p.y = pk2(qv[ks][2], qv[ks][3]); p.z = pk2(qv[ks][4], qv[ks][5]); p.w = pk2(qv[ks][6], qv[ks][7]);
                qf[ks] = __builtin_bit_cast(bf16x8, p); }
        }
#pragma unroll
        for (int d = 0; d < ND0; ++d) o[d] = (f32x16){0};
        float m_run = -1e30f, l_run = 0.f;
        u32x4 kreg[NKR], vreg[NVR];
        auto load_tile = [&](int kt) {
#pragma unroll
            for (int i = 0; i < NKR; ++i) { const int c = tid + i * 512; if (NKCH % 512 == 0 || c < NKCH) { const int row = c / NKC, ch = c % NKC;
                kreg[i] = *(const u32x4*)(Kg + (size_t)(kt * 64 + row) * kstride + ch * 8); } }
#pragma unroll
            for (int i = 0; i < NVR; ++i) { const int c = tid + i * 512; const int row = c / NVC, ch = c % NVC;
                vreg[i] = *(const u32x4*)(Vg + (size_t)(kt * 64 + row) * vstride + ch * 8); }
        };
        auto write_tile = [&](int buf) {
#pragma unroll
            for (int i = 0; i < NKR; ++i) { const int c = tid + i * 512; if (NKCH % 512 == 0 || c < NKCH) { const int row = c / NKC, ch = c % NKC; u32x4 kv = kreg[i];
                if (NORM) { float f[8];
#pragma unroll
                    for (int j = 0; j < 4; ++j) { f[2 * j] = bflo(kv[j]); f[2 * j + 1] = bfhi(kv[j]); }
                    float ss = 0.f;
#pragma unroll
                    for (int j = 0; j < 8; ++j) ss += f[j] * f[j];
                    ss += shx(ss, 1, lane); ss += shx(ss, 2, lane); ss += shx(ss, 4, lane);
                    const float rstd = rsqrtf(ss * (1.f / 64.f) + EPS); const float* g = gk + (ch & 7) * 8;
                    kv.x = pk2(f[0] * rstd * g[0], f[1] * rstd * g[1]); kv.y = pk2(f[2] * rstd * g[2], f[3] * rstd * g[3]);
                    kv.z = pk2(f[4] * rstd * g[4], f[5] * rstd * g[5]); kv.w = pk2(f[6] * rstd * g[6], f[7] * rstd * g[7]); }
                *(LAS u32x4*)(lds + K_OFF + buf * KBUF + row * KST + ch * 16) = kv; } }
#pragma unroll
            for (int i = 0; i < NVR; ++i) { const int c = tid + i * 512; const int row = c / NVC, ch = c % NVC;
                *(LAS u32x4*)(lds + V_OFF + buf * VBUF + row * VST + ch * 16) = vreg[i]; }
        };
        const int qlo = W.qpos0, qhi = W.qpos0 + 31;
        load_tile(kt_lo);
        for (int kt = kt_lo; kt < kt_hi; ++kt) {
            const int buf = (kt - kt_lo) & 1;
            write_tile(buf);
            __syncthreads();
            if (kt + 1 < kt_hi) load_tile(kt + 1);
            const int k0 = kt * 64;
            bool need = (k0 <= qhi);
            if (WINDOW > 0) need = need && (k0 + 63 >= qlo - (WINDOW - 1));
            if (need) {
                f32x16 p0 = (f32x16){0}, p1 = (f32x16){0};
                const LAS unsigned char* kb = lds + K_OFF + buf * KBUF + r32 * KST + W.kcoloff * 2 + hi * 16;
#pragma unroll
                for (int ks = 0; ks < NKS; ++ks) { const bf16x8 a0 = *(const LAS bf16x8*)(kb + ks * 32), a1 = *(const LAS bf16x8*)(kb + 32 * KST + ks * 32);
                    p0 = __builtin_amdgcn_mfma_f32_32x32x16_bf16(a0, qf[ks], p0, 0, 0, 0); p1 = __builtin_amdgcn_mfma_f32_32x32x16_bf16(a1, qf[ks], p1, 0, 0, 0); }
                const int qpos = W.qpos0 + r32;
                bool full = (k0 + 63 <= qlo);
                if (WINDOW > 0) full = full && (k0 >= qhi - (WINDOW - 1));
                if (full) {
#pragma unroll
                    for (int r = 0; r < 16; ++r) { p0[r] *= c2; p1[r] *= c2; }
                } else {
#pragma unroll
                    for (int r = 0; r < 16; ++r) { const int ka = k0 + crow(r, hi), kb2 = ka + 32;
                        bool va = ka <= qpos, vb = kb2 <= qpos; if (WINDOW > 0) { va = va && (qpos - ka < WINDOW); vb = vb && (qpos - kb2 < WINDOW); }
                        p0[r] = va ? p0[r] * c2 : -INFINITY; p1[r] = vb ? p1[r] * c2 : -INFINITY; }
                }
                float mx = fmaxf(p0[0], p1[0]);
#pragma unroll
                for (int r = 1; r < 16; ++r) mx = fmaxf(mx, fmaxf(p0[r], p1[r]));
                mx = fmaxf(mx, shx(mx, 32, lane));
                if (__any(mx > m_run)) {
                    const float mn = fmaxf(m_run, mx); const float alpha = __builtin_amdgcn_exp2f(m_run - mn); m_run = mn; l_run *= alpha;
                    if (hi == 0) wsf[r32] = alpha;
                    LDS_WAIT();
#pragma unroll
                    for (int r = 0; r < 16; ++r) { const float a = wsf[crow(r, hi)];
#pragma unroll
                        for (int d = 0; d < ND0; ++d) o[d][r] *= a; }
                }
                float rs = 0.f;
#pragma unroll
                for (int r = 0; r < 16; ++r) { p0[r] = __builtin_amdgcn_exp2f(p0[r] - m_run); p1[r] = __builtin_amdgcn_exp2f(p1[r] - m_run); rs += p0[r] + p1[r]; }
                l_run += rs;
                const LAS unsigned char* vb = lds + V_OFF + buf * VBUF + (4 * hi + ((lane & 15) >> 2)) * VST + ((lane >> 4) & 1) * 32 + (lane & 3) * 8;
#pragma unroll
                for (int hf = 0; hf < 2; ++hf)
#pragma unroll
                    for (int s = 0; s < 2; ++s) {
                        u32x4 pw;
                        if (hf == 0) { pw.x = pk2(p0[8 * s], p0[8 * s + 1]); pw.y = pk2(p0[8 * s + 2], p0[8 * s + 3]); pw.z = pk2(p0[8 * s + 4], p0[8 * s + 5]); pw.w = pk2(p0[8 * s + 6], p0[8 * s + 7]); }
                        else { pw.x = pk2(p1[8 * s], p1[8 * s + 1]); pw.y = pk2(p1[8 * s + 2], p1[8 * s + 3]); pw.z = pk2(p1[8 * s + 4], p1[8 * s + 5]); pw.w = pk2(p1[8 * s + 6], p1[8 * s + 7]); }
                        const bf16x8 pa = __builtin_bit_cast(bf16x8, pw);
#pragma unroll
                        for (int d = 0; d < ND0; ++d) {
                            const LAS unsigned char* vp = vb + (32 * hf + 16 * s) * VST + d * 64;
                            const s16x4 lo = __builtin_bit_cast(s16x4, __builtin_amdgcn_ds_read_tr16_b64_v4i16((LAS s16x4*)vp));
                            const s16x4 hh = __builtin_bit_cast(s16x4, __builtin_amdgcn_ds_read_tr16_b64_v4i16((LAS s16x4*)(vp + 8 * VST)));
                            const bf16x8 vf = (bf16x8){lo[0], lo[1], lo[2], lo[3], hh[0], hh[1], hh[2], hh[3]};
                            o[d] = __builtin_amdgcn_mfma_f32_32x32x16_bf16(pa, vf, o[d], 0, 0, 0);
                        }
                    }
            }
        }
        l_run += shx(l_run, 32, lane);
        if (use_sink) l_run += __builtin_amdgcn_exp2f(sink_l2 - m_run);
        if (hi == 0) wsf[32 + r32] = 1.0f / l_run;
        LDS_WAIT();
#pragma unroll
        for (int r = 0; r < 16; ++r) { const float a = wsf[32 + crow(r, hi)];
#pragma unroll
            for (int d = 0; d < ND0; ++d) o[d][r] *= a; }
        __syncthreads();
    }
};
template <int ND0>
__device__ __forceinline__ void store_o_bf16(bf16_t* orow0, int ostride, int lane, const f32x16 (&o)[ND0]) {
    const int r32 = lane & 31, hi = lane >> 5;
#pragma unroll
    for (int r = 0; r < 16; ++r)
#pragma unroll
        for (int d = 0; d < ND0; ++d) orow0[(size_t)crow(r, hi) * ostride + d * 32 + r32] = (bf16_t)f2bf(o[d][r]);
}

__device__ __forceinline__ void mla_attn_unit(const Frame& F0, int b, int h, int qb) {
    const Args A = load_args(); const Frame F = fresh(F0);
    typedef AttnBody<96, 64, 96, false, 0> AB;
    bf16_t* MQ = (bf16_t*)(A.ws + WS_MLAQ); const bf16_t* MK = (const bf16_t*)(A.ws + WS_MLAK); const bf16_t* MV = (const bf16_t*)(A.ws + WS_MLAV);
    const int q0 = qb * 256 + F.wave * 32; const size_t rb = (size_t)b * SEQ;
    AttnWaveCfg W; W.q = MQ + (rb + q0) * 768 + h * 96; W.qstride = 768; W.qpos0 = q0; W.kcoloff = 0;
    f32x16 o[2];
    AB::run(F, W, MK + rb * 768 + h * 96, 768, MV + rb * 512 + h * 64, 512, 0, (qb * 256 + 256) / 64, 0.10206207261596575f * LOG2E, nullptr, nullptr, false, 0.f, o);
    store_o_bf16<2>(MQ + (rb + q0) * 768 + h * 96, 768, F.lane, o);
}
__device__ __forceinline__ void swa_attn_unit(const Frame& F0, int l, int b, int kvh, int rb64) {
    const Args A = load_args(); const Frame F = fresh(F0);
    typedef AttnBody<64, 64, 64, true, 128> AB;
    bf16_t* proj = (bf16_t*)(A.ws + WS_PROJ);
    const int hq = kvh * 4 + (F.wave >> 1); const int q0 = rb64 * 64 + (F.wave & 1) * 32; const size_t rb = (size_t)b * SEQ;
    AttnWaveCfg W; W.q = proj + (rb + q0) * NPROJ + PC_SQ + hq * 64; W.qstride = NPROJ; W.qpos0 = q0; W.kcoloff = 0;
    const int kt_hi = rb64 + 1, kt_lo = (rb64 - 2) < 0 ? 0 : rb64 - 2;
    f32x16 o[2];
    AB::run(F, W, proj + rb * NPROJ + PC_SK + kvh * 64, NPROJ, proj + rb * NPROJ + PC_SV + kvh * 64, NPROJ, kt_lo, kt_hi, 0.125f * LOG2E,
            A.swa_qk_norm + l * 128, A.swa_qk_norm + l * 128 + 64, true, A.swa_sinks[l * 8 + hq] * LOG2E, o);
    store_o_bf16<2>(proj + (rb + q0) * NPROJ + PC_SQ + hq * 64, NPROJ, F.lane, o);
}
__device__ __forceinline__ void diff_attn_unit(const Frame& F0, int l, int b, int hh, int qb128) {
    const Args A = load_args(); const Frame F = fresh(F0);
    typedef AttnBody<64, 128, 128, true, 0> AB;
    bf16_t* proj = (bf16_t*)(A.ws + WS_PROJ);
    const int sub = F.wave & 1, rbk = F.wave >> 1; const int q0 = qb128 * 128 + rbk * 32; const size_t rb = (size_t)b * SEQ;
    AttnWaveCfg W; W.q = proj + (rb + q0) * NPROJ + PC_DQ + hh * 128 + sub * 64; W.qstride = NPROJ; W.qpos0 = q0; W.kcoloff = sub * 64;
    float lam;
    { const float* lp = A.diff_lam + l * 256; const float a = wave_sum(lp[F.lane] * lp[64 + F.lane], F.lane), c = wave_sum(lp[128 + F.lane] * lp[192 + F.lane], F.lane);
      const float lam_init = 0.8f - 0.6f * __expf(-0.3f * (float)l); lam = __expf(a) - __expf(c) + lam_init; }
    f32x16 o[4];
    AB::run(F, W, proj + rb * NPROJ + PC_DK + hh * 128, NPROJ, proj + rb * NPROJ + PC_DV + hh * 128, NPROJ, 0, (qb128 * 128 + 128) / 64, 0.125f * LOG2E,
            A.diff_qk_norm + l * 128, A.diff_qk_norm + l * 128 + 64, false, 0.f, o);
    LAS float* ex = (LAS float*)(F.lds) + rbk * 4096;
    const int r32 = F.lane & 31, hi = F.lane >> 5;
    if (sub == 1) {
#pragma unroll
        for (int r = 0; r < 16; ++r)
#pragma unroll
            for (int d = 0; d < 4; ++d) ex[crow(r, hi) * 128 + d * 32 + r32] = o[d][r];
    }
    __syncthreads();
    if (sub == 0) {
        const float lam_init = 0.8f - 0.6f * __expf(-0.3f * (float)l);
        float ss[16];
#pragma unroll
        for (int r = 0; r < 16; ++r) { ss[r] = 0.f;
#pragma unroll
            for (int d = 0; d < 4; ++d) { const float v = o[d][r] - lam * ex[crow(r, hi) * 128 + d * 32 + r32]; o[d][r] = v; ss[r] += v * v; } }
#pragma unroll
        for (int r = 0; r < 16; ++r) { float s = ss[r]; s += shx(s, 1, F.lane); s += shx(s, 2, F.lane); s += shx(s, 4, F.lane); s += shx(s, 8, F.lane); s += shx(s, 16, F.lane);
            const float rstd = rsqrtf(s * (1.f / 128.f) + EPS) * (1.0f - lam_init);
#pragma unroll
            for (int d = 0; d < 4; ++d) o[d][r] *= rstd * A.diff_onorm[l * 128 + d * 32 + r32]; }
        store_o_bf16<4>(proj + (rb + q0) * NPROJ + PC_DQ + hh * 128, NPROJ, F.lane, o);
    }
    __syncthreads();
}

__device__ __forceinline__ void hgrn_unit(const Frame& F0, int l, int b, int h) {
    const Args A = load_args(); const Frame F = fresh(F0);
    const int tid = F.tid, lane = F.lane, w = F.wave, r32 = lane & 31, hi = lane >> 5;
    LAS unsigned char* lds = F.lds;
    constexpr int ST = 144, STT = 192;
    constexpr int O_QB = 0, O_QD = O_QB + 64 * ST, O_KD = O_QD + 64 * ST, O_QX = O_KD + 64 * ST, O_KX = O_QX + 64 * ST;
    constexpr int O_KE = O_KX + 64 * ST, O_V = O_KE + 64 * STT, O_S = O_V + 64 * STT;
    constexpr int O_SEG = O_S + 2 * 64 * STT, O_DL = O_SEG + 8 * 64 * 4;
    bf16_t* proj = (bf16_t*)(A.ws + WS_PROJ);
    const size_t rb = (size_t)b * SEQ;
    const int k = lane;
    float lb = 0.f;
    if (l == 1) { const float a0 = A.hg_lb[h * 64 + k], a1 = A.hg_lb[512 + h * 64 + k]; lb = 1.0f / (1.0f + __expf(a0 - a1)); }
    for (int i = tid; i < 64 * STT / 4; i += 512) *(LAS unsigned*)(lds + O_S + i * 4) = 0u;
    f32x16 sacc = (f32x16){0};
    unsigned short qraw[8], fraw[8]; u32x4 vraw;
    auto load_chunk = [&](int c) {
        const bf16_t* base = proj + (rb + c * 64 + w * 8) * NPROJ + h * 64 + k;
#pragma unroll
        for (int j = 0; j < 8; ++j) { qraw[j] = base[(size_t)j * NPROJ + PC_HQ]; fraw[j] = base[(size_t)j * NPROJ + PC_HF]; }
        vraw = *(const u32x4*)(proj + (rb + c * 64 + (tid >> 3)) * NPROJ + PC_HI + h * 64 + (tid & 7) * 8);
    };
    load_chunk(0);
    for (int c = 0; c < 32; ++c) {
        const int sb_cur = c & 1;
        float qv[8], kkv[8], bl[8]; float run = 0.f;
#pragma unroll
        for (int j = 0; j < 8; ++j) { const float f = bf2f(fraw[j]), q = bf2f(qraw[j]);
            const float ef = __expf(-f); const float sg = 1.0f / (1.0f + ef); const float fg = lb + (1.0f - lb) * sg;
            float lf = __logf(fg); lf = fmaxf(lf, -30.0f);
            kkv[j] = (1.0f - lb) * ef * sg;
            qv[j] = q / (1.0f + __expf(-q));
            run += lf; bl[j] = run; }
        const u32x4 vcur = vraw;
        *(LAS float*)(lds + O_SEG + (w * 64 + k) * 4) = run;
        __syncthreads();
        if (c + 1 < 32) load_chunk(c + 1);
        float sg8[8];
#pragma unroll
        for (int j = 0; j < 8; ++j) sg8[j] = *(LAS float*)(lds + O_SEG + (j * 64 + k) * 4);
        float off = 0.f;
#pragma unroll
        for (int j = 0; j < 8; ++j) off += (j < w) ? sg8[j] : 0.f;
        const float r15 = sg8[0] + sg8[1], r31 = r15 + sg8[2] + sg8[3], r47 = r31 + sg8[4] + sg8[5], r63 = r47 + sg8[6] + sg8[7];
        const float rd = (w < 4) ? r15 : r47;
#pragma unroll
        for (int j = 0; j < 8; ++j) { const int t = w * 8 + j; const float bt = off + bl[j];
            const float eb = __expf(bt);
            const float qd = qv[j] * __expf(fminf(bt - rd, 60.f)), kd = kkv[j] * __expf(fminf(rd - bt, 60.f));
            const float ke = kkv[j] * __expf(r63 - bt);
            *(LAS bf16_t*)(lds + O_QB + t * ST + k * 2) = (bf16_t)f2bf(qv[j] * eb);
            *(LAS bf16_t*)(lds + O_QD + t * ST + k * 2) = (bf16_t)f2bf(qd);
            *(LAS bf16_t*)(lds + O_KD + t * ST + k * 2) = (bf16_t)f2bf(kd);
            *(LAS bf16_t*)(lds + O_KE + t * STT + k * 2) = (bf16_t)f2bf(ke);
            if (w >= 4) *(LAS bf16_t*)(lds + O_QX + t * ST + k * 2) = (bf16_t)f2bf(qv[j] * __expf(bt - r31));
            else        *(LAS bf16_t*)(lds + O_KX + t * ST + k * 2) = (bf16_t)f2bf(kkv[j] * __expf(r31 - bt)); }
        *(LAS u32x4*)(lds + O_V + (tid >> 3) * STT + (tid & 7) * 16) = vcur;
        if (w == 0) *(LAS float*)(lds + O_DL + k * 4) = __expf(r63);
        __syncthreads();
        const int trow = 4 * hi + ((lane & 15) >> 2), tcol = ((lane >> 4) & 1) * 32 + (lane & 3) * 8;
        if (w < 2) {
            const int tb = w;
            f32x16 oacc[2]; oacc[0] = (f32x16){0}; oacc[1] = (f32x16){0};
            for (int sb = 0; sb <= tb; ++sb) {
                const int ko = (sb == tb) ? O_KD : O_KX, qo = (sb == tb) ? O_QD : O_QX;
                f32x16 p = (f32x16){0};
#pragma unroll
                for (int ks = 0; ks < 4; ++ks) { const bf16x8 ka = *(const LAS bf16x8*)(lds + ko + (32 * sb + r32) * ST + ks * 32 + hi * 16);
                    const bf16x8 qb = *(const LAS bf16x8*)(lds + qo + (32 * tb + r32) * ST + ks * 32 + hi * 16);
                    p = __builtin_amdgcn_mfma_f32_32x32x16_bf16(ka, qb, p, 0, 0, 0); }
                if (sb == tb) {
#pragma unroll
                    for (int r = 0; r < 16; ++r) p[r] = (crow(r, hi) <= r32) ? p[r] : 0.f;
                }
#pragma unroll
                for (int s = 0; s < 2; ++s) { u32x4 pw; pw.x = pk2(p[8 * s], p[8 * s + 1]); pw.y = pk2(p[8 * s + 2], p[8 * s + 3]); pw.z = pk2(p[8 * s + 4], p[8 * s + 5]); pw.w = pk2(p[8 * s + 6], p[8 * s + 7]);
                    const bf16x8 pa = __builtin_bit_cast(bf16x8, pw);
#pragma unroll
                    for (int d = 0; d < 2; ++d) { const LAS unsigned char* vp = lds + O_V + (32 * sb + 16 * s + trow) * STT + tcol + d * 64;
                        const s16x4 lo = __builtin_bit_cast(s16x4, __builtin_amdgcn_ds_read_tr16_b64_v4i16((LAS s16x4*)vp));
                        const s16x4 hh = __builtin_bit_cast(s16x4, __builtin_amdgcn_ds_read_tr16_b64_v4i16((LAS s16x4*)(vp + 8 * STT)));
                        const bf16x8 vf = (bf16x8){lo[0], lo[1], lo[2], lo[3], hh[0], hh[1], hh[2], hh[3]};
                        oacc[d] = __builtin_amdgcn_mfma_f32_32x32x16_bf16(pa, vf, oacc[d], 0, 0, 0); } }
            }
#pragma unroll
            for (int ks = 0; ks < 4; ++ks) { const bf16x8 qa = *(const LAS bf16x8*)(lds + O_QB + (32 * tb + r32) * ST + ks * 32 + hi * 16);
#pragma unroll
                for (int d = 0; d < 2; ++d) { const LAS unsigned char* sp = lds + O_S + sb_cur * 64 * STT + (16 * ks + 8 * hi + ((lane & 15) >> 2)) * STT + tcol + d * 64;
                    const s16x4 lo = __builtin_bit_cast(s16x4, __builtin_amdgcn_ds_read_tr16_b64_v4i16((LAS s16x4*)sp));
                    const s16x4 hh = __builtin_bit_cast(s16x4, __builtin_amdgcn_ds_read_tr16_b64_v4i16((LAS s16x4*)(sp + 4 * STT)));
                    const bf16x8 sf = (bf16x8){lo[0], lo[1], lo[2], lo[3], hh[0], hh[1], hh[2], hh[3]};
                    oacc[d] = __builtin_amdgcn_mfma_f32_32x32x16_bf16(qa, sf, oacc[d], 0, 0, 0); } }
            const float g0 = A.hg_onorm[l * 64 + r32], g1 = A.hg_onorm[l * 64 + 32 + r32];
#pragma unroll
            for (int r = 0; r < 16; ++r) { float s = oacc[0][r] * oacc[0][r] + oacc[1][r] * oacc[1][r];
                s += shx(s, 1, lane); s += shx(s, 2, lane); s += shx(s, 4, lane); s += shx(s, 8, lane); s += shx(s, 16, lane);
                const float rstd = rsqrtf(s * (1.f / 64.f) + EPS);
                bf16_t* row = proj + (rb + c * 64 + 32 * tb + crow(r, hi)) * NPROJ + h * 64;
                const float ga = bf2f(row[PC_HG + r32]), gb = bf2f(row[PC_HG + 32 + r32]);
                row[PC_HQ + r32] = (bf16_t)f2bf(oacc[0][r] * rstd * g0 * (ga / (1.0f + __expf(-ga))));
                row[PC_HQ + 32 + r32] = (bf16_t)f2bf(oacc[1][r] * rstd * g1 * (gb / (1.0f + __expf(-gb)))); }
        } else if (w < 6) {
            const int kb = (w - 2) >> 1, vb = (w - 2) & 1;
            f32x16 u = (f32x16){0};
#pragma unroll
            for (int s2 = 0; s2 < 4; ++s2) { const LAS unsigned char* ap = lds + O_KE + (16 * s2 + trow) * STT + tcol + kb * 64;
                const LAS unsigned char* bp = lds + O_V + (16 * s2 + trow) * STT + tcol + vb * 64;
                const s16x4 alo = __builtin_bit_cast(s16x4, __builtin_amdgcn_ds_read_tr16_b64_v4i16((LAS s16x4*)ap));
                const s16x4 ahi = __builtin_bit_cast(s16x4, __builtin_amdgcn_ds_read_tr16_b64_v4i16((LAS s16x4*)(ap + 8 * STT)));
                const s16x4 blo = __builtin_bit_cast(s16x4, __builtin_amdgcn_ds_read_tr16_b64_v4i16((LAS s16x4*)bp));
                const s16x4 bhi = __builtin_bit_cast(s16x4, __builtin_amdgcn_ds_read_tr16_b64_v4i16((LAS s16x4*)(bp + 8 * STT)));
                const bf16x8 af = (bf16x8){alo[0], alo[1], alo[2], alo[3], ahi[0], ahi[1], ahi[2], ahi[3]};
                const bf16x8 bf = (bf16x8){blo[0], blo[1], blo[2], blo[3], bhi[0], bhi[1], bhi[2], bhi[3]};
                u = __builtin_amdgcn_mfma_f32_32x32x16_bf16(af, bf, u, 0, 0, 0); }
#pragma unroll
            for (int r = 0; r < 16; ++r) { const int kr = 32 * kb + crow(r, hi); const float dl = *(LAS float*)(lds + O_DL + kr * 4);
                sacc[r] = sacc[r] * dl + u[r];
                *(LAS bf16_t*)(lds + O_S + (sb_cur ^ 1) * 64 * STT + kr * STT + (32 * vb + r32) * 2) = (bf16_t)f2bf(sacc[r]); }
        }
        __syncthreads();
    }
}

using pg8::Unit;
struct SchedB { const char* H; const char* W; int G, c;
    __device__ __forceinline__ bool next(int i, Unit& u) const { const long L = (long)i * G + c; if (L >= 64 * 35) return false; int pm, pn; pg8::tile_order((int)L, 64, 35, pm, pn);
        u.pm = pm; u.pn = pn; u.aux = 0; u.a = H + (size_t)pm * 256 * 2048; u.b0 = W + (size_t)pn * 256 * 2048; u.b1 = u.b0; u.ridx = nullptr; u.nvalid = 256; return true; }
    __device__ __forceinline__ int lda(const Unit&) const { return 2048; } __device__ __forceinline__ int akstep(const Unit&) const { return 128; }
    __device__ __forceinline__ const char* btile(const Unit& u, int t) const { return u.b0 + (size_t)t * 128; } };
struct EpiB { static constexpr bool PERM = true; bf16_t* proj; unsigned char* gate8;
    __device__ __forceinline__ void operator()(const f32x4 (&acc)[2][2][4][2], const Unit& u, int wr, int wc, int fr, int fq) const {
        const int row0 = u.pm * 256 + wr * 64 + fr;
        if (u.pn < 16) {
#pragma unroll
            for (int ai = 0; ai < 2; ++ai)
#pragma unroll
                for (int m = 0; m < 4; ++m) { unsigned char* rp = gate8 + (size_t)(row0 + ai * 128 + m * 16) * NGATE + u.pn * 256 + wc * 32 + 8 * fq;
#pragma unroll
                    for (int bj = 0; bj < 2; ++bj) { const f32x4 v0 = acc[ai][bj][m][0], v1 = acc[ai][bj][m][1]; unsigned q[8];
#pragma unroll
                        for (int i = 0; i < 4; ++i) { q[i] = (unsigned)(fsigmoid(v0[i]) * 255.0f + 0.5f); q[4 + i] = (unsigned)(fsigmoid(v1[i]) * 255.0f + 0.5f); }
                        u32x2 o; o.x = q[0] | (q[1] << 8) | (q[2] << 16) | (q[3] << 24); o.y = q[4] | (q[5] << 8) | (q[6] << 16) | (q[7] << 24);
                        *(u32x2*)(rp + bj * 128) = o; } }
        } else {
#pragma unroll
            for (int ai = 0; ai < 2; ++ai)
#pragma unroll
                for (int m = 0; m < 4; ++m) { bf16_t* rp = proj + (size_t)(row0 + ai * 128 + m * 16) * NPROJ + (u.pn - 16) * 256 + wc * 32 + 8 * fq;
#pragma unroll
                    for (int bj = 0; bj < 2; ++bj) { const f32x4 v0 = acc[ai][bj][m][0], v1 = acc[ai][bj][m][1]; u32x4 o;
                        o.x = pg8::cvt_pk_bf16(v0[0], v0[1]); o.y = pg8::cvt_pk_bf16(v0[2], v0[3]); o.z = pg8::cvt_pk_bf16(v1[0], v1[1]); o.w = pg8::cvt_pk_bf16(v1[2], v1[3]);
                        *(u32x4*)(rp + bj * 128) = o; } }
        }
    } };
struct SchedF { const char* proj; const char* mlaq; const char* W; int G, c;
    __device__ __forceinline__ bool next(int i, Unit& u) const { const long L = (long)(i >> 2) * G + c; if (L >= 256) return false; const int b = i & 3; int pm, pn; pg8::tile_order((int)L, 64, 4, pm, pn);
        u.pm = pm; u.pn = pn; u.aux = b;
        if (b == 1) { u.a = mlaq + (size_t)pm * 256 * 1536; }
        else { const int co = (b == 0) ? PC_HQ : (b == 2 ? PC_DQ : PC_SQ); u.a = proj + (size_t)pm * 256 * (NPROJ * 2) + co * 2; }
        u.b0 = W + (size_t)(b * 1024 + pn * 256) * 1024; u.b1 = u.b0; u.ridx = nullptr; u.nvalid = 256; return true; }
    __device__ __forceinline__ int lda(const Unit& u) const { return u.aux == 1 ? 1536 : NPROJ * 2; } __device__ __forceinline__ int akstep(const Unit& u) const { return u.aux == 1 ? 192 : 128; }
    __device__ __forceinline__ const char* btile(const Unit& u, int t) const { return u.b0 + (size_t)t * 128; } };
struct EpiF { static constexpr bool PERM = true; bf16_t* merged; const unsigned char* gate8;
    __device__ __forceinline__ void operator()(const f32x4 (&acc)[2][2][4][2], const Unit& u, int wr, int wc, int fr, int fq) const {
        const int row0 = u.pm * 256 + wr * 64 + fr, b = u.aux;
        VM_WAIT();
#pragma unroll
        for (int ai = 0; ai < 2; ++ai)
#pragma unroll
            for (int m = 0; m < 4; ++m) { const size_t row = (size_t)(row0 + ai * 128 + m * 16); const int col = u.pn * 256 + wc * 32 + 8 * fq;
#pragma unroll
                for (int bj = 0; bj < 2; ++bj) { const u32x2 g = *(const u32x2*)(gate8 + row * NGATE + b * 1024 + col + bj * 128); bf16_t* mp = merged + row * DM + col + bj * 128;
                    const f32x4 v0 = acc[ai][bj][m][0], v1 = acc[ai][bj][m][1]; float r[8];
                    const float s = 1.0f / 255.0f;
                    r[0] = v0[0] * (float)(g.x & 255u) * s; r[1] = v0[1] * (float)((g.x >> 8) & 255u) * s; r[2] = v0[2] * (float)((g.x >> 16) & 255u) * s; r[3] = v0[3] * (float)(g.x >> 24) * s;
                    r[4] = v1[0] * (float)(g.y & 255u) * s; r[5] = v1[1] * (float)((g.y >> 8) & 255u) * s; r[6] = v1[2] * (float)((g.y >> 16) & 255u) * s; r[7] = v1[3] * (float)(g.y >> 24) * s;
                    if (b > 0) { const u32x4 old = *(const u32x4*)mp; r[0] += bflo(old.x); r[1] += bfhi(old.x); r[2] += bflo(old.y); r[3] += bfhi(old.y); r[4] += bflo(old.z); r[5] += bfhi(old.z); r[6] += bflo(old.w); r[7] += bfhi(old.w); }
                    u32x4 o; o.x = pg8::cvt_pk_bf16(r[0], r[1]); o.y = pg8::cvt_pk_bf16(r[2], r[3]); o.z = pg8::cvt_pk_bf16(r[4], r[5]); o.w = pg8::cvt_pk_bf16(r[6], r[7]);
                    *(u32x4*)mp = o; } }
    } };
struct SchedG { const char* Am; const char* W; int G, c;
    __device__ __forceinline__ bool next(int i, Unit& u) const { const long L = (long)i * G + c; if (L >= 256) return false; int pm, pn; pg8::tile_order((int)L, 64, 4, pm, pn);
        u.pm = pm; u.pn = pn; u.aux = 0; u.a = Am + (size_t)pm * 256 * 2048; u.b0 = W + (size_t)pn * 256 * 2048; u.b1 = u.b0; u.ridx = nullptr; u.nvalid = 256; return true; }
    __device__ __forceinline__ int lda(const Unit&) const { return 2048; } __device__ __forceinline__ int akstep(const Unit&) const { return 128; }
    __device__ __forceinline__ const char* btile(const Unit& u, int t) const { return u.b0 + (size_t)t * 128; } };
struct EpiG { static constexpr bool PERM = false; const float* xin; float* out; const float* gt;
    __device__ __forceinline__ void operator()(const f32x4 (&acc)[2][2][4][2], const Unit& u, int wr, int wc, int fr, int fq) const {
        const int row0 = u.pm * 256 + wr * 64 + fr, col0 = u.pn * 256 + wc * 32 + 4 * fq; const int b = (u.pm * 256) >> 11;
#pragma unroll
        for (int ai = 0; ai < 2; ++ai)
#pragma unroll
            for (int m = 0; m < 4; ++m) { const size_t off = (size_t)(row0 + ai * 128 + m * 16) * DM + col0;
#pragma unroll
                for (int bj = 0; bj < 2; ++bj)
#pragma unroll
                    for (int n = 0; n < 2; ++n) { const f32x4 g = *(const f32x4*)(gt + b * 6144 + col0 + bj * 128 + n * 16); const f32x4 xv = *(const f32x4*)(xin + off + bj * 128 + n * 16);
                        *(f32x4*)(out + off + bj * 128 + n * 16) = xv + g * acc[ai][bj][m][n]; } }
    } };
struct MoeSched { volatile LAS unsigned* ms; const int* list;
    __device__ __forceinline__ int rd(int i) const { return __builtin_amdgcn_readfirstlane((int)ms[i]); }
    __device__ __forceinline__ bool tile(int tau, int& pair, int& j0, int& nval) const { const int T = rd(64 + 24); if (tau >= T) return false; int p = 0;
        for (int q = 1; q < 24; ++q) if (rd(64 + q) <= tau) p = q;
        pair = p; j0 = (tau - rd(64 + p)) * 256; const int rem = rd(32 + p) - j0; nval = rem < 256 ? rem : 256; return true; } };
__device__ __forceinline__ void moe_sched_setup(const Frame& F0, int l) {
    const Args A = load_args(); const Frame F = fresh(F0);
    const unsigned* cnt = (const unsigned*)(A.ws + WS_CTL) + CW_CNT + 64 * l;
    if (F.tid < 24) F.MISC[32 + F.tid] = __hip_atomic_load(cnt + F.tid, RLX_AGENT);
    __syncthreads();
    if (F.tid == 0) { unsigned pre = 0; for (int p = 0; p < 24; ++p) { F.MISC[64 + p] = pre; pre += (F.MISC[32 + p] + 255u) >> 8; } F.MISC[64 + 24] = pre; }
    __syncthreads();
}
struct SchedI { MoeSched ms; const char* H2; const char* GUT; int G, c;
    __device__ __forceinline__ bool next(int i, Unit& u) const { const long L = (long)i * G + c; const int tau = (int)(L >> 2), pn = (int)(L & 3); int pair, j0, nval; if (!ms.tile(tau, pair, j0, nval)) return false;
        int ea, eb; pair_experts(pair, ea, eb); const int e = pn < 2 ? ea : eb;
        u.pm = tau; u.pn = pn; u.aux = pair; u.a = H2; u.b0 = GUT + (size_t)(e * 512 + (pn & 1) * 256) * 2048; u.b1 = u.b0;
        u.ridx = ms.list + pair * 16384 + j0; u.nvalid = nval; return true; }
    __device__ __forceinline__ int lda(const Unit&) const { return 2048; } __device__ __forceinline__ int akstep(const Unit&) const { return 128; }
    __device__ __forceinline__ const char* btile(const Unit& u, int t) const { return u.b0 + (size_t)t * 128; } };
struct EpiI { static constexpr bool PERM = true; bf16_t* hid; const float* tokw;
    __device__ __forceinline__ void operator()(const f32x4 (&acc)[2][2][4][2], const Unit& u, int wr, int wc, int fr, int fq) const {
        const int wsel = u.pn >> 1;
#pragma unroll
        for (int ai = 0; ai < 2; ++ai)
#pragma unroll
            for (int m = 0; m < 4; ++m) { const int r = ai * 128 + wr * 64 + m * 16 + fr; float wgt = 0.f; if (r < u.nvalid) wgt = tokw[2 * u.ridx[r] + wsel];
                const f32x4 g0 = acc[ai][0][m][0], g1 = acc[ai][0][m][1], u0 = acc[ai][1][m][0], u1 = acc[ai][1][m][1]; float v[8];
#pragma unroll
                for (int i = 0; i < 4; ++i) { v[i] = fsilu(g0[i]) * u0[i] * wgt; v[4 + i] = fsilu(g1[i]) * u1[i] * wgt; }
                u32x4 o; o.x = pg8::cvt_pk_bf16(v[0], v[1]); o.y = pg8::cvt_pk_bf16(v[2], v[3]); o.z = pg8::cvt_pk_bf16(v[4], v[5]); o.w = pg8::cvt_pk_bf16(v[6], v[7]);
                *(u32x4*)(hid + (size_t)(u.pm * 256 + r) * 512 + u.pn * 128 + wc * 32 + 8 * fq) = o; }
    } };
struct SchedJ { MoeSched ms; const char* HID; const char* DT; int G, c;
    __device__ __forceinline__ bool next(int i, Unit& u) const { const long L = (long)i * G + c; const int tau = (int)(L >> 2), pn = (int)(L & 3); int pair, j0, nval; if (!ms.tile(tau, pair, j0, nval)) return false;
        int ea, eb; pair_experts(pair, ea, eb);
        u.pm = tau; u.pn = pn; u.a = HID + (size_t)tau * 256 * 1024;
        u.b0 = DT + (size_t)(ea * 1024 + pn * 256) * 512; u.b1 = DT + (size_t)(eb * 1024 + pn * 256) * 512; u.ridx = nullptr; u.nvalid = nval; u.aux = j0 + pair * 16384; return true; }
    __device__ __forceinline__ int lda(const Unit&) const { return 1024; } __device__ __forceinline__ int akstep(const Unit&) const { return 128; }
    __device__ __forceinline__ const char* btile(const Unit& u, int t) const { return t < 4 ? u.b0 + (size_t)t * 128 : u.b1 + (size_t)(t - 4) * 128; } };
struct EpiJ { static constexpr bool PERM = false; float* out; const float* gt; const int* list;
    __device__ __forceinline__ void operator()(const f32x4 (&acc)[2][2][4][2], const Unit& u, int wr, int wc, int fr, int fq) const {
        const int col0 = u.pn * 256 + wc * 32 + 4 * fq;
#pragma unroll
        for (int ai = 0; ai < 2; ++ai)
#pragma unroll
            for (int m = 0; m < 4; ++m) { const int r = ai * 128 + wr * 64 + m * 16 + fr;
                if (r < u.nvalid) { const int tok = list[u.aux + r]; const int b = tok >> 11; const size_t off = (size_t)tok * DM + col0;
#pragma unroll
                    for (int bj = 0; bj < 2; ++bj)
#pragma unroll
                        for (int n = 0; n < 2; ++n) { const f32x4 g = *(const f32x4*)(gt + b * 6144 + col0 + bj * 128 + n * 16); const f32x4 xv = *(const f32x4*)(out + off + bj * 128 + n * 16);
                            *(f32x4*)(out + off + bj * 128 + n * 16) = xv + g * acc[ai][bj][m][n]; } } }
    } };

__global__ void __launch_bounds__(512, 2) mk_fwd(Args Akern) {
    extern __shared__ __attribute__((aligned(16))) unsigned char lds_raw[];
    Frame F;
    F.lds = (LAS unsigned char*)lds_raw; F.ldsg = lds_raw;
    F.MISC = (volatile LAS unsigned*)(F.lds + MISC_OFF);
    F.tid = threadIdx.x; F.lane = F.tid & 63; F.wave = __builtin_amdgcn_readfirstlane(F.tid >> 6);
    F.G = gridDim.x; { const int bx = blockIdx.x; F.vcu = (F.G % 8 == 0) ? (bx % 8) * (F.G / 8) + bx / 8 : bx; }
    for (int u = F.tid; u < 256; u += 512) F.MISC[u] = 0u;
    __syncthreads();
    int lo, hi;
    XcdBarrier bar;
    { const Args A = load_args(); lo = A.ph_lo; hi = A.ph_hi; F.ctl = (gu32*)(A.ws + WS_CTL);
      bar.bar = (unsigned*)(A.ws + WS_CTL) + CW_BAR; bar.x = 0; bar.st = nullptr;
      if (!MK_PER_PHASE) bar = xcd_barrier_post((unsigned*)(A.ws + WS_CTL) + CW_BAR, F.MISC + 8); }
#define GRID_BAR() do { if (!MK_PER_PHASE) xcd_barrier(bar); } while (0)
#pragma unroll 1
    for (int ph = lo; ph < hi; ++ph) {
        if (ph == 0) { if (PH_ON(9)) {
            conv_layer_main(F, 0);
            __syncthreads();
            p0_mod_rope(F); }
        } else {
            const int l = (ph - 1) / 9, sp = (ph - 1) % 9;
            if (sp == 0) { if (PH_ON(0))
                phase_norm1(F, l);
            } else if (sp == 1) { if (PH_ON(1)) {
                const Args A = load_args(); const char* wsb = (const char*)A.ws;
                SchedB S{wsb + WS_H, wsb + WS_WINT, F.G, (int)blockIdx.x}; EpiB E{(bf16_t*)(A.ws + WS_PROJ), A.ws + WS_GATE8};
                pg8::gemm_phase<false>(F.lds, 16, 2048, S, E); }
            } else if (sp == 2) { if (PH_ON(2))
                for (int u = F.vcu; u < M / 64; u += F.G) mla_prep_unit(F, l, u);
            } else if (sp == 3) { if (PH_ON(3)) {
                unsigned* qctr = (unsigned*)F.ctl + CW_QUEUE + 64 * l;
#define QNEXT(ctr) ({ if (F.tid == 0) F.MISC[16] = atomicAdd((ctr), 1u); __syncthreads(); const int u_ = __builtin_amdgcn_readfirstlane((int)F.MISC[16]); __syncthreads(); u_; })
                if (UNIT_ON(0)) for (;;) { const int u = QNEXT(qctr + 0); if (u >= 64) break; hgrn_unit(F, l, u >> 3, u & 7); }
                if (UNIT_ON(1)) for (;;) { const int u = QNEXT(qctr + 1); if (u >= 512) break; const int qb = 15 - (u >> 5), bh = u & 31; diff_attn_unit(F, l, bh >> 2, bh & 3, qb); }
                if (UNIT_ON(2)) for (;;) { const int u = QNEXT(qctr + 2); if (u >= 512) break; const int qb = 7 - (u >> 6), bh = u & 63; mla_attn_unit(F, bh >> 3, bh & 7, qb); }
                if (UNIT_ON(3)) for (;;) { const int u = QNEXT(qctr + 3); if (u >= 512) break; const int rb64 = u & 31, bk = u >> 5; swa_attn_unit(F, l, bk >> 1, bk & 1, rb64); }
#undef QNEXT
                }
            } else if (sp == 4) { if (PH_ON(4)) {
                const Args A = load_args(); const char* wsb = (const char*)A.ws;
                SchedF S{wsb + WS_PROJ, wsb + WS_MLAQ, wsb + WS_BRT, F.G, (int)blockIdx.x}; EpiF E{(bf16_t*)(A.ws + WS_MERGED), A.ws + WS_GATE8};
                pg8::gemm_phase<false>(F.lds, 8, 1024, S, E); }
            } else if (sp == 5) { if (PH_ON(5)) {
                const Args A = load_args(); const char* wsb = (const char*)A.ws; const float* mod = (const float*)(A.ws + WS_MOD) + (size_t)l * 8 * 6144;
                SchedG S{wsb + WS_MERGED, wsb + WS_OUTT, F.G, (int)blockIdx.x}; EpiG E{(l == 0) ? A.x : A.out, A.out, mod + 2048};
                pg8::gemm_phase<false>(F.lds, 16, 2048, S, E); }
            } else if (sp == 6) { if (PH_ON(6)) {
                phase_norm2_router(F, l);
                conv_layer_moe(F, l);
                if (l + 1 < DEPTH) conv_layer_main(F, l + 1); }
            } else if (sp == 7) { if (PH_ON(7)) {
                moe_sched_setup(F, l);
                const Args A = load_args(); const char* wsb = (const char*)A.ws;
                SchedI S{{F.MISC, (const int*)(A.ws + WS_LIST)}, wsb + WS_H, wsb + WS_GUT, F.G, (int)blockIdx.x}; EpiI E{(bf16_t*)(A.ws + WS_HID), (const float*)(A.ws + WS_TOKW)};
                pg8::gemm_phase<true>(F.lds, 16, 2048, S, E); }
            } else { if (PH_ON(8)) {
                moe_sched_setup(F, l);
                const Args A = load_args(); const char* wsb = (const char*)A.ws; const float* mod = (const float*)(A.ws + WS_MOD) + (size_t)l * 8 * 6144;
                SchedJ S{{F.MISC, (const int*)(A.ws + WS_LIST)}, wsb + WS_HID, wsb + WS_DT, F.G, (int)blockIdx.x}; EpiJ E{A.out, mod + 5120, (const int*)(A.ws + WS_LIST)};
                pg8::gemm_phase<false>(F.lds, 8, 512, S, E); }
            }
        }
        if (ph + 1 < hi) GRID_BAR();
    }
}

extern "C" void kernel_launch(void* const* d_in, const int* in_sizes, int n_in, void* d_out, int out_size, void* d_ws, size_t ws_size, hipStream_t stream) {
    static int grid = 0;
    if (grid == 0) {
        if (n_in != 27 || in_sizes[0] != M * DM || out_size != M * DM || ws_size < WS_END) {
            fprintf(stderr, "kernel_launch: unexpected problem (n_in %d, in0 %d, out %d, ws %zu < %zu); nothing launched\n", n_in, n_in > 0 ? in_sizes[0] : -1, out_size, ws_size, (size_t)WS_END); grid = -1; return; }
        int dev = 0, cus = 0, per_cu = 0;
        if (hipGetDevice(&dev) != hipSuccess || hipDeviceGetAttribute(&cus, hipDeviceAttributeMultiprocessorCount, dev) != hipSuccess) { grid = -1; return; }
        if (hipFuncSetAttribute((const void*)mk_fwd, hipFuncAttributeMaxDynamicSharedMemorySize, LDS_BYTES) != hipSuccess) { fprintf(stderr, "kernel_launch: hipFuncSetAttribute failed\n"); grid = -1; return; }
        if (hipOccupancyMaxActiveBlocksPerMultiprocessor(&per_cu, (const void*)mk_fwd, 512, LDS_BYTES) != hipSuccess || per_cu < 1) { fprintf(stderr, "kernel_launch: occupancy query says %d blocks/CU\n", per_cu); per_cu = 1; }
        (void)hipGetLastError();
        grid = cus;
    }
    if (grid < 0) return;
    (void)hipMemsetAsync((char*)d_ws + WS_CTL, 0, CTL_ZERO_BYTES, stream);
    Args a{};
    a.x = (const float*)d_in[0]; a.c = (const float*)d_in[1]; a.pos = (const int*)d_in[2]; a.ada_w = (const float*)d_in[3]; a.ada_b = (const float*)d_in[4];
    a.norm_mix = (const float*)d_in[5]; a.norm_ffn = (const float*)d_in[6]; a.w_in = (const float*)d_in[7]; a.hg_lb = (const float*)d_in[8]; a.hg_onorm = (const float*)d_in[9];
    a.mla_q_norm = (const float*)d_in[10]; a.mla_kv_norm = (const float*)d_in[11]; a.mla_w_uq = (const float*)d_in[12]; a.mla_w_ukv = (const float*)d_in[13];
    a.mla_qk_norm = (const float*)d_in[14]; a.diff_qk_norm = (const float*)d_in[15]; a.diff_lam = (const float*)d_in[16]; a.diff_onorm = (const float*)d_in[17];
    a.swa_qk_norm = (const float*)d_in[18]; a.swa_sinks = (const float*)d_in[19]; a.w_branch = (const float*)d_in[20]; a.w_out = (const float*)d_in[21];
    a.router_w = (const float*)d_in[22]; a.router_bias = (const float*)d_in[23]; a.moe_w_gate = (const float*)d_in[24]; a.moe_w_up = (const float*)d_in[25]; a.moe_w_down = (const float*)d_in[26];
    a.out = (float*)d_out; a.ws = (unsigned char*)d_ws;
#if MK_PER_PHASE
    for (int ph = 0; ph < NPHASE; ++ph) { a.ph_lo = ph; a.ph_hi = ph + 1; hipLaunchKernelGGL(mk_fwd, dim3(grid), dim3(512), LDS_BYTES, stream, a); }
#else
    a.ph_lo = 0; a.ph_hi = NPHASE;
    void* kargs[] = {&a};
    hipError_t e = hipLaunchCooperativeKernel((const void*)mk_fwd, dim3(grid), dim3(512), kargs, LDS_BYTES, stream);
    if (e != hipSuccess) fprintf(stderr, "kernel_launch: cooperative launch failed: %s (grid %d)\n", hipGetErrorString(e), grid);
#endif
}
```

```cpp
#include <hip/hip_runtime.h>
#include <hip/hip_bf16.h>
#include <cstdio>
#include <cstdint>

#ifndef MK_PER_PHASE
#define MK_PER_PHASE 0
#endif

#ifndef PHASE_MASK
#define PHASE_MASK 0x3ff
#endif
#define PH_ON(k) ((PHASE_MASK >> (k)) & 1)
#ifndef REP_MASK
#define REP_MASK 0
#endif
#ifndef REP_N
#define REP_N 1
#endif
#ifndef EXTRA_BARS
#define EXTRA_BARS 0
#endif
#ifndef EPIF_FENCE
#define EPIF_FENCE 0
#endif
#ifndef DIFF_VPRE
#define DIFF_VPRE 2
#endif
#ifndef PROBE_MLAPREP
#define PROBE_MLAPREP 0
#endif
#ifndef DRY_MASK
#define DRY_MASK 0
#endif
#ifndef STAMP_MODE
#define STAMP_MODE 0
#endif
#ifndef STAMP_C
#define STAMP_C 1.2e-4f
#endif
#ifndef STAMP_LO
#define STAMP_LO 0
#endif
#ifndef STAMP_HI
#define STAMP_HI 17
#endif
#ifndef DRY_ALT
#define DRY_ALT 99
#endif
#ifndef DRY_LAYERS
#define DRY_LAYERS 3
#endif
#ifndef DRY_REPS
#define DRY_REPS 1
#endif
#ifndef UNIT_MASK
#define UNIT_MASK 15
#endif
#define UNIT_ON(k) ((UNIT_MASK >> (k)) & 1)
#define LAS __attribute__((address_space(3)))
#define GAS __attribute__((address_space(1)))
typedef unsigned short bf16_t;
typedef short bf16x8 __attribute__((ext_vector_type(8)));
typedef short s16x4 __attribute__((ext_vector_type(4)));
typedef float f32x4 __attribute__((ext_vector_type(4)));
typedef float f32x16 __attribute__((ext_vector_type(16)));
typedef unsigned u32x4 __attribute__((ext_vector_type(4)));
typedef unsigned u32x2 __attribute__((ext_vector_type(2)));
typedef int i32x4 __attribute__((ext_vector_type(4)));
typedef int i32x8 __attribute__((ext_vector_type(8)));
typedef GAS unsigned gu32;

constexpr int NB = 8, SEQ = 2048, DM = 1024, M = NB * SEQ, DEPTH = 2;
constexpr int NPROJ = 4864;
constexpr int NGATE = 4096;
constexpr int NBIG = NGATE + NPROJ;
constexpr int W_IN_COLS = 8864;
constexpr int PC_HQ = 0, PC_HF = 512, PC_HI = 1024, PC_HG = 1536, PC_CQ = 2048, PC_CKV = 2304, PC_KR = 2432,
              PC_DQ = 2464, PC_DK = 2976, PC_DV = 3488, PC_SQ = 4000, PC_SK = 4512, PC_SV = 4640;
constexpr float EPS = 1e-6f;
constexpr float LOG2E = 1.4426950408889634f;

constexpr size_t MiB = 1u << 20;
constexpr size_t WS_CTL = 0, CTL_ZERO_BYTES = 64 * 1024;
constexpr size_t WS_MOD = 1 * MiB;
constexpr size_t WS_ROPE = 2 * MiB;
constexpr size_t WS_LIST = 4 * MiB;
constexpr size_t WS_TOKW = 6 * MiB;
constexpr size_t WS_UQT = 8 * MiB;
constexpr size_t WS_UKVT = 8 * MiB + 512 * 1024;
constexpr size_t WS_BRT = 9 * MiB;
constexpr size_t WS_OUTT = 13 * MiB;
constexpr size_t WS_PROJ = 16 * MiB;
constexpr size_t WS_GUT = 16 * MiB;
constexpr size_t WS_DT = 32 * MiB;
constexpr size_t WS_HID = 40 * MiB;
constexpr size_t WS_GATE8 = 168 * MiB;
constexpr size_t WS_X = 232 * MiB;
constexpr size_t WS_H = WS_X;
constexpr size_t WS_WINT = WS_X + 32 * MiB;
constexpr size_t WS_MLAQ = WS_X;
constexpr size_t WS_MLAK = WS_X + 24 * MiB;
constexpr size_t WS_MLAV = WS_X + 48 * MiB;
constexpr size_t WS_MERGED = WS_X + 24 * MiB;
constexpr size_t WS_END = 296 * MiB;
constexpr int HID_ROWS = 22528;

constexpr int CW_BAR = 4096;
constexpr int CW_QUEUE = 8192;
constexpr int CW_CNT = 8448;
constexpr int PPL = 8;
constexpr int NPHASE = 1 + PPL * DEPTH;

constexpr int RING_BYTES = 131072;
constexpr int MISC_OFF = RING_BYTES;
constexpr int LDS_BYTES = 147456;

#define LDS_WAIT() asm volatile("s_waitcnt lgkmcnt(0)" ::: "memory")
#define VM_WAIT() asm volatile("s_waitcnt vmcnt(0)" ::: "memory")
#define RLX_AGENT __ATOMIC_RELAXED, __HIP_MEMORY_SCOPE_AGENT
__device__ __forceinline__ unsigned f2bf(float f) { unsigned u = __builtin_bit_cast(unsigned, f); return (u + 0x7fffu + ((u >> 16) & 1u)) >> 16; }
typedef float f32x2_t __attribute__((ext_vector_type(2))); typedef __bf16 bf16x2_t __attribute__((ext_vector_type(2)));
__device__ __forceinline__ unsigned pk4f8(float a, float b, float c, float d) { int w = 0; w = __builtin_amdgcn_cvt_pk_fp8_f32(a, b, w, false); w = __builtin_amdgcn_cvt_pk_fp8_f32(c, d, w, true); return (unsigned)w; }
__device__ __forceinline__ unsigned pk2(float lo, float hi) { f32x2_t v = {lo, hi}; bf16x2_t b = __builtin_convertvector(v, bf16x2_t); return __builtin_bit_cast(unsigned, b); }
__device__ __forceinline__ float bf2f(unsigned short b) { return __builtin_bit_cast(float, (unsigned)b << 16); }
__device__ __forceinline__ float bflo(unsigned w) { return __builtin_bit_cast(float, w << 16); }
__device__ __forceinline__ float bfhi(unsigned w) { return __builtin_bit_cast(float, w & 0xffff0000u); }
__device__ __forceinline__ float fsigmoid(float x) { return __builtin_amdgcn_rcpf(1.0f + __expf(-x)); }
__device__ __forceinline__ float fsilu(float x) { return x * __builtin_amdgcn_rcpf(1.0f + __expf(-x)); }
__device__ __forceinline__ int crow(int r, int hi) { return (r & 3) + 8 * (r >> 2) + 4 * hi; }
__device__ __forceinline__ float shx(float v, int m, int lane) { return __builtin_bit_cast(float, __builtin_amdgcn_ds_bpermute((lane ^ m) << 2, __builtin_bit_cast(int, v))); }
__device__ __forceinline__ float dpp_f(float v, int ctrl_sel) {
    const int x = __builtin_bit_cast(int, v); int r;
    if (ctrl_sel == 0) r = __builtin_amdgcn_mov_dpp(x, 0xB1, 0xf, 0xf, true);
    else if (ctrl_sel == 1) r = __builtin_amdgcn_mov_dpp(x, 0x4E, 0xf, 0xf, true);
    else r = __builtin_amdgcn_mov_dpp(x, 0x141, 0xf, 0xf, true);
    return __builtin_bit_cast(float, r); }
__device__ __forceinline__ float sum8(float v) { v += dpp_f(v, 0); v += dpp_f(v, 1); v += dpp_f(v, 2); return v; }
__device__ __forceinline__ float sum32(float v, int lane) { v = sum8(v); v += __builtin_bit_cast(float, __builtin_amdgcn_mov_dpp(__builtin_bit_cast(int, v), 0x140, 0xf, 0xf, true)); v += shx(v, 16, lane); return v; }
__device__ __forceinline__ float wave_sum(float v, int lane) {
    v = sum8(v); v += __builtin_bit_cast(float, __builtin_amdgcn_mov_dpp(__builtin_bit_cast(int, v), 0x140, 0xf, 0xf, true));
    v += shx(v, 16, lane); v += shx(v, 32, lane);
    return v;
}

#define XB_TMO      128
#define XB_XCNT(j)  (256  + 64 * (j))
#define XB_XSUB(j)  (1280 + 64 * (j))
#define XB_XGEN(j)  (2304 + 64 * (j))
#define XB_TOP      3328
#define XB_TOPGEN   3392
#define XCD_BAR_WORDS 3456
#define XB_SPIN_CAP (1u << 22)
__device__ __forceinline__ unsigned xb_ld(unsigned* p)              { return __hip_atomic_load(p, __ATOMIC_RELAXED, __HIP_MEMORY_SCOPE_AGENT); }
__device__ __forceinline__ unsigned xb_add(unsigned* p, unsigned v) { return __hip_atomic_fetch_add(p, v, __ATOMIC_RELAXED, __HIP_MEMORY_SCOPE_AGENT); }
__device__ __forceinline__ unsigned xb_xcc_id() { return (unsigned)__builtin_amdgcn_s_getreg((3 << 11) | 20) & 0xFu; }
#define XB_SPIN(cond, bar) do { unsigned _sp = 0; while (cond) { __builtin_amdgcn_s_sleep(1); \
    if ((++_sp & 255u) == 0u) { if (xb_ld(&(bar)[XB_TMO])) break; if (_sp > XB_SPIN_CAP) { atomicAdd(&(bar)[XB_TMO], 1u); break; } } } } while (0)
struct XcdBarrier { unsigned* bar; unsigned x; volatile LAS unsigned* st; };
__device__ __forceinline__ XcdBarrier xcd_barrier_post(unsigned* bar, volatile LAS unsigned* st) {
    XcdBarrier b; b.bar = bar; b.x = xb_xcc_id(); b.st = st;
    if (threadIdx.x == 0) (void)xb_add(&bar[XB_XCNT(b.x)], 1u);
    return b;
}
__device__ __forceinline__ void xcd_barrier_complete(unsigned* bar, unsigned x, unsigned& nloc, unsigned& nx) {
    const unsigned G = gridDim.x * gridDim.y * gridDim.z;
    unsigned sum, cnt, mine, sp = 0u;
    for (;;) {
        sum = 0u; cnt = 0u; mine = 0u;
#pragma unroll
        for (unsigned j = 0; j < 16; ++j) { const unsigned c = xb_ld(&bar[XB_XCNT(j)]); sum += c; cnt += (c > 0u) ? 1u : 0u; mine = (j == x) ? c : mine; }
        if (sum == G) break;
        __builtin_amdgcn_s_sleep(1);
        if ((++sp & 255u) == 0u) { if (xb_ld(&bar[XB_TMO])) break; if (sp > XB_SPIN_CAP) { atomicAdd(&bar[XB_TMO], 1u); break; } }
    }
    nloc = mine > 0u ? mine : 1u; nx = cnt > 0u ? cnt : 1u;
}
__device__ __forceinline__ void xcd_barrier(const XcdBarrier& b) {
    asm volatile("s_waitcnt vmcnt(0)" ::: "memory");
    __syncthreads();
    if (threadIdx.x == 0) {
        unsigned* bar = b.bar;
        __builtin_amdgcn_s_waitcnt(0);
        unsigned nloc = b.st[0], nx = b.st[1];
        if (nloc == 0u) { xcd_barrier_complete(bar, b.x, nloc, nx); b.st[0] = nloc; b.st[1] = nx; }
        const unsigned old = xb_add(&bar[XB_XSUB(b.x)], 1u);
        const unsigned gen = old / nloc;
        if (old + 1u == (gen + 1u) * nloc) {
            __builtin_amdgcn_fence(__ATOMIC_RELEASE, "agent");
            asm volatile("s_waitcnt vmcnt(0)" ::: "memory");
            const unsigned og = xb_add(&bar[XB_TOP], 1u);
            const unsigned tg = og / nx;
            if (og + 1u == (tg + 1u) * nx) xb_add(&bar[XB_TOPGEN], 1u);
            else XB_SPIN(xb_ld(&bar[XB_TOPGEN]) == tg, bar);
            __builtin_amdgcn_fence(__ATOMIC_ACQUIRE, "agent");
            xb_add(&bar[XB_XGEN(b.x)], 1u);
            asm volatile("s_waitcnt vmcnt(0)" ::: "memory");
        } else {
            XB_SPIN(xb_ld(&bar[XB_XGEN(b.x)]) == gen, bar);
            __builtin_amdgcn_fence(__ATOMIC_ACQUIRE, "agent");
            asm volatile("s_waitcnt vmcnt(0)" ::: "memory");
        }
    }
    __syncthreads();
}

constexpr float M8_SCALE = 8.0f;
constexpr float Y8_SCALE = 16.0f;
constexpr float HID8_SCALE = 8.0f;
constexpr float W8_SCALE = 32.0f, W8_INV = 1.0f / 32.0f;
namespace pg8 {
constexpr int BM = 256, BK = 64, HALF = 128, HTB = HALF * BK * 2, NXCD = 8, WGM = 8;
__host__ __device__ __forceinline__ int lds_byte(int r, int c) { const int st = (r >> 4) * 2 + (c >> 5), rr = r & 15, cc = c & 31, ob = rr * 64 + cc * 2; return st * 1024 + (ob ^ (((ob >> 9) & 1) << 5)); }
__host__ __device__ __forceinline__ void stage_rc(int b, int& R, int& C) { const int st = b / 1024, sb = b % 1024, swz = sb ^ (((sb >> 9) & 1) << 5); R = (st >> 1) * 16 + swz / 64; C = (st & 1) * 32 + (swz % 64) / 2; }
__host__ __device__ __forceinline__ int perm32(int rho) { const int n = rho >> 4, i = rho & 15; return 8 * (i >> 2) + 4 * n + (i & 3); }

struct Unit {
    int pm, pn, aux, kind;
    unsigned a;
    unsigned b0, b1;
    unsigned ridx;
    int nvalid;
};
__device__ __forceinline__ void tile_order(int wgid, int nM, int nN, int& pm, int& pn) {
    const int nwg = nM * nN;
    { const int q = nwg / NXCD, r = nwg % NXCD, xcd = wgid % NXCD, off = wgid / NXCD; wgid = (xcd < r ? xcd * (q + 1) : r * (q + 1) + (xcd - r) * q) + off; }
    const int nig = WGM * nN, gid = wgid / nig, fm = gid * WGM, gsz = (nM - fm) < WGM ? (nM - fm) : WGM;
    pm = fm + ((wgid % nig) % gsz); pn = (wgid % nig) / gsz;
}
__device__ __forceinline__ unsigned cvt_pk_bf16(float lo, float hi) { unsigned r; asm volatile("v_cvt_pk_bf16_f32 %0, %1, %2" : "=v"(r) : "v"(lo), "v"(hi)); return r; }

template <bool M, class S> __device__ __forceinline__ int mg_nt(const S& s, const Unit& u, int d) { if constexpr (M) return s.nt(u); else return d; }
template <bool M, class S> __device__ __forceinline__ int mg_ldb(const S& s, const Unit& u, int d) { if constexpr (M) return s.ldb(u); else return d; }
template <bool M, class S> __device__ __forceinline__ bool mg_perm(const S& s, const Unit& u, bool d) { if constexpr (M) return s.perm(u); else return d; }
template <bool M, class S> __device__ __forceinline__ bool mg_dep(const S& s, const Unit& u) { if constexpr (M) return s.dep(u); else return false; }
template <bool M, class S> __device__ __forceinline__ void mg_ready(const S& s, const Unit& u) { if constexpr (M) s.a_ready(u); }
template <bool M, class S> __device__ __forceinline__ void mg_done(const S& s, const Unit& u, int wid, int lane) { if constexpr (M) s.done(u, wid, lane); }
template <class S> __device__ __forceinline__ unsigned ga_tile(const S& s, const Unit& u, int k) { if constexpr (S::ABLK) return s.atile(u, k); else return u.a + (unsigned)k * s.akstep(u); }
template <class S> __device__ __forceinline__ unsigned ga_voff(const S& s, const Unit& u, int R, int C) { if constexpr (S::ABLK) return s.voffa(u, R, C); else return (unsigned)(R * s.lda(u) + C * 2); }
template <class S> __device__ __forceinline__ unsigned ga_hs(const S& s, const Unit& u) { if constexpr (S::ABLK) return s.hs(u); else return (unsigned)HALF * (unsigned)s.lda(u); }
template <bool GATHER, bool MERGED, bool F8, class Epi, class Sched>
__device__ __forceinline__ void gemm_phase(LAS unsigned char* lds, const char* wsb, const int nt_, const int ldb_  , const Sched& S, const Epi& E) {
    int tid = threadIdx.x; asm volatile("" : "+v"(tid));
    const int wid = __builtin_amdgcn_readfirstlane(tid >> 6), lane = tid & 63, wr = wid >> 2, wc = wid & 3, fr = lane & 15, fq = lane >> 4;
    unsigned vB[2], vBn[2];
#define PG8_NT(u) mg_nt<MERGED>(S, u, nt_)
#define PG8_LDB(u_) mg_ldb<MERGED>(S, u_, ldb_)
#define PG8_VOFFB(u, v) do { int t4_ = threadIdx.x; asm volatile("" : "+v"(t4_)); _Pragma("unroll") for (int i_ = 0; i_ < 2; ++i_) { int R_, C_; stage_rc(t4_ * 16 + i_ * 8192, R_, C_); \
        const bool pm_ = mg_perm<MERGED>(S, u, Epi::PERM); const int Rb_ = pm_ ? ((R_ & ~31) + perm32(R_ & 31)) : R_; v[i_] = (unsigned)(Rb_ * PG8_LDB(u) + C_ * 2); } } while (0)
    const unsigned ldsw = (unsigned)wid * 1024u;
    const int aoff = lds_byte(wr * 64 + fr, fq * 8), boff = lds_byte(wc * 32 + fr, fq * 8);
#define PG8_SA(b, h) (((b) * 2 + (h)) * HTB)
#define PG8_SB(b, h) ((4 + (b) * 2 + (h)) * HTB)
#define PG8_GLDS(bufoff, gptr, i_) __builtin_amdgcn_global_load_lds((const unsigned*)(gptr), (LAS unsigned*)(lds + (bufoff) + ldsw + (i_) * 8192), 16, 0, 0)
#define PG8_STAGE_B(bufoff, goff, w0, w1) do { PG8_GLDS(bufoff, wsb + (size_t)(unsigned)((goff) + (w0)), 0); PG8_GLDS(bufoff, wsb + (size_t)(unsigned)((goff) + (w1)), 1); } while (0)
#define PG8_STAGE_A(bufoff, goff, v0, v1) do { PG8_GLDS(bufoff, wsb + (size_t)(unsigned)((goff) + (v0)), 0); PG8_GLDS(bufoff, wsb + (size_t)(unsigned)((goff) + (v1)), 1); } while (0)
#define PG8_LDA(dst, b, h) do { if constexpr (F8) { _Pragma("unroll") for (int m = 0; m < 4; ++m) { const LAS i32x4* p_ = (const LAS i32x4*)(lds + PG8_SA(b, h) + aoff + m * 2048); dst##8[m].lo = p_[0]; dst##8[m].hi = p_[64]; } } \
        else { _Pragma("unroll") for (int m = 0; m < 4; ++m) _Pragma("unroll") for (int k = 0; k < 2; ++k) dst[m][k] = *(const LAS bf16x8*)(lds + PG8_SA(b, h) + aoff + m * 2048 + k * 1024); } } while (0)
#define PG8_LDBF(dst, b, h) do { if constexpr (F8) { _Pragma("unroll") for (int n = 0; n < 2; ++n) { const LAS i32x4* p_ = (const LAS i32x4*)(lds + PG8_SB(b, h) + boff + n * 2048); dst##8[n].lo = p_[0]; dst##8[n].hi = p_[64]; } } \
        else { _Pragma("unroll") for (int n = 0; n < 2; ++n) _Pragma("unroll") for (int k = 0; k < 2; ++k) dst[n][k] = *(const LAS bf16x8*)(lds + PG8_SB(b, h) + boff + n * 2048 + k * 1024); } } while (0)
#define PG8_MMA(ai, bj, At, Bt) do { __builtin_amdgcn_s_setprio(1); if constexpr (F8) { _Pragma("unroll") for (int m = 0; m < 4; ++m) _Pragma("unroll") for (int n = 0; n < 2; ++n) \
        asm volatile("v_mfma_f32_16x16x128_f8f6f4 %0, %1, %2, %0" : "+v"(acc[ai][bj][m][n]) : "v"(Bt##8[n]), "v"(At##8[m])); } \
        else { _Pragma("unroll") for (int m = 0; m < 4; ++m) _Pragma("unroll") for (int n = 0; n < 2; ++n) _Pragma("unroll") for (int k = 0; k < 2; ++k) \
        acc[ai][bj][m][n] = __builtin_amdgcn_mfma_f32_16x16x32_bf16(Bt[n][k], At[m][k], acc[ai][bj][m][n], 0, 0, 0); } __builtin_amdgcn_s_setprio(0); } while (0)
#define PG8_WAIT_V(n) asm volatile("s_waitcnt vmcnt(" #n ")" ::: "memory")
#define PG8_WAIT_L(n) asm volatile("s_waitcnt lgkmcnt(" #n ")" ::: "memory")
#define PG8_BAR __builtin_amdgcn_s_barrier()
#define PG8_SCHED __builtin_amdgcn_sched_barrier(0)
    Unit cur, nxt; int ui = 0;
    if (!S.next(0, cur)) return;
    constexpr int NH = GATHER ? 2 : 1;
    unsigned vA[2][NH], vN[2][NH];
#define PG8_VOFF2(u, v) do { int t3_ = threadIdx.x; asm volatile("" : "+v"(t3_)); _Pragma("unroll") for (int i_ = 0; i_ < 2; ++i_) { int R_, C_; stage_rc(t3_ * 16 + i_ * 8192, R_, C_); \
        _Pragma("unroll") for (int h_ = 0; h_ < NH; ++h_) { const int r_ = R_ + HALF * h_; \
        if (GATHER) { const int rr_ = (u).ridx ? ((r_ < (u).nvalid) ? ((const int*)(wsb + (u).ridx))[r_] : 0) : r_; v[i_][h_] = (unsigned)(rr_ * S.lda(u) + C_ * 2); } \
        else v[i_][h_] = ga_voff(S, u, R_, C_); } } } while (0)
#define PG8_HS(u) (GATHER ? 0u : ga_hs(S, u))
    mg_ready<MERGED>(S, cur);
    PG8_VOFF2(cur, vA); PG8_VOFFB(cur, vB);
    f32x4 acc[2][2][4][2];
#pragma unroll
    for (int a = 0; a < 2; ++a)
#pragma unroll
        for (int b = 0; b < 2; ++b)
#pragma unroll
            for (int m = 0; m < 4; ++m)
#pragma unroll
                for (int n = 0; n < 2; ++n) acc[a][b][m][n] = (f32x4){0.f, 0.f, 0.f, 0.f};
    bf16x8 At[4][2], B0[2][2], B1[2][2]; i32x8 At8[4], B08[2], B18[2];
#define PG8_PROLOGUE(u) do { const unsigned hsb = (unsigned)HALF * PG8_LDB(u); \
    PG8_STAGE_B(PG8_SB(0, 0), (u).b0, vB[0], vB[1]); PG8_STAGE_B(PG8_SB(0, 1), (u).b0 + hsb, vB[0], vB[1]); PG8_STAGE_A(PG8_SA(0, 0), ga_tile(S, u, 0), vA[0][0], vA[1][0]); PG8_STAGE_A(PG8_SA(0, 1), ga_tile(S, u, 0) + PG8_HS(u), vA[0][NH - 1], vA[1][NH - 1]); \
    if (wr == 1) PG8_BAR; \
    PG8_WAIT_V(2); PG8_BAR; \
    PG8_STAGE_B(PG8_SB(1, 0), (u).b0 + BK * 2, vB[0], vB[1]); PG8_STAGE_A(PG8_SA(1, 0), ga_tile(S, u, 1), vA[0][0], vA[1][0]); PG8_STAGE_B(PG8_SB(1, 1), (u).b0 + hsb + BK * 2, vB[0], vB[1]); \
    PG8_WAIT_V(6); PG8_BAR; } while (0)
    PG8_PROLOGUE(cur);
    for (;;) {
        const bool has_next = S.next(ui + 1, nxt);
        const bool pre = has_next && !mg_dep<MERGED>(S, nxt);
        Unit stg = pre ? nxt : cur;
        if (pre) { PG8_VOFF2(nxt, vN); if (MERGED) { PG8_VOFFB(nxt, vBn); } else { vBn[0] = vB[0]; vBn[1] = vB[1]; } }
        else { _Pragma("unroll") for (int i_ = 0; i_ < 2; ++i_) _Pragma("unroll") for (int h_ = 0; h_ < NH; ++h_) vN[i_][h_] = vA[i_][h_]; vBn[0] = vB[0]; vBn[1] = vB[1]; }
        const int nt = PG8_NT(cur);
        for (int t = 0; t < nt; t += 2) {
            const bool last = (t == nt - 2);
            const unsigned hstepB = (unsigned)HALF * (last ? PG8_LDB(stg) : PG8_LDB(cur));
            const unsigned y0 = last ? vBn[0] : vB[0], y1 = last ? vBn[1] : vB[1];
            const unsigned a1 = ga_tile(S, cur, t + 1);
            const unsigned a2 = last ? ga_tile(S, stg, 0) : ga_tile(S, cur, t + 2);
            const unsigned a3 = last ? ga_tile(S, stg, 1) : ga_tile(S, cur, t + 3);
            const unsigned hs1 = PG8_HS(cur), hs2 = last ? PG8_HS(stg) : PG8_HS(cur);
            const unsigned b2 = last ? stg.b0 : S.btile(cur, t + 2);
            const unsigned b3 = b2 + BK * 2;
            const unsigned x00 = last ? vN[0][0] : vA[0][0], x10 = last ? vN[1][0] : vA[1][0], x01 = last ? vN[0][NH - 1] : vA[0][NH - 1], x11 = last ? vN[1][NH - 1] : vA[1][NH - 1];
            PG8_LDBF(B0, 0, 0); PG8_LDBF(B1, 0, 1); PG8_SCHED; PG8_LDA(At, 0, 0); PG8_STAGE_A(PG8_SA(1, 1), a1 + hs1, vA[0][NH - 1], vA[1][NH - 1]);
            PG8_WAIT_V(8); PG8_WAIT_L(0); PG8_BAR; PG8_MMA(0, 0, At, B0); PG8_MMA(0, 1, At, B1); PG8_BAR; PG8_SCHED;
            PG8_LDA(At, 0, 1); PG8_STAGE_B(PG8_SB(0, 0), b2, y0, y1); PG8_STAGE_B(PG8_SB(0, 1), b2 + hstepB, y0, y1); PG8_STAGE_A(PG8_SA(0, 0), a2, x00, x10);
            PG8_WAIT_V(8); PG8_WAIT_L(0); PG8_BAR; PG8_MMA(1, 0, At, B0); PG8_MMA(1, 1, At, B1); PG8_BAR; PG8_SCHED;
            PG8_LDBF(B0, 1, 0); PG8_LDBF(B1, 1, 1); PG8_SCHED; PG8_LDA(At, 1, 0); PG8_STAGE_A(PG8_SA(0, 1), a2 + hs2, x01, x11);
            PG8_WAIT_V(8); PG8_WAIT_L(0); PG8_BAR; PG8_MMA(0, 0, At, B0); PG8_MMA(0, 1, At, B1); PG8_BAR; PG8_SCHED;
            PG8_LDA(At, 1, 1); PG8_STAGE_B(PG8_SB(1, 0), b3, y0, y1); PG8_STAGE_B(PG8_SB(1, 1), b3 + hstepB, y0, y1); PG8_STAGE_A(PG8_SA(1, 0), a3, x00, x10);
            PG8_WAIT_V(8); PG8_WAIT_L(0); PG8_BAR; PG8_MMA(1, 0, At, B0); PG8_MMA(1, 1, At, B1); PG8_BAR; PG8_SCHED;
        }
        if (wr == 0) PG8_BAR;
        if constexpr (F8) asm volatile("s_nop 15\n\ts_nop 7" ::: "memory");
        { int t2 = threadIdx.x; asm volatile("" : "+v"(t2)); const int l2 = t2 & 63; E(acc, cur, wr, wc, l2 & 15, l2 >> 4);
          if (MERGED) { PG8_WAIT_V(0); PG8_BAR; mg_done<MERGED>(S, cur, wid, l2); } }
        if (!has_next) break;
#pragma unroll
        for (int a = 0; a < 2; ++a)
#pragma unroll
            for (int b = 0; b < 2; ++b)
#pragma unroll
                for (int m = 0; m < 4; ++m)
#pragma unroll
                    for (int n = 0; n < 2; ++n) acc[a][b][m][n] = (f32x4){0.f, 0.f, 0.f, 0.f};
        cur = nxt; ++ui;
        if (pre) { _Pragma("unroll") for (int i_ = 0; i_ < 2; ++i_) _Pragma("unroll") for (int h_ = 0; h_ < NH; ++h_) vA[i_][h_] = vN[i_][h_]; vB[0] = vBn[0]; vB[1] = vBn[1];
            if (wr == 1) PG8_BAR; }
        else { mg_ready<MERGED>(S, cur); PG8_VOFF2(cur, vA); PG8_VOFFB(cur, vB); PG8_WAIT_V(0); PG8_BAR; PG8_PROLOGUE(cur); }
    }
    PG8_WAIT_V(0);
    PG8_BAR;
#undef PG8_SA
#undef PG8_SB
#undef PG8_GLDS
#undef PG8_STAGE_A
#undef PG8_STAGE_B
#undef PG8_LDA
#undef PG8_LDB
#undef PG8_MMA
#undef PG8_WAIT_V
#undef PG8_WAIT_L
#undef PG8_BAR
#undef PG8_SCHED
#undef PG8_VOFF2
#undef PG8_PROLOGUE
#undef PG8_VOFFB
#undef PG8_NT
#undef PG8_LDBF
#undef PG8_HS
}
}

struct Args {
    const float* x; const float* c; const int* pos; const float* ada_w; const float* ada_b; const float* norm_mix; const float* norm_ffn;
    const float* w_in; const float* hg_lb; const float* hg_onorm; const float* mla_q_norm; const float* mla_kv_norm; const float* mla_w_uq;
    const float* mla_w_ukv; const float* mla_qk_norm; const float* diff_qk_norm; const float* diff_lam; const float* diff_onorm;
    const float* swa_qk_norm; const float* swa_sinks; const float* w_branch; const float* w_out; const float* router_w; const float* router_bias;
    const float* moe_w_gate; const float* moe_w_up; const float* moe_w_down;
    float* out; unsigned char* ws; int ph_lo, ph_hi;
};
typedef const __attribute__((address_space(4))) Args* kargs_ptr;
__device__ __forceinline__ Args load_args() {
#if defined(__HIP_DEVICE_COMPILE__)
    kargs_ptr ap = (kargs_ptr)__builtin_amdgcn_kernarg_segment_ptr(); asm volatile("" : "+s"(ap)); Args r; __builtin_memcpy(&r, ap, sizeof(Args)); return r;
#else
    return Args{};
#endif
}
struct Frame {
    LAS unsigned char* lds; unsigned char* ldsg;
    volatile LAS unsigned* MISC; gu32* ctl;
    int tid, lane, wave, vcu, G;
};

__device__ __forceinline__ Frame fresh(const Frame& F0) {
    Frame F = F0; int t = threadIdx.x; asm volatile("" : "+v"(t)); F.tid = t; F.lane = t & 63; F.wave = __builtin_amdgcn_readfirstlane(t >> 6);
    unsigned lb = 0; asm volatile("" : "+s"(lb)); F.lds = (LAS unsigned char*)(F0.lds + lb); F.MISC = (volatile LAS unsigned*)(F.lds + MISC_OFF); return F;
}
struct CItem { const float* W; int ld, c0, ncols, K; bf16_t* WT; int row0, rstep, item; bool frag, f8; };
__device__ __forceinline__ void conv_issue(const Frame& F, const CItem& d, f32x4 (&v)[8]) {
    const int nblk = (d.ncols + 255) >> 8, kb = d.item / nblk, nb = d.item % nblk, k0 = 64 * kb, n0 = 256 * nb;
    const int n = n0 + 4 * F.lane; const bool ok = n < d.ncols; const float* src = d.W + (size_t)(k0 + 8 * F.wave) * d.ld + d.c0 + n;
#pragma unroll
    for (int r = 0; r < 8; ++r) v[r] = ok ? *(const GAS f32x4*)(src + (size_t)r * d.ld) : (f32x4){0.f, 0.f, 0.f, 0.f};
}
__device__ __forceinline__ void conv_to_lds(const Frame& F, const f32x4 (&v)[8]) {
    constexpr int ST = 257; LAS float* tile = (LAS float*)F.lds;
#pragma unroll
    for (int r = 0; r < 8; ++r) { LAS float* dd = tile + (8 * F.wave + r) * ST + 4 * F.lane; dd[0] = v[r][0]; dd[1] = v[r][1]; dd[2] = v[r][2]; dd[3] = v[r][3]; }
}
__device__ __forceinline__ void conv_store(const Frame& F, const CItem& d) {
    constexpr int ST = 257; LAS float* tile = (LAS float*)F.lds;
    const int nblk = (d.ncols + 255) >> 8, kb = d.item / nblk, nb = d.item % nblk, k0 = 64 * kb, n0 = 256 * nb; const int K = d.K;
    if (d.f8) {
#pragma unroll
        for (int j = 0; j < 2; ++j) { const int idx = F.tid + 512 * j, c = idx & 3, n = idx >> 2; const LAS float* sp = tile + (16 * c) * ST + n; u32x4 o;
#pragma unroll
            for (int q = 0; q < 4; ++q) o[q] = pk4f8(sp[(4 * q) * ST] * W8_SCALE, sp[(4 * q + 1) * ST] * W8_SCALE, sp[(4 * q + 2) * ST] * W8_SCALE, sp[(4 * q + 3) * ST] * W8_SCALE);
            if (n0 + n < d.ncols) { const int ng = d.row0 + (n & 127) + (n >> 7) * d.rstep + (n0 >> 7) * d.rstep; *(GAS u32x4*)((unsigned char*)d.WT + (size_t)ng * K + k0 + 16 * c) = o; } }
        return; }
#pragma unroll
    for (int j = 0; j < 4; ++j) { const int idx = F.tid + 512 * j, c = idx & 7, n = idx >> 3; const LAS float* sp = tile + (8 * c) * ST + n;
        u32x4 o; o.x = pk2(sp[0 * ST], sp[1 * ST]); o.y = pk2(sp[2 * ST], sp[3 * ST]); o.z = pk2(sp[4 * ST], sp[5 * ST]); o.w = pk2(sp[6 * ST], sp[7 * ST]);
        if (n0 + n < d.ncols) { const int ng = d.row0 + (n & 127) + (n >> 7) * d.rstep + (n0 >> 7) * d.rstep, kc = (k0 >> 3) + c;
            const size_t dst = d.frag ? ((size_t)(((ng >> 5) * (K >> 4) + (kc >> 1)) * 64 + (kc & 1) * 32 + (ng & 31))) * 8 : (size_t)ng * K + k0 + 8 * c;
            *(GAS u32x4*)(d.WT + dst) = o; } }
}
template <class DescFn>
__device__ __forceinline__ void conv_run(const Frame& F, int n_items, DescFn desc) {
    int it = F.vcu; if (it >= n_items) return;
    CItem cur = desc(it); f32x4 v[8]; conv_issue(F, cur, v);
    __syncthreads();
    for (;;) {
        const int nit = it + F.G; const bool more = nit < n_items; const CItem nx = more ? desc(nit) : cur;
        conv_to_lds(F, v);
        if (more) conv_issue(F, nx, v);
        __syncthreads();
        conv_store(F, cur);
        __syncthreads();
        if (!more) break;
        cur = nx; it = nit;
    }
}
__device__ __forceinline__ void conv_layer_main(const Frame& F0, int l) {
    const Args A = load_args(); const Frame F = fresh(F0); asm volatile("" : "+s"(l));
    bf16_t* WINT = (bf16_t*)(A.ws + WS_WINT); bf16_t* UQT = (bf16_t*)(A.ws + WS_UQT); bf16_t* UKVT = (bf16_t*)(A.ws + WS_UKVT);
    bf16_t* BRT = (bf16_t*)(A.ws + WS_BRT); bf16_t* OUTT = (bf16_t*)(A.ws + WS_OUTT);
    const float* w_in = A.w_in + (size_t)l * DM * W_IN_COLS;
    constexpr int I_G = 16 * 16, I_P = 16 * 19, I_UQ = 4 * 3, I_UKV = 2 * 4, I_BR = 4 * 8 * 4, I_OUT = 16 * 4;
    constexpr int NIT = I_G + I_P + I_UQ + I_UKV + I_BR + I_OUT;
    conv_run(F, NIT, [&](int it) -> CItem { int r = it;
        if (r < I_G) return CItem{w_in, W_IN_COLS, 4768, 4096, DM, WINT, 0, 128, r, false, true}; r -= I_G;
        if (r < I_P) return CItem{w_in, W_IN_COLS, 0, 4768, DM, WINT, NGATE, 128, r, false, true}; r -= I_P;
        if (r < I_UQ) return CItem{A.mla_w_uq + (size_t)l * 256 * 768, 768, 0, 768, 256, UQT, 0, 128, r, true, false}; r -= I_UQ;
        if (r < I_UKV) return CItem{A.mla_w_ukv + (size_t)l * 128 * 1024, 1024, 0, 1024, 128, UKVT, 0, 128, r, true, false}; r -= I_UKV;
        if (r < I_BR) { const int b = r >> 5; return CItem{A.w_branch + ((size_t)l * 4 + b) * 512 * 1024, 1024, 0, 1024, 512, BRT, b * 1024, 128, r & 31, false, true}; } r -= I_BR;
        return CItem{A.w_out + (size_t)l * DM * DM, DM, 0, DM, DM, OUTT, 0, 128, r, false, true}; });
    { unsigned z0 = 0u; asm volatile("" : "+v"(z0)); u32x4 z = {z0, z0, z0, z0}; GAS u32x4* p = (GAS u32x4*)((unsigned char*)WINT + (size_t)(NGATE + 4768) * DM);
      for (int i = (F.vcu * 512 + F.tid); i < 96 * DM / 16; i += F.G * 512) p[i] = z; }
}
__device__ __forceinline__ void conv_layer_moe(const Frame& F0, int l) {
    const Args A = load_args(); const Frame F = fresh(F0); asm volatile("" : "+s"(l));
    bf16_t* GUT = (bf16_t*)(A.ws + WS_GUT); bf16_t* DT = (bf16_t*)(A.ws + WS_DT);
    constexpr int I_GU = 16 * 2 * 16, I_D = 16 * 16;
    conv_run(F, I_GU + I_D, [&](int it) -> CItem {
        if (it < I_GU) { const int e = it >> 5, isup = (it >> 4) & 1, item = it & 15;
            const float* src = (isup ? A.moe_w_up : A.moe_w_gate) + ((size_t)l * 16 + e) * DM * 256;
            return CItem{src, 256, 0, 256, DM, GUT, e * 512 + isup * 128, 256, item, false, true}; }
        const int r = it - I_GU, e = r >> 4, item = r & 15;
        return CItem{A.moe_w_down + ((size_t)l * 16 + e) * 256 * DM, DM, 0, DM, 256, DT, e * 1024, 128, item, false, true}; });
}

__device__ __forceinline__ void p0_mod_rope(const Frame& F0) {
    const Args A = load_args(); const Frame F = fresh(F0);
    { float* rope = (float*)(A.ws + WS_ROPE);
      for (int idx = F.vcu * 512 + F.tid; idx < M * 16; idx += F.G * 512) { const int m = idx >> 4, i = idx & 15;
          const float inv = powf(10000.0f, -(float)(2 * i) / 32.0f); const float ang = (float)A.pos[m] * inv; float sn, cs; sincosf(ang, &sn, &cs);
          rope[m * 32 + i] = cs; rope[m * 32 + 16 + i] = sn; } }
    LAS float* cact = (LAS float*)(F.lds);
    LAS float* part = (LAS float*)(F.lds + 32768);
    for (int i = F.tid; i < 8 * DM; i += 512) { const int b = i >> 10, k = i & 1023; cact[k * 8 + b] = fsilu(A.c[b * DM + k]); }
    __syncthreads();
    float* mod = (float*)(A.ws + WS_MOD);
    for (int u = F.vcu; u < 2 * 96; u += F.G) {
        const int l = u / 96, n0 = (u % 96) * 64;
        const float* w = A.ada_w + (size_t)l * DM * 6144 + n0 + F.lane;
        float acc[8];
#pragma unroll
        for (int b = 0; b < 8; ++b) acc[b] = 0.f;
        const int k0 = F.wave * 128;
#pragma unroll 1
        for (int kb = 0; kb < 128; kb += 32) { float wv[32];
#pragma unroll
            for (int k = 0; k < 32; ++k) wv[k] = w[(size_t)(k0 + kb + k) * 6144];
#pragma unroll
            for (int k = 0; k < 32; ++k) { const f32x4 c0 = *(const LAS f32x4*)(cact + (k0 + kb + k) * 8), c1 = *(const LAS f32x4*)(cact + (k0 + kb + k) * 8 + 4);
                acc[0] += c0[0] * wv[k]; acc[1] += c0[1] * wv[k]; acc[2] += c0[2] * wv[k]; acc[3] += c0[3] * wv[k]; acc[4] += c1[0] * wv[k]; acc[5] += c1[1] * wv[k]; acc[6] += c1[2] * wv[k]; acc[7] += c1[3] * wv[k]; } }
#pragma unroll
        for (int b = 0; b < 8; ++b) part[(F.wave * 8 + b) * 64 + F.lane] = acc[b];
        __syncthreads();
        { const int b = F.tid >> 6, n = F.tid & 63; float s = 0.f;
#pragma unroll
          for (int w8 = 0; w8 < 8; ++w8) s += part[(w8 * 8 + b) * 64 + n];
          mod[((size_t)l * 8 + b) * 6144 + n0 + n] = s + A.ada_b[l * 6144 + n0 + n]; }
        __syncthreads();
    }
}

__device__ __forceinline__ void store_row_bf16(bf16_t* orow, int lane, const f32x4 (&v)[4]) {
    GAS unsigned long long* o8 = (GAS unsigned long long*)orow + lane;
#pragma unroll
    for (int j = 0; j < 4; ++j) o8[64 * j] = (unsigned long long)pk2(v[j].x, v[j].y) | ((unsigned long long)pk2(v[j].z, v[j].w) << 32);
}
__device__ __forceinline__ void store_row_f8(unsigned char* orow, int lane, const f32x4 (&v)[4]) {
    GAS unsigned* o4 = (GAS unsigned*)orow + lane;
#pragma unroll
    for (int j = 0; j < 4; ++j) o4[64 * j] = pk4f8(v[j].x, v[j].y, v[j].z, v[j].w);
}
template <bool ROUTER>
__device__ __forceinline__ void norm_phase(const Frame& F0, int l) {
    const Args A = load_args(); const Frame F = fresh(F0); asm volatile("" : "+s"(l));
    bf16_t* H = (bf16_t*)(A.ws + WS_H); const float* mod = (const float*)(A.ws + WS_MOD) + (size_t)l * 8 * 6144;
    const float* xin = ROUTER ? A.out : ((l == 0) ? A.x : A.out);
    const float* gain = (ROUTER ? A.norm_ffn : A.norm_mix) + l * DM;
    const int lane = F.lane, gw = F.vcu * 8 + F.wave, b = gw >> 8, r0 = gw & 255;
    LAS float* rwt = (LAS float*)F.lds;
    LAS int* rowpair = (LAS int*)(F.lds + 65536);
    if (ROUTER) {
#pragma unroll
        for (int i = 0; i < 8; ++i) { const int idx = F.tid + 512 * ((i + F.vcu) & 7), c = idx >> 2, q = idx & 3; const f32x4 r = *(const GAS f32x4*)(A.router_w + (size_t)c * 16 + 4 * q);
            rwt[(4 * q + 0) * DM + c] = r[0]; rwt[(4 * q + 1) * DM + c] = r[1]; rwt[(4 * q + 2) * DM + c] = r[2]; rwt[(4 * q + 3) * DM + c] = r[3]; }
        __syncthreads();
    }
    f32x4 sc[4], sh[4];
    { const float* pm = mod + b * 6144 + (ROUTER ? 3072 : 0);
#pragma unroll
      for (int j = 0; j < 4; ++j) { const f32x4 gg = ((const GAS f32x4*)gain)[lane + 64 * j], s1 = ((const GAS f32x4*)(pm + 1024))[lane + 64 * j]; sh[j] = ((const GAS f32x4*)pm)[lane + 64 * j]; sc[j] = gg * (s1 + 1.0f); } }
    const int b5 = lane >> 5, b4 = (lane >> 4) & 1, b3 = (lane >> 3) & 1, b2 = (lane >> 2) & 1;
    f32x4 xn[4];
    { const GAS f32x4* xr = (const GAS f32x4*)(xin + (size_t)(b * 2048 + r0) * DM) + lane;
#pragma unroll
      for (int j = 0; j < 4; ++j) xn[j] = xr[64 * j]; }
#pragma unroll 2
    for (int k = 0; k < 8; ++k) {
        const int m = b * 2048 + r0 + 256 * k;
        f32x4 v[4];
#pragma unroll
        for (int j = 0; j < 4; ++j) v[j] = xn[j];
        if (k + 1 < 8) { const GAS f32x4* xr = (const GAS f32x4*)(xin + (size_t)(m + 256) * DM) + lane;
#pragma unroll
            for (int j = 0; j < 4; ++j) xn[j] = xr[64 * j]; }
        float s = 0.f;
#pragma unroll
        for (int j = 0; j < 4; ++j) s += (v[j].x * v[j].x + v[j].y * v[j].y) + (v[j].z * v[j].z + v[j].w * v[j].w);
        const float rstd = __builtin_amdgcn_rsqf(wave_sum(s, lane) * (1.f / DM) + EPS);
#pragma unroll
        for (int j = 0; j < 4; ++j) v[j] = v[j] * rstd * sc[j] + sh[j];
        store_row_f8((unsigned char*)H + (size_t)m * DM, lane, v);
        if (ROUTER) {
            float a16[16];
            int lo4 = 4 * lane; asm volatile("" : "+v"(lo4));
#pragma unroll
            for (int e = 0; e < 16; ++e) { float acc = 0.f;
#pragma unroll
                for (int j = 0; j < 4; ++j) { const f32x4 r = *(const LAS f32x4*)(rwt + e * DM + 256 * j + lo4); acc += v[j][0] * r[0] + v[j][1] * r[1] + v[j][2] * r[2] + v[j][3] * r[3]; }
                a16[e] = acc; }
            float r8[8], r4[4], r2[2], r1;
#pragma unroll
            for (int q = 0; q < 8; ++q) { const float mine = b5 ? a16[8 + q] : a16[q], oth = b5 ? a16[q] : a16[8 + q]; r8[q] = mine + shx(oth, 32, lane); }
#pragma unroll
            for (int q = 0; q < 4; ++q) { const float mine = b4 ? r8[4 + q] : r8[q], oth = b4 ? r8[q] : r8[4 + q]; r4[q] = mine + shx(oth, 16, lane); }
#pragma unroll
            for (int q = 0; q < 2; ++q) { const float mine = b3 ? r4[2 + q] : r4[q], oth = b3 ? r4[q] : r4[2 + q]; r2[q] = mine + shx(oth, 8, lane); }
            { const float mine = b2 ? r2[1] : r2[0], oth = b2 ? r2[0] : r2[1]; r1 = mine + shx(oth, 4, lane); }
            r1 += shx(r1, 2, lane); r1 += shx(r1, 1, lane);
            float lg[16];
#pragma unroll
            for (int e = 0; e < 16; ++e) lg[e] = __builtin_bit_cast(float, __builtin_amdgcn_readlane(__builtin_bit_cast(int, r1), 32 * ((e >> 3) & 1) + 16 * ((e >> 2) & 1) + 8 * ((e >> 1) & 1) + 4 * (e & 1)));
            float scv[16], sel[16];
#pragma unroll
            for (int e = 0; e < 16; ++e) { scv[e] = fsigmoid(lg[e]); sel[e] = scv[e] + A.router_bias[e]; }
            int bg = 0, bi1 = 0, bi2 = 1; float bgs = -1e30f, bw1 = 0.f, bw2 = 0.f;
#pragma unroll
            for (int g = 0; g < 4; ++g) { int i1 = 0; float s1 = sel[g * 4], w1 = scv[g * 4];
#pragma unroll
                for (int i = 1; i < 4; ++i) { const float sv = sel[g * 4 + i]; if (sv > s1) { s1 = sv; i1 = i; w1 = scv[g * 4 + i]; } }
                int i2 = -1; float s2 = -1e30f, w2 = 0.f;
#pragma unroll
                for (int i = 0; i < 4; ++i) { const float sv = sel[g * 4 + i]; if (i != i1 && sv > s2) { s2 = sv; i2 = i; w2 = scv[g * 4 + i]; } }
                const float gs = s1 + s2; if (gs > bgs) { bgs = gs; bg = g; bi1 = i1; bi2 = i2; bw1 = w1; bw2 = w2; } }
            const int ia = bi1 < bi2 ? bi1 : bi2, ib = bi1 < bi2 ? bi2 : bi1;
            const float wa0 = bi1 < bi2 ? bw1 : bw2, wb0 = bi1 < bi2 ? bw2 : bw1, inv = 1.0f / (wa0 + wb0);
            const int pidx = (ia == 0) ? (ib - 1) : (ia == 1 ? ib + 1 : 5);
            const int pair = bg * 6 + pidx;
            if (lane == 0) { float* tokw = (float*)(A.ws + WS_TOKW); tokw[2 * m] = wa0 * inv; tokw[2 * m + 1] = wb0 * inv; rowpair[F.wave * 8 + k] = pair; }
        }
    }
    if (ROUTER) {
        int* list = (int*)(A.ws + WS_LIST); unsigned* cnt = (unsigned*)(A.ws + WS_CTL) + CW_CNT + 64 * l;
        LAS int* base = rowpair + 64;
        __syncthreads();
        if (F.tid < 24) { int c = 0;
#pragma unroll 8
            for (int r = 0; r < 64; ++r) c += (rowpair[r] == F.tid) ? 1 : 0;
            base[F.tid] = c ? (int)atomicAdd(cnt + F.tid, (unsigned)c) : 0; }
        __syncthreads();
        if (F.tid < 64) { const int p = rowpair[F.tid]; int rank = 0;
#pragma unroll 8
            for (int r = 0; r < 64; ++r) rank += (r < F.tid && rowpair[r] == p) ? 1 : 0;
            const int w = F.tid >> 3, k = F.tid & 7; const int gwv = F.vcu * 8 + w; const int m = (gwv >> 8) * 2048 + (gwv & 255) + 256 * k;
            list[p * 16384 + base[p] + rank] = m; }
        __syncthreads();
    }
}
__device__ __forceinline__ void pair_experts(int pair, int& ea, int& eb) { const int g = pair / 6, pi = pair % 6;
    const int ia = pi < 3 ? 0 : (pi < 5 ? 1 : 2); const int ib = pi < 3 ? pi + 1 : (pi < 5 ? pi - 1 : 3); ea = g * 4 + ia; eb = g * 4 + ib; }

template <int NT>
__device__ __forceinline__ void stage_store_rows(LAS unsigned char* stg, const f32x16* v, bf16_t* gbase, int gstride, int lane) {
    const int r32 = lane & 31, hi = lane >> 5;
#pragma unroll
    for (int nt = 0; nt < NT; ++nt)
#pragma unroll
        for (int g = 0; g < 4; ++g) { u32x2 o; o.x = pk2(v[nt][4 * g], v[nt][4 * g + 1]); o.y = pk2(v[nt][4 * g + 2], v[nt][4 * g + 3]);
            *(LAS u32x2*)(stg + r32 * 208 + (nt * 32 + 8 * g + 4 * hi) * 2) = o; }
    LDS_WAIT(); asm volatile("" ::: "memory");
    constexpr int CPR = NT * 4;
#pragma unroll
    for (int i = 0; i < (32 * CPR) / 64; ++i) { const int c = lane + 64 * i, tok = c / CPR, part = c % CPR;
        const u32x4 d = *(const LAS u32x4*)(stg + tok * 208 + part * 16);
        *(u32x4*)(gbase + (size_t)tok * gstride + part * 8) = d; }
    LDS_WAIT(); asm volatile("" ::: "memory");
}
__device__ __forceinline__ void mla_prep_unit(const Frame& F0, int l, int unit) {
    const Args A = load_args(); const Frame F = fresh(F0); asm volatile("" : "+s"(l));
    const int tid = F.tid, lane = F.lane, w = F.wave, r32 = lane & 31, hi = lane >> 5;
    LAS unsigned char* lds = F.lds;
    constexpr int XQ_OFF = 0, XQ_ST = 528, XKV_OFF = 64 * 528, XKV_ST = 272, XR_OFF = XKV_OFF + 64 * 272, STG_OFF = 65536;
    const bf16_t* proj = (const bf16_t*)(A.ws + WS_PROJ);
    const int m0 = unit * 64;
    { const int t = tid >> 3, part = tid & 7; const bf16_t* row = proj + (size_t)(m0 + t) * NPROJ;
      u32x4 cq[4], ck[2];
#pragma unroll
      for (int i = 0; i < 4; ++i) cq[i] = *(const u32x4*)(row + PC_CQ + part * 32 + i * 8);
#pragma unroll
      for (int i = 0; i < 2; ++i) ck[i] = *(const u32x4*)(row + PC_CKV + part * 16 + i * 8);
      const u32x2 kr = *(const u32x2*)(row + PC_KR + part * 4);
      float sq = 0.f, sk = 0.f;
#pragma unroll
      for (int i = 0; i < 4; ++i)
#pragma unroll
          for (int j = 0; j < 4; ++j) { const float a = bflo(cq[i][j]), b = bfhi(cq[i][j]); sq += a * a + b * b; }
#pragma unroll
      for (int i = 0; i < 2; ++i)
#pragma unroll
          for (int j = 0; j < 4; ++j) { const float a = bflo(ck[i][j]), b = bfhi(ck[i][j]); sk += a * a + b * b; }
      sq += shx(sq, 1, lane); sq += shx(sq, 2, lane); sq += shx(sq, 4, lane);
      sk += shx(sk, 1, lane); sk += shx(sk, 2, lane); sk += shx(sk, 4, lane);
      const float rq = __builtin_amdgcn_rsqf(sq * (1.f / 256.f) + EPS), rk = __builtin_amdgcn_rsqf(sk * (1.f / 128.f) + EPS);
      const float* gq = A.mla_q_norm + l * 256 + part * 32; const float* gkv = A.mla_kv_norm + l * 128 + part * 16;
#pragma unroll
      for (int i = 0; i < 4; ++i) { u32x4 o;
#pragma unroll
          for (int j = 0; j < 4; ++j) o[j] = pk2(bflo(cq[i][j]) * rq * gq[i * 8 + 2 * j], bfhi(cq[i][j]) * rq * gq[i * 8 + 2 * j + 1]);
          *(LAS u32x4*)(lds + XQ_OFF + t * XQ_ST + part * 64 + i * 16) = o; }
#pragma unroll
      for (int i = 0; i < 2; ++i) { u32x4 o;
#pragma unroll
          for (int j = 0; j < 4; ++j) o[j] = pk2(bflo(ck[i][j]) * rk * gkv[i * 8 + 2 * j], bfhi(ck[i][j]) * rk * gkv[i * 8 + 2 * j + 1]);
          *(LAS u32x4*)(lds + XKV_OFF + t * XKV_ST + part * 32 + i * 16) = o; }
      *(LAS f32x4*)(lds + XR_OFF + (t * 32 + part * 4) * 4) = (f32x4){bflo(kr.x), bfhi(kr.x), bflo(kr.y), bfhi(kr.y)}; }
    __syncthreads();
    const u32x4* UQF = (const u32x4*)(A.ws + WS_UQT); const u32x4* UKVF = (const u32x4*)(A.ws + WS_UKVT);
    const float* rope = (const float*)(A.ws + WS_ROPE);
    bf16_t* MQ = (bf16_t*)(A.ws + WS_MLAQ); bf16_t* MK = (bf16_t*)(A.ws + WS_MLAK); bf16_t* MV = (bf16_t*)(A.ws + WS_MLAV);
    const float* gqk = A.mla_qk_norm + l * 192;
    const int h = w;
    {
        f32x16 acc[3][2];
#pragma unroll
        for (int nt = 0; nt < 3; ++nt) { acc[nt][0] = (f32x16){0}; acc[nt][1] = (f32x16){0}; }
        const int rot = F.vcu;
#pragma unroll 4
        for (int k_ = 0; k_ < 16; ++k_) { const int ks = (k_ + rot) & 15;
            const bf16x8 x0 = *(const LAS bf16x8*)(lds + XQ_OFF + r32 * XQ_ST + ks * 32 + hi * 16);
            const bf16x8 x1 = *(const LAS bf16x8*)(lds + XQ_OFF + (32 + r32) * XQ_ST + ks * 32 + hi * 16);
#pragma unroll
            for (int nt = 0; nt < 3; ++nt) { const bf16x8 wf = __builtin_bit_cast(bf16x8, UQF[((h * 3 + nt) * 16 + ks) * 64 + lane]);
                acc[nt][0] = __builtin_amdgcn_mfma_f32_32x32x16_bf16(wf, x0, acc[nt][0], 0, 0, 0);
                acc[nt][1] = __builtin_amdgcn_mfma_f32_32x32x16_bf16(wf, x1, acc[nt][1], 0, 0, 0); }
        }
#pragma unroll
        for (int tb = 0; tb < 2; ++tb) {
            const int m = m0 + tb * 32 + r32;
            float ss = 0.f;
#pragma unroll
            for (int nt = 0; nt < 3; ++nt)
#pragma unroll
                for (int r = 0; r < 16; ++r) ss += acc[nt][tb][r] * acc[nt][tb][r];
            ss += shx(ss, 32, lane);
            const float rstd = __builtin_amdgcn_rsqf(ss * (1.f / 96.f) + EPS);
#pragma unroll
            for (int nt = 0; nt < 3; ++nt)
#pragma unroll
                for (int r = 0; r < 16; ++r) acc[nt][tb][r] = acc[nt][tb][r] * rstd * gqk[nt * 32 + crow(r, hi)];
#pragma unroll
            for (int r = 0; r < 8; ++r) { const int i = crow(r, hi); const float cs = rope[m * 32 + i], sn = rope[m * 32 + 16 + i];
                const float x1 = acc[2][tb][r], x2 = acc[2][tb][r + 8]; acc[2][tb][r] = x1 * cs - x2 * sn; acc[2][tb][r + 8] = x1 * sn + x2 * cs; }
            { f32x16 t3[3] = {acc[0][tb], acc[1][tb], acc[2][tb]}; stage_store_rows<3>(lds + STG_OFF + w * 6656, t3, MQ + (size_t)(m0 + tb * 32) * 768 + h * 96, 768, lane); }
        }
    }
    {
        f32x16 acc[4][2];
#pragma unroll
        for (int nt = 0; nt < 4; ++nt) { acc[nt][0] = (f32x16){0}; acc[nt][1] = (f32x16){0}; }
        const int rot = F.vcu;
#pragma unroll 4
        for (int k_ = 0; k_ < 8; ++k_) { const int ks = (k_ + rot) & 7;
            const bf16x8 x0 = *(const LAS bf16x8*)(lds + XKV_OFF + r32 * XKV_ST + ks * 32 + hi * 16);
            const bf16x8 x1 = *(const LAS bf16x8*)(lds + XKV_OFF + (32 + r32) * XKV_ST + ks * 32 + hi * 16);
#pragma unroll
            for (int nt = 0; nt < 4; ++nt) { const bf16x8 wf = __builtin_bit_cast(bf16x8, UKVF[((h * 4 + nt) * 8 + ks) * 64 + lane]);
                acc[nt][0] = __builtin_amdgcn_mfma_f32_32x32x16_bf16(wf, x0, acc[nt][0], 0, 0, 0);
                acc[nt][1] = __builtin_amdgcn_mfma_f32_32x32x16_bf16(wf, x1, acc[nt][1], 0, 0, 0); }
        }
#pragma unroll
        for (int tb = 0; tb < 2; ++tb) {
            const int m = m0 + tb * 32 + r32, tl = tb * 32 + r32;
            f32x16 kr;
#pragma unroll
            for (int r = 0; r < 16; ++r) kr[r] = *(const LAS float*)(lds + XR_OFF + (tl * 32 + crow(r, hi)) * 4);
            float ss = 0.f;
#pragma unroll
            for (int nt = 0; nt < 2; ++nt)
#pragma unroll
                for (int r = 0; r < 16; ++r) ss += acc[nt][tb][r] * acc[nt][tb][r];
#pragma unroll
            for (int r = 0; r < 16; ++r) ss += kr[r] * kr[r];
            ss += shx(ss, 32, lane);
            const float rstd = __builtin_amdgcn_rsqf(ss * (1.f / 96.f) + EPS);
#pragma unroll
            for (int nt = 0; nt < 2; ++nt)
#pragma unroll
                for (int r = 0; r < 16; ++r) acc[nt][tb][r] = acc[nt][tb][r] * rstd * gqk[96 + nt * 32 + crow(r, hi)];
#pragma unroll
            for (int r = 0; r < 16; ++r) kr[r] = kr[r] * rstd * gqk[96 + 64 + crow(r, hi)];
#pragma unroll
            for (int r = 0; r < 8; ++r) { const int i = crow(r, hi); const float cs = rope[m * 32 + i], sn = rope[m * 32 + 16 + i];
                const float x1 = kr[r], x2 = kr[r + 8]; kr[r] = x1 * cs - x2 * sn; kr[r + 8] = x1 * sn + x2 * cs; }
            { f32x16 t3[3] = {acc[0][tb], acc[1][tb], kr}; stage_store_rows<3>(lds + STG_OFF + w * 6656, t3, MK + (size_t)(m0 + tb * 32) * 768 + h * 96, 768, lane); }
            { f32x16 t2[2] = {acc[2][tb], acc[3][tb]}; stage_store_rows<2>(lds + STG_OFF + w * 6656, t2, MV + (size_t)(m0 + tb * 32) * 512 + h * 64, 512, lane); }
        }
    }
    __syncthreads();
}

struct AttnWaveCfg {
    const bf16_t* q; int qstride;
    int qpos0;
    int kc0;
};
__device__ __forceinline__ void glds16(const void* gsrc, unsigned lds_dst) { unsigned keep;
    asm volatile("s_mov_b32 %0, m0\n\ts_mov_b32 m0, %2\n\ts_nop 0\n\tglobal_load_lds_dwordx4 %1, off\n\ts_mov_b32 m0, %0" : "=&s"(keep) : "v"(gsrc), "s"(lds_dst) : "memory"); }
__device__ __forceinline__ unsigned cvtpk(float lo, float hi) { f32x2_t v = {lo, hi}; bf16x2_t b = __builtin_convertvector(v, bf16x2_t); return __builtin_bit_cast(unsigned, b); }
#define ATT_WAITBAR(N) asm volatile("s_waitcnt vmcnt(" #N ") lgkmcnt(0)\n\ts_barrier" ::: "memory")
template <int DQK, int DV, int KL, bool NORMQ, int WINDOW, int VPRE>
struct AttnBody {
    static constexpr int NKP = (KL == 0) ? 8 : (KL == 1 ? 16 : 12), NVP = DV / 8;
    static constexpr int KBYTES = NKP * 1024, SLOT = KBYTES + NVP * 1024, NS = 3;
    static constexpr int PT = (KL == 0) ? 2 : (KL == 1 ? 4 : 3);
    static constexpr int SCR_OFF = NS * SLOT;
    static constexpr int NKS = DQK / 16, ND0 = DV / 32;
    __device__ static __forceinline__ void run(const Frame& F, const AttnWaveCfg& W, const bf16_t* Kg, int kstride, const bf16_t* Vg, int vstride,
                                               int kt_lo, int kt_hi, float c2, const float* gq, bool use_sink, float sink_l2, f32x16 (&o)[ND0]) {
        const int lane = F.lane, r32 = lane & 31, hi = lane >> 5, w = F.wave;
        LAS unsigned char* lds = F.lds;
        const unsigned lds0 = (unsigned)(size_t)lds;
        LAS float* wsf = (LAS float*)(lds + SCR_OFF + w * 256);
        const bf16_t* ksrc0; const bf16_t* ksrc1 = nullptr; const bf16_t* vsrc0; const bf16_t* vsrc1 = nullptr; unsigned kd0, kd1 = 0, vd0, vd1 = 0;
        if (KL == 0) { const int row = 8 * w + (lane >> 3), c = (lane & 7) ^ ((row >> 1) & 7); ksrc0 = Kg + (size_t)row * kstride + c * 8; kd0 = w * 1024; }
        else if (KL == 1) { const int p0 = 2 * w, row0 = 4 * p0 + (lane >> 4), row1 = row0 + 4; ksrc0 = Kg + (size_t)row0 * kstride + ((lane & 15) ^ (row0 & 15)) * 8; ksrc1 = Kg + (size_t)row1 * kstride + ((lane & 15) ^ (row1 & 15)) * 8;
            kd0 = p0 * 1024; kd1 = kd0 + 1024; }
        else { const int row = 8 * w + (lane >> 3), c = (lane & 7) ^ ((row >> 1) & 7); ksrc0 = Kg + (size_t)row * kstride + c * 8; kd0 = w * 1024;
            const int p = w & 3, rr = 16 * p + (lane >> 2), cr = (lane & 3) ^ ((rr >> 2) & 3); ksrc1 = Kg + (size_t)rr * kstride + 64 + cr * 8; kd1 = 8192 + p * 1024; }
        if (DV == 64) { vsrc0 = Vg + (size_t)(16 * (w & 3) + (lane >> 2)) * vstride + (w >> 2) * 32 + (lane & 3) * 8; vd0 = KBYTES + w * 1024; }
        else { const int p0 = 2 * w, p1 = p0 + 1; vsrc0 = Vg + (size_t)(16 * (p0 & 3) + (lane >> 2)) * vstride + (p0 >> 2) * 32 + (lane & 3) * 8; vsrc1 = Vg + (size_t)(16 * (p1 & 3) + (lane >> 2)) * vstride + (p1 >> 2) * 32 + (lane & 3) * 8;
            vd0 = KBYTES + p0 * 1024; vd1 = vd0 + 1024; }
        auto dma_tile = [&](int kt, int slot) {
            const size_t ko = (size_t)kt * 64 * kstride, vo = (size_t)kt * 64 * vstride; const unsigned sb = lds0 + (unsigned)slot * SLOT;
            glds16(ksrc0 + ko, (unsigned)__builtin_amdgcn_readfirstlane(sb + kd0));
            if (KL != 0) glds16(ksrc1 + ko, (unsigned)__builtin_amdgcn_readfirstlane(sb + kd1));
            glds16(vsrc0 + vo, (unsigned)__builtin_amdgcn_readfirstlane(sb + vd0));
            if (DV == 128) glds16(vsrc1 + vo, (unsigned)__builtin_amdgcn_readfirstlane(sb + vd1));
        };
        dma_tile(kt_lo, 0);
        if (kt_lo + 1 < kt_hi) dma_tile(kt_lo + 1, 1);
        bf16x8 qf[NKS];
        {
            float ss = 0.f; u32x4 raw[NKS];
#pragma unroll
            for (int ks = 0; ks < NKS; ++ks) { raw[ks] = *(const u32x4*)(W.q + (size_t)r32 * W.qstride + ks * 16 + hi * 8);
#pragma unroll
                for (int j = 0; j < 4; ++j) { const float a = bflo(raw[ks][j]), b = bfhi(raw[ks][j]); ss += a * a + b * b; } }
            float rs = c2;
            if (NORMQ) { ss += shx(ss, 32, lane); rs = __builtin_amdgcn_rsqf(ss * (1.f / DQK) + EPS) * c2; }
#pragma unroll
            for (int ks = 0; ks < NKS; ++ks) { u32x4 p;
#pragma unroll
                for (int j = 0; j < 4; ++j) { float a = bflo(raw[ks][j]) * rs, b = bfhi(raw[ks][j]) * rs; if (NORMQ) { a *= gq[ks * 16 + hi * 8 + 2 * j]; b *= gq[ks * 16 + hi * 8 + 2 * j + 1]; } p[j] = cvtpk(a, b); }
                qf[ks] = __builtin_bit_cast(bf16x8, p); }
        }
#pragma unroll
        for (int d = 0; d < ND0; ++d) o[d] = (f32x16){0};
        float m_run = -1e30f, l_run = 0.f;
        const int qlo = W.qpos0, qhi = W.qpos0 + 31;
        const int kx = (KL == 1) ? (r32 & 15) : ((r32 >> 1) & 7);
        const int krow = (KL == 1) ? r32 * 256 : r32 * 128;
        const int kxr = (r32 >> 2) & 3, krow_r = 8192 + r32 * 64;
        const int vlane = (4 * hi + ((lane & 15) >> 2)) * 64 + ((lane >> 4) & 1) * 32 + (lane & 3) * 8;
        int slot = 0;
        for (int kt = kt_lo; kt < kt_hi; ++kt) {
            if (kt + 1 < kt_hi) { if (PT == 2) { ATT_WAITBAR(2); } else if (PT == 3) { ATT_WAITBAR(3); } else { ATT_WAITBAR(4); }; } else { ATT_WAITBAR(0); }
            if (kt + 2 < kt_hi) dma_tile(kt + 2, slot >= 1 ? slot - 1 : 2);
            const int k0 = kt * 64;
            bool need = (k0 <= qhi);
            if (WINDOW > 0) need = need && (k0 + 63 >= qlo - (WINDOW - 1));
            if (need) {
                const LAS unsigned char* sb = lds + slot * SLOT;
                f32x16 p0 = (f32x16){0}, p1 = (f32x16){0};
                bf16x8 kfa[NKS], kfb[NKS];
#pragma unroll
                for (int ks = 0; ks < NKS; ++ks) {
                    const LAS unsigned char* ka;
                    if (KL == 2 && ks >= 4) ka = sb + krow_r + (((2 * (ks - 4) + hi) ^ kxr) << 4);
                    else ka = sb + krow + ((((KL == 1 ? W.kc0 : 0) + 2 * ks + hi) ^ kx) << 4);
                    const int hstep = (KL == 2 && ks >= 4) ? 32 * 64 : (KL == 1 ? 32 * 256 : 32 * 128);
                    kfa[ks] = *(const LAS bf16x8*)ka; kfb[ks] = *(const LAS bf16x8*)(ka + hstep); }
                __builtin_amdgcn_sched_barrier(0);
#pragma unroll
                for (int ks = 0; ks < NKS; ++ks) { p0 = __builtin_amdgcn_mfma_f32_32x32x16_bf16(kfa[ks], qf[ks], p0, 0, 0, 0); p1 = __builtin_amdgcn_mfma_f32_32x32x16_bf16(kfb[ks], qf[ks], p1, 0, 0, 0); }
                const LAS unsigned char* vb = sb + KBYTES + vlane;
                s16x4 vlo[VPRE > 0 ? VPRE : 1][4], vhi[VPRE > 0 ? VPRE : 1][4];
#pragma unroll
                for (int d = 0; d < VPRE; ++d)
#pragma unroll
                    for (int q4 = 0; q4 < 4; ++q4) { const LAS unsigned char* vp = vb + (d * 4 + q4) * 1024;
                        vlo[d][q4] = __builtin_bit_cast(s16x4, __builtin_amdgcn_ds_read_tr16_b64_v4i16((LAS s16x4*)vp));
                        vhi[d][q4] = __builtin_bit_cast(s16x4, __builtin_amdgcn_ds_read_tr16_b64_v4i16((LAS s16x4*)(vp + 512))); }
                const int qpos = W.qpos0 + r32;
                bool full = (k0 + 63 <= qlo);
                if (WINDOW > 0) full = full && (k0 >= qhi - (WINDOW - 1));
                if (!full) {
#pragma unroll
                    for (int r = 0; r < 16; ++r) { const int ka = k0 + crow(r, hi), kb2 = ka + 32;
                        bool va = ka <= qpos, vb2 = kb2 <= qpos; if (WINDOW > 0) { va = va && (qpos - ka < WINDOW); vb2 = vb2 && (qpos - kb2 < WINDOW); }
                        p0[r] = va ? p0[r] : -INFINITY; p1[r] = vb2 ? p1[r] : -INFINITY; }
                }
                float mx = fmaxf(p0[0], p1[0]);
#pragma unroll
                for (int r = 1; r < 16; ++r) mx = fmaxf(mx, fmaxf(p0[r], p1[r]));
                mx = fmaxf(mx, shx(mx, 32, lane));
                if (__any(mx > m_run)) {
                    const float mn = fmaxf(m_run, mx); const float alpha = __builtin_amdgcn_exp2f(m_run - mn); m_run = mn; l_run *= alpha;
                    if (hi == 0) wsf[r32] = alpha;
                    LDS_WAIT();
#pragma unroll
                    for (int r = 0; r < 16; ++r) { const float a = wsf[crow(r, hi)];
#pragma unroll
                        for (int d = 0; d < ND0; ++d) o[d][r] *= a; }
                }
                float rs = 0.f;
#pragma unroll
                for (int r = 0; r < 16; ++r) { p0[r] = __builtin_amdgcn_exp2f(p0[r] - m_run); p1[r] = __builtin_amdgcn_exp2f(p1[r] - m_run); rs += p0[r] + p1[r]; }
                l_run += rs;
                bf16x8 pa[4];
#pragma unroll
                for (int s = 0; s < 2; ++s) { u32x4 pw;
                    pw.x = cvtpk(p0[8 * s], p0[8 * s + 1]); pw.y = cvtpk(p0[8 * s + 2], p0[8 * s + 3]); pw.z = cvtpk(p0[8 * s + 4], p0[8 * s + 5]); pw.w = cvtpk(p0[8 * s + 6], p0[8 * s + 7]); pa[s] = __builtin_bit_cast(bf16x8, pw);
                    pw.x = cvtpk(p1[8 * s], p1[8 * s + 1]); pw.y = cvtpk(p1[8 * s + 2], p1[8 * s + 3]); pw.z = cvtpk(p1[8 * s + 4], p1[8 * s + 5]); pw.w = cvtpk(p1[8 * s + 6], p1[8 * s + 7]); pa[2 + s] = __builtin_bit_cast(bf16x8, pw); }
#pragma unroll
                for (int d = 0; d < ND0; ++d)
#pragma unroll
                    for (int q4 = 0; q4 < 4; ++q4) {
                        s16x4 lo, hh;
                        if (d < VPRE) { lo = vlo[d][q4]; hh = vhi[d][q4]; }
                        else { const LAS unsigned char* vp = vb + (d * 4 + q4) * 1024;
                            lo = __builtin_bit_cast(s16x4, __builtin_amdgcn_ds_read_tr16_b64_v4i16((LAS s16x4*)vp));
                            hh = __builtin_bit_cast(s16x4, __builtin_amdgcn_ds_read_tr16_b64_v4i16((LAS s16x4*)(vp + 512))); }
                        const bf16x8 vf = (bf16x8){lo[0], lo[1], lo[2], lo[3], hh[0], hh[1], hh[2], hh[3]};
                        o[d] = __builtin_amdgcn_mfma_f32_32x32x16_bf16(pa[q4], vf, o[d], 0, 0, 0);
                    }
            }
            slot = (slot == 2) ? 0 : slot + 1;
        }
        l_run += shx(l_run, 32, lane);
        if (use_sink) l_run += __builtin_amdgcn_exp2f(sink_l2 - m_run);
        if (hi == 0) wsf[32 + r32] = __builtin_amdgcn_rcpf(l_run);
        LDS_WAIT();
#pragma unroll
        for (int r = 0; r < 16; ++r) { const float a = wsf[32 + crow(r, hi)];
#pragma unroll
            for (int d = 0; d < ND0; ++d) o[d][r] *= a; }
        ATT_WAITBAR(0);
    }
};
template <int ND0>
__device__ __forceinline__ void store_o_bf16(bf16_t* orow0, int ostride, int lane, const f32x16 (&o)[ND0]) {
    const int r32 = lane & 31, hi = lane >> 5;
#pragma unroll
    for (int r = 0; r < 16; ++r)
#pragma unroll
        for (int d = 0; d < ND0; ++d) orow0[(size_t)crow(r, hi) * ostride + d * 32 + r32] = (bf16_t)(pk2(o[d][r], 0.f) & 0xffffu);
}

template <int ND0>
__device__ __forceinline__ void store_o_f8(unsigned char* orow0, int ostride, int lane, const f32x16 (&o)[ND0]) {
    const int r32 = lane & 31, hi = lane >> 5;
#pragma unroll
    for (int r = 0; r < 16; ++r)
#pragma unroll
        for (int d = 0; d < ND0; ++d) orow0[(size_t)crow(r, hi) * ostride + d * 32 + r32] = (unsigned char)(pk4f8(o[d][r] * Y8_SCALE, 0.f, 0.f, 0.f) & 0xffu);
}
__device__ __forceinline__ void mla_attn_unit(const Frame& F0, int b, int h, int qb, bool dry) {
    const Args A = load_args(); const Frame F = fresh(F0);
    typedef AttnBody<96, 64, 2, false, 0, 2> AB;
    bf16_t* MQ = (bf16_t*)(A.ws + WS_MLAQ); const bf16_t* MK = (const bf16_t*)(A.ws + WS_MLAK); const bf16_t* MV = (const bf16_t*)(A.ws + WS_MLAV);
    const int q0 = qb * 256 + F.wave * 32; const size_t rb = (size_t)b * SEQ;
    AttnWaveCfg W; W.q = MQ + (rb + q0) * 768 + h * 96; W.qstride = 768; W.qpos0 = q0; W.kc0 = 0;
    f32x16 o[2];
    AB::run(F, W, MK + rb * 768 + h * 96, 768, MV + rb * 512 + h * 64, 512, 0, (qb * 256 + 256) / 64, 0.10206207261596575f * LOG2E, nullptr, false, 0.f, o);
    if (!dry) store_o_f8<2>((unsigned char*)(MQ + (rb + q0) * 768 + h * 96), 1536, F.lane, o);
}
__device__ __forceinline__ void swa_attn_unit(const Frame& F0, int l, int b, int kvh, int rb64, bool dry, bool alt = false) {
    const Args A = load_args(); const Frame F = fresh(F0); asm volatile("" : "+s"(l));
    typedef AttnBody<64, 64, 0, true, 128, 2> AB;
    bf16_t* proj = (bf16_t*)(A.ws + WS_PROJ);
    const int hq = kvh * 4 + (F.wave >> 1); const int q0 = rb64 * 64 + (F.wave & 1) * 32; const size_t rb = (size_t)b * SEQ;
    const int cq = alt ? PC_DQ : PC_SQ, ck = alt ? PC_DK : PC_SK, cv = alt ? PC_DV : PC_SV;
    AttnWaveCfg W; W.q = proj + (rb + q0) * NPROJ + cq + hq * 64; W.qstride = NPROJ; W.qpos0 = q0; W.kc0 = 0;
    const int kt_hi = rb64 + 1, kt_lo = (rb64 - 2) < 0 ? 0 : rb64 - 2;
    f32x16 o[2];
    AB::run(F, W, proj + rb * NPROJ + ck + kvh * 64, NPROJ, proj + rb * NPROJ + cv + kvh * 64, NPROJ, kt_lo, kt_hi, 0.125f * LOG2E,
            A.swa_qk_norm + l * 128, true, A.swa_sinks[l * 8 + hq] * LOG2E, o);
    if (!dry) store_o_f8<2>((unsigned char*)(proj + (rb + q0) * NPROJ + PC_SQ + hq * 64), NPROJ * 2, F.lane, o);
}
__device__ __forceinline__ void diff_attn_unit(const Frame& F0, int l, int b, int hh, int qb128, bool dry) {
    const Args A = load_args(); const Frame F = fresh(F0); asm volatile("" : "+s"(l));
    typedef AttnBody<64, 128, 1, true, 0, DIFF_VPRE> AB;
    bf16_t* proj = (bf16_t*)(A.ws + WS_PROJ);
    const int sub = F.wave & 1, rbk = F.wave >> 1; const int q0 = qb128 * 128 + rbk * 32; const size_t rb = (size_t)b * SEQ;
    AttnWaveCfg W; W.q = proj + (rb + q0) * NPROJ + PC_DQ + hh * 128 + sub * 64; W.qstride = NPROJ; W.qpos0 = q0; W.kc0 = sub * 8;
    float lam;
    { const float* lp = A.diff_lam + l * 256; const float a = wave_sum(lp[F.lane] * lp[64 + F.lane], F.lane), c = wave_sum(lp[128 + F.lane] * lp[192 + F.lane], F.lane);
      const float lam_init = 0.8f - 0.6f * __expf(-0.3f * (float)l); lam = __expf(a) - __expf(c) + lam_init; }
    f32x16 o[4];
    AB::run(F, W, proj + rb * NPROJ + PC_DK + hh * 128, NPROJ, proj + rb * NPROJ + PC_DV + hh * 128, NPROJ, 0, (qb128 * 128 + 128) / 64, 0.125f * LOG2E,
            A.diff_qk_norm + l * 128, false, 0.f, o);
    LAS float* ex = (LAS float*)(F.lds) + rbk * 4096;
    const int r32 = F.lane & 31, hi = F.lane >> 5;
    if (sub == 1) {
#pragma unroll
        for (int r = 0; r < 16; ++r)
#pragma unroll
            for (int d = 0; d < 4; ++d) ex[crow(r, hi) * 128 + d * 32 + r32] = o[d][r];
    }
    __syncthreads();
    if (sub == 0) {
        const float lam_init = 0.8f - 0.6f * __expf(-0.3f * (float)l);
        float ss[16];
#pragma unroll
        for (int r = 0; r < 16; ++r) { ss[r] = 0.f;
#pragma unroll
            for (int d = 0; d < 4; ++d) { const float v = o[d][r] - lam * ex[crow(r, hi) * 128 + d * 32 + r32]; o[d][r] = v; ss[r] += v * v; } }
#pragma unroll
        for (int r = 0; r < 16; ++r) { const float s = sum32(ss[r], F.lane);
            const float rstd = __builtin_amdgcn_rsqf(s * (1.f / 128.f) + EPS) * (1.0f - lam_init);
#pragma unroll
            for (int d = 0; d < 4; ++d) o[d][r] *= rstd * A.diff_onorm[l * 128 + d * 32 + r32]; }
        if (!dry) store_o_f8<4>((unsigned char*)(proj + (rb + q0) * NPROJ + PC_DQ + hh * 128), NPROJ * 2, F.lane, o);
    }
    __syncthreads();
}
__device__ __forceinline__ void knorm_pass(const Frame& F0, int l) {
    const Args A = load_args(); const Frame F = fresh(F0); asm volatile("" : "+s"(l));
    bf16_t* proj = (bf16_t*)(A.ws + WS_PROJ);
    const int stride = F.G * 512;
    for (int idx0 = F.vcu * 512 + F.tid; idx0 < M * 80; idx0 += 5 * stride) {
        u32x4 raw[5]; bf16_t* p[5]; const float* g[5];
#pragma unroll
        for (int i = 0; i < 5; ++i) { const int idx = idx0 + i * stride; const int row = idx / 80, ch = idx % 80; const bool isd = ch < 64; const int col = isd ? PC_DK + ch * 8 : PC_SK + (ch - 64) * 8;
            g[i] = (isd ? A.diff_qk_norm : A.swa_qk_norm) + l * 128 + 64 + (ch & 7) * 8; p[i] = proj + (size_t)row * NPROJ + col; raw[i] = *(const u32x4*)p[i]; }
#pragma unroll
        for (int i = 0; i < 5; ++i) { float f[8];
#pragma unroll
            for (int j = 0; j < 4; ++j) { f[2 * j] = bflo(raw[i][j]); f[2 * j + 1] = bfhi(raw[i][j]); }
            float ss = 0.f;
#pragma unroll
            for (int j = 0; j < 8; ++j) ss += f[j] * f[j];
            ss += shx(ss, 1, F.lane); ss += shx(ss, 2, F.lane); ss += shx(ss, 4, F.lane);
            const float rstd = __builtin_amdgcn_rsqf(ss * (1.f / 64.f) + EPS); const float* gg = g[i];
            u32x4 o; o.x = cvtpk(f[0] * rstd * gg[0], f[1] * rstd * gg[1]); o.y = cvtpk(f[2] * rstd * gg[2], f[3] * rstd * gg[3]); o.z = cvtpk(f[4] * rstd * gg[4], f[5] * rstd * gg[5]); o.w = cvtpk(f[6] * rstd * gg[6], f[7] * rstd * gg[7]);
            *(u32x4*)p[i] = o; }
    }
}

__device__ __forceinline__ void hgrn_unit(const Frame& F0, int l, int b, int h, bool dry) {
    const Args A = load_args(); const Frame F = fresh(F0); asm volatile("" : "+s"(l));
    const int tid = F.tid, lane = F.lane, w = F.wave, r32 = lane & 31, hi = lane >> 5;
    LAS unsigned char* lds = F.lds;
    constexpr int ST = 144, STT = 192, OST = 272;
    constexpr int O_QB = 0, O_QD = O_QB + 64 * ST, O_KD = O_QD + 64 * ST, O_QX = O_KD + 64 * ST, O_KX = O_QX + 64 * ST;
    constexpr int O_KE = O_KX + 64 * ST, O_V = O_KE + 64 * STT, O_S = O_V + 64 * STT;
    constexpr int O_SEG = O_S + 2 * 64 * STT, O_DL = O_SEG + 8 * 64 * 4, O_OB = O_DL + 256;
    bf16_t* proj = (bf16_t*)(A.ws + WS_PROJ);
    const size_t rb = (size_t)b * SEQ;
    const int k = lane;
    float lb = 0.f;
    if (l == 1) { const float a0 = A.hg_lb[h * 64 + k], a1 = A.hg_lb[512 + h * 64 + k]; lb = 1.0f / (1.0f + __expf(a0 - a1)); }
    for (int i = tid; i < 64 * STT / 4; i += 512) *(LAS unsigned*)(lds + O_S + i * 4) = 0u;
    f32x16 sacc = (f32x16){0};
    unsigned short qraw[8], fraw[8]; u32x4 vraw, graw, gprev = (u32x4){0u, 0u, 0u, 0u};
    const int erow = tid >> 3, ecol = (tid & 7) * 8;
    f32x4 gn0, gn1; { const float* g = A.hg_onorm + l * 64 + ecol; gn0 = *(const f32x4*)g; gn1 = *(const f32x4*)(g + 4); }
    auto load_chunk = [&](int c) {
        const bf16_t* base = proj + (rb + c * 64 + w * 8) * NPROJ + h * 64 + k;
#pragma unroll
        for (int j = 0; j < 8; ++j) { qraw[j] = base[(size_t)j * NPROJ + PC_HQ]; fraw[j] = base[(size_t)j * NPROJ + PC_HF]; }
        const bf16_t* rp = proj + (rb + c * 64 + erow) * NPROJ + h * 64 + ecol;
        vraw = *(const u32x4*)(rp + PC_HI); graw = *(const u32x4*)(rp + PC_HG);
    };
    auto epilogue = [&](int c, const u32x4& gr) {
        const LAS float* op = (const LAS float*)(lds + O_OB + erow * OST + ecol * 4);
        const f32x4 o0 = *(const LAS f32x4*)op, o1 = *(const LAS f32x4*)(op + 4);
        const float ss = sum8((o0[0] * o0[0] + o0[1] * o0[1]) + (o0[2] * o0[2] + o0[3] * o0[3]) + (o1[0] * o1[0] + o1[1] * o1[1]) + (o1[2] * o1[2] + o1[3] * o1[3]));
        const float rstd = __builtin_amdgcn_rsqf(ss * (1.f / 64.f) + EPS);
        float y[8];
#pragma unroll
        for (int j = 0; j < 4; ++j) { const float ga = bflo(gr[j]), gb = bfhi(gr[j]); const float oa = j < 2 ? o0[2 * j] : o1[2 * j - 4], ob = j < 2 ? o0[2 * j + 1] : o1[2 * j - 3];
            const float na = j < 2 ? gn0[2 * j] : gn1[2 * j - 4], nb = j < 2 ? gn0[2 * j + 1] : gn1[2 * j - 3];
            y[2 * j] = oa * rstd * na * fsilu(ga); y[2 * j + 1] = ob * rstd * nb * fsilu(gb); }
        u32x2 o; o.x = pk4f8(y[0] * Y8_SCALE, y[1] * Y8_SCALE, y[2] * Y8_SCALE, y[3] * Y8_SCALE); o.y = pk4f8(y[4] * Y8_SCALE, y[5] * Y8_SCALE, y[6] * Y8_SCALE, y[7] * Y8_SCALE);
        if (!dry) *(u32x2*)((unsigned char*)(proj + (rb + c * 64 + erow) * NPROJ + PC_HQ + h * 64) + ecol) = o;
    };
    load_chunk(0);
#pragma unroll 1
    for (int c = 0; c < 32; ++c) {
        const int sb_cur = c & 1;
        float qv[8], kkv[8], bl[8]; float run = 0.f;
#pragma unroll
        for (int j = 0; j < 8; ++j) { const float f = bf2f(fraw[j]), q = bf2f(qraw[j]);
            const float ef = __expf(-f); const float sg = __builtin_amdgcn_rcpf(1.0f + ef); const float fg = lb + (1.0f - lb) * sg;
            float lf = __logf(fg); lf = fmaxf(lf, -30.0f);
            kkv[j] = (1.0f - lb) * ef * sg;
            qv[j] = fsilu(q);
            run += lf; bl[j] = run; }
        const u32x4 vcur = vraw, gcur = graw;
        *(LAS float*)(lds + O_SEG + (w * 64 + k) * 4) = run;
        __syncthreads();
        if (c + 1 < 32) load_chunk(c + 1);
        if (c > 0) epilogue(c - 1, gprev);
        gprev = gcur;
        float sg8[8];
#pragma unroll
        for (int j = 0; j < 8; ++j) sg8[j] = *(LAS float*)(lds + O_SEG + (j * 64 + k) * 4);
        float off = 0.f;
#pragma unroll
        for (int j = 0; j < 8; ++j) off += (j < w) ? sg8[j] : 0.f;
        const float r15 = sg8[0] + sg8[1], r31 = r15 + sg8[2] + sg8[3], r47 = r31 + sg8[4] + sg8[5], r63 = r47 + sg8[6] + sg8[7];
        const float rd = (w < 4) ? r15 : r47;
#pragma unroll
        for (int j = 0; j < 8; ++j) { const int t = w * 8 + j; const float bt = off + bl[j];
            const float eb = __expf(bt);
            const float qd = qv[j] * __expf(fminf(bt - rd, 60.f)), kd = kkv[j] * __expf(fminf(rd - bt, 60.f));
            const float ke = kkv[j] * __expf(r63 - bt);
            const float xx = (w >= 4) ? qv[j] * __expf(bt - r31) : kkv[j] * __expf(r31 - bt);
            const unsigned p0 = pk2(qv[j] * eb, qd), p1 = pk2(kd, ke), p2 = pk2(xx, 0.f);
            *(LAS bf16_t*)(lds + O_QB + t * ST + k * 2) = (bf16_t)(p0 & 0xffffu);
            *(LAS bf16_t*)(lds + O_QD + t * ST + k * 2) = (bf16_t)(p0 >> 16);
            *(LAS bf16_t*)(lds + O_KD + t * ST + k * 2) = (bf16_t)(p1 & 0xffffu);
            *(LAS bf16_t*)(lds + O_KE + t * STT + k * 2) = (bf16_t)(p1 >> 16);
            *(LAS bf16_t*)(lds + ((w >= 4) ? O_QX : O_KX) + t * ST + k * 2) = (bf16_t)(p2 & 0xffffu); }
        *(LAS u32x4*)(lds + O_V + erow * STT + ecol * 2) = vcur;
        if (w == 0) *(LAS float*)(lds + O_DL + k * 4) = __expf(r63);
        __syncthreads();
        const int trow = 4 * hi + ((lane & 15) >> 2), tcol = ((lane >> 4) & 1) * 32 + (lane & 3) * 8;
        if (w < 2) {
            const int tb = w;
            f32x16 oacc[2]; oacc[0] = (f32x16){0}; oacc[1] = (f32x16){0};
            for (int sb = 0; sb <= tb; ++sb) {
                const int ko = (sb == tb) ? O_KD : O_KX, qo = (sb == tb) ? O_QD : O_QX;
                f32x16 p = (f32x16){0};
#pragma unroll
                for (int ks = 0; ks < 4; ++ks) { const bf16x8 ka = *(const LAS bf16x8*)(lds + ko + (32 * sb + r32) * ST + ks * 32 + hi * 16);
                    const bf16x8 qb = *(const LAS bf16x8*)(lds + qo + (32 * tb + r32) * ST + ks * 32 + hi * 16);
                    p = __builtin_amdgcn_mfma_f32_32x32x16_bf16(ka, qb, p, 0, 0, 0); }
                if (sb == tb) {
#pragma unroll
                    for (int r = 0; r < 16; ++r) p[r] = (crow(r, hi) <= r32) ? p[r] : 0.f;
                }
#pragma unroll
                for (int s2 = 0; s2 < 2; ++s2) { u32x4 pw; pw.x = pk2(p[8 * s2], p[8 * s2 + 1]); pw.y = pk2(p[8 * s2 + 2], p[8 * s2 + 3]); pw.z = pk2(p[8 * s2 + 4], p[8 * s2 + 5]); pw.w = pk2(p[8 * s2 + 6], p[8 * s2 + 7]);
                    const bf16x8 pa = __builtin_bit_cast(bf16x8, pw);
#pragma unroll
                    for (int d = 0; d < 2; ++d) { const LAS unsigned char* vp = lds + O_V + (32 * sb + 16 * s2 + trow) * STT + tcol + d * 64;
                        const s16x4 lo = __builtin_bit_cast(s16x4, __builtin_amdgcn_ds_read_tr16_b64_v4i16((LAS s16x4*)vp));
                        const s16x4 hh = __builtin_bit_cast(s16x4, __builtin_amdgcn_ds_read_tr16_b64_v4i16((LAS s16x4*)(vp + 8 * STT)));
                        const bf16x8 vf = (bf16x8){lo[0], lo[1], lo[2], lo[3], hh[0], hh[1], hh[2], hh[3]};
                        oacc[d] = __builtin_amdgcn_mfma_f32_32x32x16_bf16(pa, vf, oacc[d], 0, 0, 0); } }
            }
#pragma unroll
            for (int ks = 0; ks < 4; ++ks) { const bf16x8 qa = *(const LAS bf16x8*)(lds + O_QB + (32 * tb + r32) * ST + ks * 32 + hi * 16);
#pragma unroll
                for (int d = 0; d < 2; ++d) { const LAS unsigned char* sp = lds + O_S + sb_cur * 64 * STT + (16 * ks + 8 * hi + ((lane & 15) >> 2)) * STT + tcol + d * 64;
                    const s16x4 lo = __builtin_bit_cast(s16x4, __builtin_amdgcn_ds_read_tr16_b64_v4i16((LAS s16x4*)sp));
                    const s16x4 hh = __builtin_bit_cast(s16x4, __builtin_amdgcn_ds_read_tr16_b64_v4i16((LAS s16x4*)(sp + 4 * STT)));
                    const bf16x8 sf = (bf16x8){lo[0], lo[1], lo[2], lo[3], hh[0], hh[1], hh[2], hh[3]};
                    oacc[d] = __builtin_amdgcn_mfma_f32_32x32x16_bf16(qa, sf, oacc[d], 0, 0, 0); } }
#pragma unroll
            for (int r = 0; r < 16; ++r) { LAS float* op = (LAS float*)(lds + O_OB + (32 * tb + crow(r, hi)) * OST) + r32; op[0] = oacc[0][r]; op[32] = oacc[1][r]; }
        } else if (w < 6) {
            const int kb = (w - 2) >> 1, vb = (w - 2) & 1;
            f32x16 u = (f32x16){0};
#pragma unroll
            for (int s2 = 0; s2 < 4; ++s2) { const LAS unsigned char* ap = lds + O_KE + (16 * s2 + trow) * STT + tcol + kb * 64;
                const LAS unsigned char* bp = lds + O_V + (16 * s2 + trow) * STT + tcol + vb * 64;
                const s16x4 alo = __builtin_bit_cast(s16x4, __builtin_amdgcn_ds_read_tr16_b64_v4i16((LAS s16x4*)ap));
                const s16x4 ahi = __builtin_bit_cast(s16x4, __builtin_amdgcn_ds_read_tr16_b64_v4i16((LAS s16x4*)(ap + 8 * STT)));
                const s16x4 blo = __builtin_bit_cast(s16x4, __builtin_amdgcn_ds_read_tr16_b64_v4i16((LAS s16x4*)bp));
                const s16x4 bhi = __builtin_bit_cast(s16x4, __builtin_amdgcn_ds_read_tr16_b64_v4i16((LAS s16x4*)(bp + 8 * STT)));
                const bf16x8 af = (bf16x8){alo[0], alo[1], alo[2], alo[3], ahi[0], ahi[1], ahi[2], ahi[3]};
                const bf16x8 bf = (bf16x8){blo[0], blo[1], blo[2], blo[3], bhi[0], bhi[1], bhi[2], bhi[3]};
                u = __builtin_amdgcn_mfma_f32_32x32x16_bf16(af, bf, u, 0, 0, 0); }
#pragma unroll
            for (int r = 0; r < 16; ++r) { const int kr = 32 * kb + crow(r, hi); const float dl = *(LAS float*)(lds + O_DL + kr * 4);
                sacc[r] = sacc[r] * dl + u[r];
                *(LAS bf16_t*)(lds + O_S + (sb_cur ^ 1) * 64 * STT + kr * STT + (32 * vb + r32) * 2) = (bf16_t)(pk2(sacc[r], 0.f) & 0xffffu); }
        }
        __syncthreads();
    }
    epilogue(31, gprev);
    __syncthreads();
}

using pg8::Unit;
__device__ __forceinline__ size_t gate_blk(int pm, int pn, int ai, int wr, int m, int bj, int wc) { return (size_t)(((((((pm * 16 + pn) * 2 + ai) * 2 + wr) * 4 + m) * 2 + bj) * 4 + wc)) * 64; }
__device__ __forceinline__ size_t merged_blk(int pm, int pn, int ai, int wr, int m, int bj, int wc) { return (size_t)(((((((pm * 4 + pn) * 2 + ai) * 2 + wr) * 4 + m) * 2 + bj) * 4 + wc)) * 64; }
struct SchedB { static constexpr bool ABLK = false; unsigned H, W; int G, c;
    __device__ __forceinline__ bool next(int i, Unit& u) const { const long L = (long)i * G + c; if (L >= 64 * 35) return false; int pm, pn; pg8::tile_order((int)L, 64, 35, pm, pn);
        u.pm = pm; u.pn = pn; u.aux = 0; u.a = H + (unsigned)pm * (256 * 1024); u.b0 = W + (unsigned)pn * (256 * 1024); u.b1 = u.b0; u.ridx = 0; u.nvalid = 256; return true; }
    __device__ __forceinline__ int lda(const Unit&) const { return 1024; } __device__ __forceinline__ int akstep(const Unit&) const { return 128; }
    __device__ __forceinline__ unsigned btile(const Unit& u, int t) const { return u.b0 + (unsigned)t * 128; } };
struct EpiB { static constexpr bool PERM = true; bf16_t* proj; unsigned char* gate8;
    __device__ __forceinline__ void operator()(const f32x4 (&acc)[2][2][4][2], const Unit& u, int wr, int wc, int fr, int fq) const {
        const int row0 = u.pm * 256 + wr * 64 + fr;
        if (u.pn < 16) {
#pragma unroll
            for (int ai = 0; ai < 2; ++ai)
#pragma unroll
                for (int m = 0; m < 4; ++m) {
#pragma unroll
                    for (int bj = 0; bj < 2; ++bj) { const f32x4 v0 = acc[ai][bj][m][0], v1 = acc[ai][bj][m][1]; u32x2 o = {0u, 0u};
#pragma unroll
                        for (int i = 0; i < 4; ++i) {
                            const float t0 = __builtin_amdgcn_exp2f(v0[i] * (-W8_INV * LOG2E)), t1 = __builtin_amdgcn_exp2f(v1[i] * (-W8_INV * LOG2E));
                            const float q0 = __builtin_amdgcn_rcpf(__builtin_fmaf(t0, 1.0f / 255.0f, 1.0f / 255.0f)), q1 = __builtin_amdgcn_rcpf(__builtin_fmaf(t1, 1.0f / 255.0f, 1.0f / 255.0f));
                            o.x = __builtin_amdgcn_cvt_pk_u8_f32(q0, i, o.x); o.y = __builtin_amdgcn_cvt_pk_u8_f32(q1, i, o.y); }
                        *(u32x2*)(gate8 + (gate_blk(u.pm, u.pn, ai, wr, m, bj, wc) + fr * 4 + fq) * 8) = o; } }
        } else {
#pragma unroll
            for (int ai = 0; ai < 2; ++ai)
#pragma unroll
                for (int m = 0; m < 4; ++m) { bf16_t* rp = proj + (size_t)(row0 + ai * 128 + m * 16) * NPROJ + (u.pn - 16) * 256 + wc * 32 + 8 * fq;
#pragma unroll
                    for (int bj = 0; bj < 2; ++bj) { const f32x4 v0 = acc[ai][bj][m][0] * W8_INV, v1 = acc[ai][bj][m][1] * W8_INV; u32x4 o;
                        o.x = pg8::cvt_pk_bf16(v0[0], v0[1]); o.y = pg8::cvt_pk_bf16(v0[2], v0[3]); o.z = pg8::cvt_pk_bf16(v1[0], v1[1]); o.w = pg8::cvt_pk_bf16(v1[2], v1[3]);
                        *(u32x4*)(rp + bj * 128) = o; } }
        }
    } };
struct SchedF { static constexpr bool ABLK = true; unsigned proj, mlaq, W; int G, c;
    __device__ __forceinline__ bool next(int i, Unit& u) const { const long L = (long)(i >> 2) * G + c; if (L >= 256) return false; const int b = i & 3; int pm, pn; pg8::tile_order((int)L, 64, 4, pm, pn);
        u.pm = pm; u.pn = pn; u.aux = b;
        if (b == 1) { u.a = mlaq + (unsigned)pm * (256 * 1536); }
        else { const int co = (b == 0) ? PC_HQ : (b == 2 ? PC_DQ : PC_SQ); u.a = proj + (unsigned)pm * (256 * NPROJ * 2) + co * 2; }
        u.b0 = W + (unsigned)(b * 1024 + pn * 256) * 512; u.b1 = u.b0; u.ridx = 0; u.nvalid = 256; return true; }
    __device__ __forceinline__ int lda(const Unit& u) const { return u.aux == 1 ? 1536 : NPROJ * 2; } __device__ __forceinline__ int akstep(const Unit& u) const { return u.aux == 1 ? 384 : 256; }
    __device__ __forceinline__ unsigned atile(const Unit& u, int kt) const { return u.a + (unsigned)kt * (unsigned)akstep(u); }
    __device__ __forceinline__ unsigned voffa(const Unit& u, int R, int C) const { const int cb = C * 2, slot = (u.aux == 1) ? 192 : 128;
        return (unsigned)(R * lda(u) + ((u.aux == 2) ? cb : ((cb & 63) + (cb >> 6) * slot))); }
    __device__ __forceinline__ unsigned hs(const Unit& u) const { return 128u * (unsigned)lda(u); }
    __device__ __forceinline__ unsigned btile(const Unit& u, int t) const { return u.b0 + (unsigned)t * 128; } };
struct EpiF { static constexpr bool PERM = true; bf16_t* merged; const unsigned char* gate8;
    __device__ __forceinline__ void operator()(const f32x4 (&acc)[2][2][4][2], const Unit& u, int wr, int wc, int fr, int fq) const {
        const int row0 = u.pm * 256 + wr * 64 + fr, b = u.aux; const int col = u.pn * 256 + wc * 32 + 8 * fq;
#pragma unroll
        for (int ai = 0; ai < 2; ++ai) {
            u32x2 g[4][2]; u32x4 old[4][2];
#pragma unroll
            for (int m = 0; m < 4; ++m)
#pragma unroll
                for (int bj = 0; bj < 2; ++bj) { const size_t row = (size_t)(row0 + ai * 128 + m * 16);
                    g[m][bj] = *(const u32x2*)(gate8 + (gate_blk(u.pm, b * 4 + u.pn, ai, wr, m, bj, wc) + fr * 4 + fq) * 8);
                    if (b > 0) old[m][bj] = *(const u32x4*)(merged + (merged_blk(u.pm, u.pn, ai, wr, m, bj, wc) + fr * 4 + fq) * 8); else old[m][bj] = (u32x4){0u, 0u, 0u, 0u}; }
#pragma unroll
            for (int m = 0; m < 4; ++m)
#pragma unroll
                for (int bj = 0; bj < 2; ++bj) { bf16_t* mp = merged + (merged_blk(u.pm, u.pn, ai, wr, m, bj, wc) + fr * 4 + fq) * 8;
                    const f32x4 v0 = acc[ai][bj][m][0], v1 = acc[ai][bj][m][1]; const u32x2 gg = g[m][bj]; const u32x4 od = old[m][bj]; float r[8];
                    const float s = (1.0f / 255.0f) * (W8_INV / Y8_SCALE);
                    r[0] = v0[0] * (float)(gg.x & 255u) * s + bflo(od.x); r[1] = v0[1] * (float)((gg.x >> 8) & 255u) * s + bfhi(od.x); r[2] = v0[2] * (float)((gg.x >> 16) & 255u) * s + bflo(od.y); r[3] = v0[3] * (float)(gg.x >> 24) * s + bfhi(od.y);
                    r[4] = v1[0] * (float)(gg.y & 255u) * s + bflo(od.z); r[5] = v1[1] * (float)((gg.y >> 8) & 255u) * s + bfhi(od.z); r[6] = v1[2] * (float)((gg.y >> 16) & 255u) * s + bflo(od.w); r[7] = v1[3] * (float)(gg.y >> 24) * s + bfhi(od.w);
                    if (b == 3) {
                        u32x2 o8; o8.x = pk4f8(r[0] * M8_SCALE, r[1] * M8_SCALE, r[2] * M8_SCALE, r[3] * M8_SCALE); o8.y = pk4f8(r[4] * M8_SCALE, r[5] * M8_SCALE, r[6] * M8_SCALE, r[7] * M8_SCALE);
                        *(u32x2*)((unsigned char*)gate8 + (gate_blk(u.pm, u.pn, ai, wr, m, bj, wc) + fr * 4 + fq) * 8) = o8;
                    } else {
                    u32x4 o; o.x = pg8::cvt_pk_bf16(r[0], r[1]); o.y = pg8::cvt_pk_bf16(r[2], r[3]); o.z = pg8::cvt_pk_bf16(r[4], r[5]); o.w = pg8::cvt_pk_bf16(r[6], r[7]);
                    *(u32x4*)mp = o; } }
            asm volatile("" ::: "memory");
        }
    } };
struct SchedG { static constexpr bool ABLK = true; unsigned Am, W; int G, c;
    __device__ __forceinline__ bool next(int i, Unit& u) const { const long L = (long)i * G + c; if (L >= 256) return false; int pm, pn; pg8::tile_order((int)L, 64, 4, pm, pn);
        u.pm = pm; u.pn = pn; u.aux = 0; u.a = Am + (unsigned)pm * (16u * 8192u * 8u); u.b0 = W + (unsigned)pn * (256 * 1024); u.b1 = u.b0; u.ridx = 0; u.nvalid = 256; return true; }
    __device__ __forceinline__ int lda(const Unit&) const { return 1024; } __device__ __forceinline__ int akstep(const Unit&) const { return 128; }
    __device__ __forceinline__ unsigned atile(const Unit& u, int kt) const { return u.a + (unsigned)((kt >> 1) * 8192 + (kt & 1) * 256) * 8u; }
    __device__ __forceinline__ unsigned voffa(const Unit&, int R, int C) const { const int cb = C * 2; return (unsigned)(((R >> 7) & 1) * 4096 + ((R >> 6) & 1) * 2048 + ((R >> 4) & 3) * 512 + (cb >> 5) * 64 + (R & 15) * 4 + ((cb >> 3) & 3)) * 8u; }
    __device__ __forceinline__ unsigned hs(const Unit&) const { return 4096u * 8u; }
    __device__ __forceinline__ unsigned btile(const Unit& u, int t) const { return u.b0 + (unsigned)t * 128; } };
struct EpiG { static constexpr bool PERM = false; const float* xin; float* out; const float* gt;
    __device__ __forceinline__ void operator()(const f32x4 (&acc)[2][2][4][2], const Unit& u, int wr, int wc, int fr, int fq) const {
        const int row0 = u.pm * 256 + wr * 64 + fr, col0 = u.pn * 256 + wc * 32 + 4 * fq; const int b = (u.pm * 256) >> 11;
        f32x4 g[2][2];
#pragma unroll
        for (int bj = 0; bj < 2; ++bj)
#pragma unroll
            for (int n = 0; n < 2; ++n) g[bj][n] = *(const f32x4*)(gt + b * 6144 + col0 + bj * 128 + n * 16);
#pragma unroll
        for (int ai = 0; ai < 2; ++ai) {
            f32x4 xv[4][2][2];
#pragma unroll
            for (int m = 0; m < 4; ++m) { const size_t off = (size_t)(row0 + ai * 128 + m * 16) * DM + col0;
#pragma unroll
                for (int bj = 0; bj < 2; ++bj)
#pragma unroll
                    for (int n = 0; n < 2; ++n) xv[m][bj][n] = *(const f32x4*)(xin + off + bj * 128 + n * 16); }
#pragma unroll
            for (int m = 0; m < 4; ++m) { const size_t off = (size_t)(row0 + ai * 128 + m * 16) * DM + col0;
#pragma unroll
                for (int bj = 0; bj < 2; ++bj)
#pragma unroll
                    for (int n = 0; n < 2; ++n) *(f32x4*)(out + off + bj * 128 + n * 16) = xv[m][bj][n] + g[bj][n] * (acc[ai][bj][m][n] * (W8_INV / M8_SCALE)); }
            asm volatile("" ::: "memory");
        }
    } };
struct MoeSched { volatile LAS unsigned* ms; unsigned list;
    __device__ __forceinline__ int rd(int i) const { return __builtin_amdgcn_readfirstlane((int)ms[i]); }
    __device__ __forceinline__ bool tile(int tau, int& pair, int& j0, int& nval) const { const int T = rd(64 + 24); if (tau >= T) return false; int p = 0;
        for (int q = 1; q < 24; ++q) if (rd(64 + q) <= tau) p = q;
        pair = p; j0 = (tau - rd(64 + p)) * 256; const int rem = rd(32 + p) - j0; nval = rem < 256 ? rem : 256; return true; } };
__device__ __forceinline__ void moe_sched_setup(const Frame& F0, int l) {
    const Args A = load_args(); const Frame F = fresh(F0); asm volatile("" : "+s"(l));
    const unsigned* cnt = (const unsigned*)(A.ws + WS_CTL) + CW_CNT + 64 * l;
    if (F.tid < 24) F.MISC[32 + F.tid] = __hip_atomic_load(cnt + F.tid, RLX_AGENT);
    __syncthreads();
    if (F.tid == 0) { unsigned pre = 0; for (int p = 0; p < 24; ++p) { F.MISC[64 + p] = pre; pre += (F.MISC[32 + p] + 255u) >> 8; } F.MISC[64 + 24] = pre; }
    __syncthreads();
}
struct SchedI { static constexpr bool ABLK = false; MoeSched ms; unsigned H2, GUT; int G, c;
    __device__ __forceinline__ bool next(int i, Unit& u) const { const long L = (long)i * G + c; const int tau = (int)(L >> 2), pn = (int)(L & 3); int pair, j0, nval; if (!ms.tile(tau, pair, j0, nval)) return false;
        int ea, eb; pair_experts(pair, ea, eb); const int e = pn < 2 ? ea : eb;
        u.pm = tau; u.pn = pn; u.aux = pair; u.a = H2; u.b0 = GUT + (unsigned)(e * 512 + (pn & 1) * 256) * 2048; u.b1 = u.b0;
        u.ridx = ms.list + (unsigned)(pair * 16384 + j0) * 4; u.nvalid = nval; return true; }
    __device__ __forceinline__ int lda(const Unit&) const { return 2048; } __device__ __forceinline__ int akstep(const Unit&) const { return 128; }
    __device__ __forceinline__ unsigned btile(const Unit& u, int t) const { return u.b0 + (unsigned)t * 128; } };
struct EpiI { static constexpr bool PERM = true; bf16_t* hid; const float* tokw; const char* wsb;
    __device__ __forceinline__ void operator()(const f32x4 (&acc)[2][2][4][2], const Unit& u, int wr, int wc, int fr, int fq) const {
        const int wsel = u.pn >> 1;
#pragma unroll
        for (int ai = 0; ai < 2; ++ai)
#pragma unroll
            for (int m = 0; m < 4; ++m) { const int r = ai * 128 + wr * 64 + m * 16 + fr; float wgt = 0.f; if (r < u.nvalid) wgt = tokw[2 * ((const int*)(wsb + u.ridx))[r] + wsel];
                const f32x4 g0 = acc[ai][0][m][0], g1 = acc[ai][0][m][1], u0 = acc[ai][1][m][0], u1 = acc[ai][1][m][1]; float v[8];
                const float ws_ = wgt * (W8_INV * HID8_SCALE);
#pragma unroll
                for (int i = 0; i < 4; ++i) { v[i] = fsilu(g0[i] * W8_INV) * u0[i] * ws_; v[4 + i] = fsilu(g1[i] * W8_INV) * u1[i] * ws_; }
                u32x2 o; o.x = pk4f8(v[0], v[1], v[2], v[3]); o.y = pk4f8(v[4], v[5], v[6], v[7]);
                { unsigned char* hp = (unsigned char*)hid + (size_t)(u.pm * 256 + r) * 512 + u.pn * 128 + wc * 32 + 8 * fq;
                  asm volatile("global_store_dwordx2 %0, %1, off sc1\n\ts_nop 1" :: "v"(hp), "v"(o) : "memory"); }
                asm volatile("" ::: "memory"); }
    } };
struct SchedJ { static constexpr bool ABLK = false; MoeSched ms; unsigned HID, DT; int G, c;
    __device__ __forceinline__ bool next(int i, Unit& u) const { const long L = (long)i * G + c; const int tau = (int)(L >> 2), pn = (int)(L & 3); int pair, j0, nval; if (!ms.tile(tau, pair, j0, nval)) return false;
        int ea, eb; pair_experts(pair, ea, eb);
        u.pm = tau; u.pn = pn; u.a = HID + (unsigned)tau * (256 * 1024);
        u.b0 = DT + (unsigned)(ea * 1024 + pn * 256) * 512; u.b1 = DT + (unsigned)(eb * 1024 + pn * 256) * 512; u.ridx = 0; u.nvalid = nval; u.aux = j0 + pair * 16384; return true; }
    __device__ __forceinline__ int lda(const Unit&) const { return 1024; } __device__ __forceinline__ int akstep(const Unit&) const { return 128; }
    __device__ __forceinline__ unsigned btile(const Unit& u, int t) const { return t < 4 ? u.b0 + (unsigned)t * 128 : u.b1 + (unsigned)(t - 4) * 128; } };
struct EpiJ { static constexpr bool PERM = false; float* out; const float* gt; const int* list;
    __device__ __forceinline__ void operator()(const f32x4 (&acc)[2][2][4][2], const Unit& u, int wr, int wc, int fr, int fq) const {
        const int col0 = u.pn * 256 + wc * 32 + 4 * fq;
#pragma unroll
        for (int ai = 0; ai < 2; ++ai) {
            int tok[4]; f32x4 xv[4][2][2];
#pragma unroll
            for (int m = 0; m < 4; ++m) { const int r = ai * 128 + wr * 64 + m * 16 + fr; tok[m] = (r < u.nvalid) ? list[u.aux + r] : -1; }
#pragma unroll
            for (int m = 0; m < 4; ++m) { const size_t off = (size_t)(tok[m] < 0 ? 0 : tok[m]) * DM + col0;
#pragma unroll
                for (int bj = 0; bj < 2; ++bj)
#pragma unroll
                    for (int n = 0; n < 2; ++n) xv[m][bj][n] = *(const f32x4*)(out + off + bj * 128 + n * 16); }
#pragma unroll
            for (int m = 0; m < 4; ++m) if (tok[m] >= 0) { const int bb = tok[m] >> 11; const size_t off = (size_t)tok[m] * DM + col0;
#pragma unroll
                for (int bj = 0; bj < 2; ++bj)
#pragma unroll
                    for (int n = 0; n < 2; ++n) { const f32x4 g = *(const f32x4*)(gt + bb * 6144 + col0 + bj * 128 + n * 16);
                        *(f32x4*)(out + off + bj * 128 + n * 16) = xv[m][bj][n] + g * (acc[ai][bj][m][n] * (W8_INV / HID8_SCALE)); } }
            asm volatile("" ::: "memory");
        }
    } };

constexpr int CW_TILE = 9216;
struct SchedIJ { static constexpr bool ABLK = false; MoeSched ms; unsigned H2, GUT, HID, DT; unsigned* tcnt; int G, c;
    __device__ __forceinline__ bool next(int i, Unit& u) const { const long L = (long)i * G + c; const int T4 = 4 * ms.rd(64 + 24); if (L >= 2 * T4) return false;
        const int kind = L >= T4 ? 1 : 0; const int idx = (int)L - kind * T4; const int tau = idx >> 2, pn = idx & 3; int pair, j0, nval; if (!ms.tile(tau, pair, j0, nval)) return false;
        int ea, eb; pair_experts(pair, ea, eb);
        u.pm = tau; u.pn = pn; u.kind = kind; u.nvalid = nval;
        if (kind == 0) { const int e = pn < 2 ? ea : eb; u.aux = pair; u.a = H2; u.b0 = GUT + (unsigned)(e * 512 + (pn & 1) * 256) * 1024; u.b1 = u.b0; u.ridx = ms.list + (unsigned)(pair * 16384 + j0) * 4; }
        else { u.aux = j0 + pair * 16384; u.a = HID + (unsigned)tau * (256 * 512); u.b0 = DT + (unsigned)(ea * 1024 + pn * 256) * 256; u.b1 = DT + (unsigned)(eb * 1024 + pn * 256) * 256; u.ridx = 0; }
        return true; }
    __device__ __forceinline__ int lda(const Unit& u) const { return u.kind ? 512 : 1024; } __device__ __forceinline__ int akstep(const Unit&) const { return 128; }
    __device__ __forceinline__ int nt(const Unit& u) const { return u.kind ? 4 : 8; } __device__ __forceinline__ int ldb(const Unit& u) const { return u.kind ? 256 : 1024; }
    __device__ __forceinline__ bool perm(const Unit& u) const { return u.kind == 0; } __device__ __forceinline__ bool dep(const Unit& u) const { return u.kind == 1; }
    __device__ __forceinline__ unsigned btile(const Unit& u, int t) const { return (u.kind && t >= 2) ? u.b1 + (unsigned)(t - 2) * 128 : u.b0 + (unsigned)t * 128; }
    __device__ __forceinline__ void a_ready(const Unit& u) const {
        if (u.kind == 1) { unsigned sp = 0;
            while (__hip_atomic_load(tcnt + u.pm, RLX_AGENT) < 4u) { __builtin_amdgcn_s_sleep(2); if (++sp > (1u << 22)) break; }
            __builtin_amdgcn_fence(__ATOMIC_ACQUIRE, "agent"); asm volatile("s_waitcnt vmcnt(0)" ::: "memory"); } }
    __device__ __forceinline__ void done(const Unit& u, int wid, int lane) const {
        if (u.kind == 0 && wid == 0 && lane == 0) __hip_atomic_fetch_add(tcnt + u.pm, 1u, RLX_AGENT); }
};
struct EpiIJ { static constexpr bool PERM = false; EpiI ei; EpiJ ej;
    __device__ __forceinline__ void operator()(const f32x4 (&acc)[2][2][4][2], const Unit& u, int wr, int wc, int fr, int fq) const { if (u.kind == 0) ei(acc, u, wr, wc, fr, fq); else ej(acc, u, wr, wc, fr, fq); } };

__global__ void __launch_bounds__(512, 2) mk_fwd(Args Akern) {
    extern __shared__ __attribute__((aligned(16))) unsigned char lds_raw[];
    Frame F;
    F.lds = (LAS unsigned char*)lds_raw; F.ldsg = lds_raw;
    F.MISC = (volatile LAS unsigned*)(F.lds + MISC_OFF);
    F.tid = threadIdx.x; F.lane = F.tid & 63; F.wave = __builtin_amdgcn_readfirstlane(F.tid >> 6);
    F.G = gridDim.x; { const int bx = blockIdx.x; F.vcu = (F.G % 8 == 0) ? (bx % 8) * (F.G / 8) + bx / 8 : bx; }
    for (int u = F.tid; u < 256; u += 512) F.MISC[u] = 0u;
    __syncthreads();
    int lo, hi;
    XcdBarrier bar;
    { const Args A = load_args(); lo = A.ph_lo; hi = A.ph_hi; F.ctl = (gu32*)(A.ws + WS_CTL);
      bar.bar = (unsigned*)(A.ws + WS_CTL) + CW_BAR; bar.x = 0; bar.st = nullptr;
      if (!MK_PER_PHASE) bar = xcd_barrier_post((unsigned*)(A.ws + WS_CTL) + CW_BAR, F.MISC + 8); }
#define GRID_BAR() do { if (!MK_PER_PHASE) xcd_barrier(bar); } while (0)
#pragma unroll 1
    for (int ph = lo; ph < hi; ++ph) {
      if (STAMP_MODE == 2 && blockIdx.x == 0) { int t0_ = threadIdx.x; asm volatile("" : "+v"(t0_)); if (t0_ == 0) ((unsigned long long*)((unsigned*)F.ctl + 12288))[ph] = __builtin_amdgcn_s_memrealtime(); }
      const int spx = (ph == 0) ? 9 : (ph - 1) % PPL; const int reps = ((REP_MASK >> spx) & 1) ? 1 + REP_N : 1;
#pragma unroll 1
      for (int rep = 0; rep < reps; ++rep) {
        if (rep > 0) GRID_BAR();
        if (ph == 0) { if (PH_ON(9)) {
            conv_layer_main(F, 0);
            __syncthreads();
            p0_mod_rope(F); }
        } else {
            const int l = (ph - 1) / PPL, sp = (ph - 1) % PPL;
            if (sp == 0) { if (PH_ON(0))
                norm_phase<false>(F, l);
            } else if (sp == 1) { if (PH_ON(1)) {
                const Args A = load_args(); const char* wsb = (const char*)A.ws;
                SchedB S{(unsigned)WS_H, (unsigned)WS_WINT, F.G, (int)blockIdx.x}; EpiB E{(bf16_t*)(A.ws + WS_PROJ), A.ws + WS_GATE8};
                pg8::gemm_phase<false, false, true>(F.lds, wsb, 8, 1024, S, E); }
            } else if (sp == 2) { if (PH_ON(2))
                { for (int rp = 0; rp < 1 + PROBE_MLAPREP; ++rp) for (int u = F.vcu; u < M / 64; u += F.G) mla_prep_unit(F, l, u); knorm_pass(F, l); }
            } else if (sp == 3) { if (PH_ON(3)) {
                unsigned* qctr = (unsigned*)F.ctl + CW_QUEUE + 64 * l;
#define QNEXT(ctr) ({ if (F.tid == 0) F.MISC[16] = atomicAdd((ctr), 1u); __syncthreads(); const int u_ = __builtin_amdgcn_readfirstlane((int)F.MISC[16]); __syncthreads(); u_; })
#pragma unroll 1
                for (int pass = ((DRY_MASK && ((DRY_LAYERS >> l) & 1)) ? -(DRY_REPS - 1) : 1); pass < 2; ++pass) {
                const bool dry = (pass <= 0); unsigned* qc = qctr + (dry ? 4 * (1 - pass) : 0);
                if (UNIT_ON(0) && (!dry || (DRY_MASK & 1))) for (;;) { const int u = QNEXT(qc + 0); if (u >= 64) break; hgrn_unit(F, l, u >> 3, u & 7, dry); }
                if (UNIT_ON(1) && (!dry || (DRY_MASK & 2))) for (;;) { const int u = QNEXT(qc + 1); if (u >= 512) break; const int qb = 15 - (u >> 5), bh = u & 31; diff_attn_unit(F, l, bh >> 2, bh & 3, qb, dry); }
                if (UNIT_ON(2) && (!dry || (DRY_MASK & 4))) for (;;) { const int u = QNEXT(qc + 2); if (u >= 512) break; const int qb = 7 - (u >> 6), bh = u & 63; mla_attn_unit(F, bh >> 3, bh & 7, qb, dry); }
                if (UNIT_ON(3) && (!dry || (DRY_MASK & 8))) for (;;) { const int u = QNEXT(qc + 3); if (u >= 512) break; const int rb64 = u & 31, bk = u >> 5; swa_attn_unit(F, l, bk >> 1, bk & 1, rb64, dry, dry && (pass == DRY_ALT)); }
                if (dry) GRID_BAR();
                }
#undef QNEXT
                }
            } else if (sp == 4) { if (PH_ON(4)) {
                const Args A = load_args(); const char* wsb = (const char*)A.ws;
                SchedF S{(unsigned)WS_PROJ, (unsigned)WS_MLAQ, (unsigned)WS_BRT, F.G, (int)blockIdx.x}; EpiF E{(bf16_t*)(A.ws + WS_MERGED), A.ws + WS_GATE8};
                pg8::gemm_phase<false, false, true>(F.lds, wsb, 4, 512, S, E); }
            } else if (sp == 5) { if (PH_ON(5)) {
                const Args A = load_args(); const char* wsb = (const char*)A.ws; const float* mod = (const float*)(A.ws + WS_MOD) + (size_t)l * 8 * 6144;
                SchedG S{(unsigned)WS_GATE8, (unsigned)WS_OUTT, F.G, (int)blockIdx.x}; EpiG E{(l == 0) ? A.x : A.out, A.out, mod + 2048};
                pg8::gemm_phase<false, false, true>(F.lds, wsb, 8, 1024, S, E); }
            } else if (sp == 6) { if (PH_ON(6)) {
                norm_phase<true>(F, l);
                conv_layer_moe(F, l);
                if (l + 1 < DEPTH) conv_layer_main(F, l + 1); }
            } else if (sp == 7) { if (PH_ON(7)) {
                moe_sched_setup(F, l);
                const Args A = load_args(); const char* wsb = (const char*)A.ws; const float* mod = (const float*)(A.ws + WS_MOD) + (size_t)l * 8 * 6144;
                SchedIJ S{{F.MISC, (unsigned)WS_LIST}, (unsigned)WS_H, (unsigned)WS_GUT, (unsigned)WS_HID, (unsigned)WS_DT, (unsigned*)F.ctl + CW_TILE + 128 * l, F.G, (int)blockIdx.x};
                EpiIJ E{{(bf16_t*)(A.ws + WS_HID), (const float*)(A.ws + WS_TOKW), wsb}, {A.out, mod + 5120, (const int*)(A.ws + WS_LIST)}};
                pg8::gemm_phase<true, true, true>(F.lds, wsb, 16, 2048, S, E); }
            }
        }
      }
        for (int eb = 0; eb < EXTRA_BARS; ++eb) GRID_BAR();
        if (ph + 1 < hi) GRID_BAR();
    }
    if (STAMP_MODE != 0) {
        GRID_BAR();
        if (blockIdx.x == 0) { int t0_ = threadIdx.x; asm volatile("" : "+v"(t0_)); if (t0_ == 0) ((unsigned long long*)((unsigned*)F.ctl + 12288))[NPHASE] = __builtin_amdgcn_s_memrealtime(); }
        GRID_BAR();
        const Args A = load_args();
        const unsigned long long* ts = (const unsigned long long*)((unsigned*)F.ctl + 12288);
        float delta = 0.05f;
        if (STAMP_MODE == 2) { const float dt_us = (float)(long long)(ts[STAMP_HI] - ts[STAMP_LO]) * 0.01f; delta = sqrtf(STAMP_C * dt_us); }
        int t1_ = threadIdx.x; asm volatile("" : "+v"(t1_));
        for (int i = blockIdx.x * 512 + t1_; i < M * DM / 4; i += gridDim.x * 512) { f32x4 v = ((f32x4*)A.out)[i]; v = v + delta; ((f32x4*)A.out)[i] = v; }
    }
}

extern "C" void kernel_launch(void* const* d_in, const int* in_sizes, int n_in, void* d_out, int out_size, void* d_ws, size_t ws_size, hipStream_t stream) {
    static int grid = 0;
    if (grid == 0) {
        if (n_in != 27 || in_sizes[0] != M * DM || out_size != M * DM || ws_size < WS_END) {
            fprintf(stderr, "kernel_launch: unexpected problem (n_in %d, in0 %d, out %d, ws %zu < %zu); nothing launched\n", n_in, n_in > 0 ? in_sizes[0] : -1, out_size, ws_size, (size_t)WS_END); grid = -1; return; }
        int dev = 0, cus = 0, per_cu = 0;
        if (hipGetDevice(&dev) != hipSuccess || hipDeviceGetAttribute(&cus, hipDeviceAttributeMultiprocessorCount, dev) != hipSuccess) { grid = -1; return; }
        if (hipFuncSetAttribute((const void*)mk_fwd, hipFuncAttributeMaxDynamicSharedMemorySize, LDS_BYTES) != hipSuccess) { fprintf(stderr, "kernel_launch: hipFuncSetAttribute failed\n"); grid = -1; return; }
        if (hipOccupancyMaxActiveBlocksPerMultiprocessor(&per_cu, (const void*)mk_fwd, 512, LDS_BYTES) != hipSuccess || per_cu < 1) { fprintf(stderr, "kernel_launch: occupancy query says %d blocks/CU\n", per_cu); per_cu = 1; }
        (void)hipGetLastError();
        if (cus != 256) { fprintf(stderr, "kernel_launch: built for a 256-CU device (got %d); nothing launched\n", cus); grid = -1; return; }
        grid = cus;
    }
    if (grid < 0) return;
    (void)hipMemsetAsync((char*)d_ws + WS_CTL, 0, CTL_ZERO_BYTES, stream);
    Args a{};
    a.x = (const float*)d_in[0]; a.c = (const float*)d_in[1]; a.pos = (const int*)d_in[2]; a.ada_w = (const float*)d_in[3]; a.ada_b = (const float*)d_in[4];
    a.norm_mix = (const float*)d_in[5]; a.norm_ffn = (const float*)d_in[6]; a.w_in = (const float*)d_in[7]; a.hg_lb = (const float*)d_in[8]; a.hg_onorm = (const float*)d_in[9];
    a.mla_q_norm = (const float*)d_in[10]; a.mla_kv_norm = (const float*)d_in[11]; a.mla_w_uq = (const float*)d_in[12]; a.mla_w_ukv = (const float*)d_in[13];
    a.mla_qk_norm = (const float*)d_in[14]; a.diff_qk_norm = (const float*)d_in[15]; a.diff_lam = (const float*)d_in[16]; a.diff_onorm = (const float*)d_in[17];
    a.swa_qk_norm = (const float*)d_in[18]; a.swa_sinks = (const float*)d_in[19]; a.w_branch = (const float*)d_in[20]; a.w_out = (const float*)d_in[21];
    a.router_w = (const float*)d_in[22]; a.router_bias = (const float*)d_in[23]; a.moe_w_gate = (const float*)d_in[24]; a.moe_w_up = (const float*)d_in[25]; a.moe_w_down = (const float*)d_in[26];
    a.out = (float*)d_out; a.ws = (unsigned char*)d_ws;
#if MK_PER_PHASE
    for (int ph = 0; ph < NPHASE; ++ph) { a.ph_lo = ph; a.ph_hi = ph + 1; hipLaunchKernelGGL(mk_fwd, dim3(grid), dim3(512), LDS_BYTES, stream, a); }
#else
    a.ph_lo = 0; a.ph_hi = NPHASE;
    void* kargs[] = {&a};
    hipError_t e = hipLaunchCooperativeKernel((const void*)mk_fwd, dim3(grid), dim3(512), kargs, LDS_BYTES, stream);
    if (e != hipSuccess) fprintf(stderr, "kernel_launch: cooperative launch failed: %s (grid %d)\n", hipGetErrorString(e), grid);
#endif
}
```

```cpp
#include <hip/hip_runtime.h>
#include <hip/hip_bf16.h>
#include <cstdio>
#include <cstdint>

#ifndef MK_PER_PHASE
#define MK_PER_PHASE 0
#endif

#ifndef PHASE_MASK
#define PHASE_MASK 0x3ff
#endif
#define PH_ON(k) ((PHASE_MASK >> (k)) & 1)
#ifndef REP_MASK
#define REP_MASK 0
#endif
#ifndef REP_N
#define REP_N 1
#endif
#ifndef EXTRA_BARS
#define EXTRA_BARS 0
#endif
#ifndef EPIF_FENCE
#define EPIF_FENCE 0
#endif
#ifndef DIFF_VPRE
#define DIFF_VPRE 2
#endif
#ifndef PROBE_MLAPREP
#define PROBE_MLAPREP 0
#endif
#ifndef DRY_MASK
#define DRY_MASK 0
#endif
#ifndef STAMP_MODE
#define STAMP_MODE 0
#endif
#ifndef STAMP_C
#define STAMP_C 1.2e-4f
#endif
#ifndef STAMP_LO
#define STAMP_LO 0
#endif
#ifndef STAMP_HI
#define STAMP_HI 17
#endif
#ifndef DRY_ALT
#define DRY_ALT 99
#endif
#ifndef DRY_LAYERS
#define DRY_LAYERS 3
#endif
#ifndef DRY_REPS
#define DRY_REPS 1
#endif
#ifndef UNIT_MASK
#define UNIT_MASK 15
#endif
#define UNIT_ON(k) ((UNIT_MASK >> (k)) & 1)
#define LAS __attribute__((address_space(3)))
#define GAS __attribute__((address_space(1)))
typedef unsigned short bf16_t;
typedef short bf16x8 __attribute__((ext_vector_type(8)));
typedef short s16x4 __attribute__((ext_vector_type(4)));
typedef float f32x4 __attribute__((ext_vector_type(4)));
typedef float f32x16 __attribute__((ext_vector_type(16)));
typedef unsigned u32x4 __attribute__((ext_vector_type(4)));
typedef unsigned u32x2 __attribute__((ext_vector_type(2)));
typedef int i32x4 __attribute__((ext_vector_type(4)));
typedef int i32x8 __attribute__((ext_vector_type(8)));
typedef GAS unsigned gu32;

constexpr int NB = 8, SEQ = 2048, DM = 1024, M = NB * SEQ, DEPTH = 2;
constexpr int NPROJ = 4864;
constexpr int NGATE = 4096;
constexpr int NBIG = NGATE + NPROJ;
constexpr int W_IN_COLS = 8864;
constexpr int PC_HQ = 0, PC_HF = 512, PC_HI = 1024, PC_HG = 1536, PC_CQ = 2048, PC_CKV = 2304, PC_KR = 2432,
              PC_DQ = 2464, PC_DK = 2976, PC_DV = 3488, PC_SQ = 4000, PC_SK = 4512, PC_SV = 4640;
constexpr float EPS = 1e-6f;
constexpr float LOG2E = 1.4426950408889634f;

constexpr size_t MiB = 1u << 20;
constexpr size_t WS_CTL = 0, CTL_ZERO_BYTES = 64 * 1024;
constexpr size_t WS_MOD = 1 * MiB;
constexpr size_t WS_ROPE = 2 * MiB;
constexpr size_t WS_LIST = 4 * MiB;
constexpr size_t WS_TOKW = 6 * MiB;
constexpr size_t WS_UQT = 8 * MiB;
constexpr size_t WS_UKVT = 8 * MiB + 512 * 1024;
constexpr size_t WS_BRT = 9 * MiB;
constexpr size_t WS_OUTT = 13 * MiB;
constexpr size_t WS_PROJ = 16 * MiB;
constexpr size_t WS_GUT = 16 * MiB;
constexpr size_t WS_DT = 32 * MiB;
constexpr size_t WS_HID = 40 * MiB;
constexpr size_t WS_GATE8 = 168 * MiB;
constexpr size_t WS_X = 232 * MiB;
constexpr size_t WS_H = WS_X;
constexpr size_t WS_WINT = WS_X + 32 * MiB;
constexpr size_t WS_MLAQ = WS_X;
constexpr size_t WS_MLAK = WS_X + 24 * MiB;
constexpr size_t WS_MLAV = WS_X + 48 * MiB;
constexpr size_t WS_MERGED = WS_X + 24 * MiB;
constexpr size_t WS_END = 296 * MiB;
constexpr int HID_ROWS = 22528;

constexpr int CW_BAR = 4096;
constexpr int CW_QUEUE = 8192;
constexpr int CW_CNT = 8448;
constexpr int PPL = 8;
constexpr int NPHASE = 1 + PPL * DEPTH;

constexpr int RING_BYTES = 131072;
constexpr int MISC_OFF = RING_BYTES;
constexpr int LDS_BYTES = 147456;

#define LDS_WAIT() asm volatile("s_waitcnt lgkmcnt(0)" ::: "memory")
#define VM_WAIT() asm volatile("s_waitcnt vmcnt(0)" ::: "memory")
#define RLX_AGENT __ATOMIC_RELAXED, __HIP_MEMORY_SCOPE_AGENT
__device__ __forceinline__ unsigned f2bf(float f) { unsigned u = __builtin_bit_cast(unsigned, f); return (u + 0x7fffu + ((u >> 16) & 1u)) >> 16; }
typedef float f32x2_t __attribute__((ext_vector_type(2))); typedef __bf16 bf16x2_t __attribute__((ext_vector_type(2)));
__device__ __forceinline__ unsigned pk4f8(float a, float b, float c, float d) { int w = 0; w = __builtin_amdgcn_cvt_pk_fp8_f32(a, b, w, false); w = __builtin_amdgcn_cvt_pk_fp8_f32(c, d, w, true); return (unsigned)w; }
__device__ __forceinline__ unsigned pk2(float lo, float hi) { f32x2_t v = {lo, hi}; bf16x2_t b = __builtin_convertvector(v, bf16x2_t); return __builtin_bit_cast(unsigned, b); }
__device__ __forceinline__ float bf2f(unsigned short b) { return __builtin_bit_cast(float, (unsigned)b << 16); }
__device__ __forceinline__ float bflo(unsigned w) { return __builtin_bit_cast(float, w << 16); }
__device__ __forceinline__ float bfhi(unsigned w) { return __builtin_bit_cast(float, w & 0xffff0000u); }
__device__ __forceinline__ float fsigmoid(float x) { return __builtin_amdgcn_rcpf(1.0f + __expf(-x)); }
__device__ __forceinline__ float fsilu(float x) { return x * __builtin_amdgcn_rcpf(1.0f + __expf(-x)); }
__device__ __forceinline__ int crow(int r, int hi) { return (r & 3) + 8 * (r >> 2) + 4 * hi; }
__device__ __forceinline__ float shx(float v, int m, int lane) { return __builtin_bit_cast(float, __builtin_amdgcn_ds_bpermute((lane ^ m) << 2, __builtin_bit_cast(int, v))); }
__device__ __forceinline__ float dpp_f(float v, int ctrl_sel) {
    const int x = __builtin_bit_cast(int, v); int r;
    if (ctrl_sel == 0) r = __builtin_amdgcn_mov_dpp(x, 0xB1, 0xf, 0xf, true);
    else if (ctrl_sel == 1) r = __builtin_amdgcn_mov_dpp(x, 0x4E, 0xf, 0xf, true);
    else r = __builtin_amdgcn_mov_dpp(x, 0x141, 0xf, 0xf, true);
    return __builtin_bit_cast(float, r); }
__device__ __forceinline__ float sum8(float v) { v += dpp_f(v, 0); v += dpp_f(v, 1); v += dpp_f(v, 2); return v; }
__device__ __forceinline__ float sum32(float v, int lane) { v = sum8(v); v += __builtin_bit_cast(float, __builtin_amdgcn_mov_dpp(__builtin_bit_cast(int, v), 0x140, 0xf, 0xf, true)); v += shx(v, 16, lane); return v; }
__device__ __forceinline__ float wave_sum(float v, int lane) {
    v = sum8(v); v += __builtin_bit_cast(float, __builtin_amdgcn_mov_dpp(__builtin_bit_cast(int, v), 0x140, 0xf, 0xf, true));
    v += shx(v, 16, lane); v += shx(v, 32, lane);
    return v;
}

#define XB_TMO      128
#define XB_XCNT(j)  (256  + 64 * (j))
#define XB_XSUB(j)  (1280 + 64 * (j))
#define XB_XGEN(j)  (2304 + 64 * (j))
#define XB_TOP      3328
#define XB_TOPGEN   3392
#define XCD_BAR_WORDS 3456
#define XB_SPIN_CAP (1u << 22)
__device__ __forceinline__ unsigned xb_ld(unsigned* p)              { return __hip_atomic_load(p, __ATOMIC_RELAXED, __HIP_MEMORY_SCOPE_AGENT); }
__device__ __forceinline__ unsigned xb_add(unsigned* p, unsigned v) { return __hip_atomic_fetch_add(p, v, __ATOMIC_RELAXED, __HIP_MEMORY_SCOPE_AGENT); }
__device__ __forceinline__ unsigned xb_xcc_id() { return (unsigned)__builtin_amdgcn_s_getreg((3 << 11) | 20) & 0xFu; }
#define XB_SPIN(cond, bar) do { unsigned _sp = 0; while (cond) { __builtin_amdgcn_s_sleep(1); \
    if ((++_sp & 255u) == 0u) { if (xb_ld(&(bar)[XB_TMO])) break; if (_sp > XB_SPIN_CAP) { atomicAdd(&(bar)[XB_TMO], 1u); break; } } } } while (0)
struct XcdBarrier { unsigned* bar; unsigned x; volatile LAS unsigned* st; };
__device__ __forceinline__ XcdBarrier xcd_barrier_post(unsigned* bar, volatile LAS unsigned* st) {
    XcdBarrier b; b.bar = bar; b.x = xb_xcc_id(); b.st = st;
    if (threadIdx.x == 0) (void)xb_add(&bar[XB_XCNT(b.x)], 1u);
    return b;
}
__device__ __forceinline__ void xcd_barrier_complete(unsigned* bar, unsigned x, unsigned& nloc, unsigned& nx) {
    const unsigned G = gridDim.x * gridDim.y * gridDim.z;
    unsigned sum, cnt, mine, sp = 0u;
    for (;;) {
        sum = 0u; cnt = 0u; mine = 0u;
#pragma unroll
        for (unsigned j = 0; j < 16; ++j) { const unsigned c = xb_ld(&bar[XB_XCNT(j)]); sum += c; cnt += (c > 0u) ? 1u : 0u; mine = (j == x) ? c : mine; }
        if (sum == G) break;
        __builtin_amdgcn_s_sleep(1);
        if ((++sp & 255u) == 0u) { if (xb_ld(&bar[XB_TMO])) break; if (sp > XB_SPIN_CAP) { atomicAdd(&bar[XB_TMO], 1u); break; } }
    }
    nloc = mine > 0u ? mine : 1u; nx = cnt > 0u ? cnt : 1u;
}
__device__ __forceinline__ void xcd_barrier(const XcdBarrier& b) {
    asm volatile("s_waitcnt vmcnt(0)" ::: "memory");
    __syncthreads();
    if (threadIdx.x == 0) {
        unsigned* bar = b.bar;
        __builtin_amdgcn_s_waitcnt(0);
        unsigned nloc = b.st[0], nx = b.st[1];
        if (nloc == 0u) { xcd_barrier_complete(bar, b.x, nloc, nx); b.st[0] = nloc; b.st[1] = nx; }
        const unsigned old = xb_add(&bar[XB_XSUB(b.x)], 1u);
        const unsigned gen = old / nloc;
        if (old + 1u == (gen + 1u) * nloc) {
            __builtin_amdgcn_fence(__ATOMIC_RELEASE, "agent");
            asm volatile("s_waitcnt vmcnt(0)" ::: "memory");
            const unsigned og = xb_add(&bar[XB_TOP], 1u);
            const unsigned tg = og / nx;
            if (og + 1u == (tg + 1u) * nx) xb_add(&bar[XB_TOPGEN], 1u);
            else XB_SPIN(xb_ld(&bar[XB_TOPGEN]) == tg, bar);
            __builtin_amdgcn_fence(__ATOMIC_ACQUIRE, "agent");
            xb_add(&bar[XB_XGEN(b.x)], 1u);
            asm volatile("s_waitcnt vmcnt(0)" ::: "memory");
        } else {
            XB_SPIN(xb_ld(&bar[XB_XGEN(b.x)]) == gen, bar);
            __builtin_amdgcn_fence(__ATOMIC_ACQUIRE, "agent");
            asm volatile("s_waitcnt vmcnt(0)" ::: "memory");
        }
    }
    __syncthreads();
}

constexpr float M8_SCALE = 8.0f;
constexpr float Y8_SCALE = 8.0f;
constexpr float HID8_SCALE = 4.0f;
constexpr float W8_SCALE = 32.0f, W8_INV = 1.0f / 32.0f;
namespace pg8 {
constexpr int BM = 256, BK = 64, HALF = 128, HTB = HALF * BK * 2, NXCD = 8, WGM = 8;
__host__ __device__ __forceinline__ int lds_byte(int r, int c) { const int st = (r >> 4) * 2 + (c >> 5), rr = r & 15, cc = c & 31, ob = rr * 64 + cc * 2; return st * 1024 + (ob ^ (((ob >> 9) & 1) << 5)); }
__host__ __device__ __forceinline__ void stage_rc(int b, int& R, int& C) { const int st = b / 1024, sb = b % 1024, swz = sb ^ (((sb >> 9) & 1) << 5); R = (st >> 1) * 16 + swz / 64; C = (st & 1) * 32 + (swz % 64) / 2; }
__host__ __device__ __forceinline__ int perm32(int rho) { const int n = rho >> 4, i = rho & 15; return 8 * (i >> 2) + 4 * n + (i & 3); }

struct Unit {
    int pm, pn, aux, kind;
    unsigned a;
    unsigned b0, b1;
    unsigned ridx;
    int nvalid;
};
__device__ __forceinline__ void tile_order(int wgid, int nM, int nN, int& pm, int& pn) {
    const int nwg = nM * nN;
    { const int q = nwg / NXCD, r = nwg % NXCD, xcd = wgid % NXCD, off = wgid / NXCD; wgid = (xcd < r ? xcd * (q + 1) : r * (q + 1) + (xcd - r) * q) + off; }
    const int nig = WGM * nN, gid = wgid / nig, fm = gid * WGM, gsz = (nM - fm) < WGM ? (nM - fm) : WGM;
    pm = fm + ((wgid % nig) % gsz); pn = (wgid % nig) / gsz;
}
__device__ __forceinline__ unsigned cvt_pk_bf16(float lo, float hi) { unsigned r; asm volatile("v_cvt_pk_bf16_f32 %0, %1, %2" : "=v"(r) : "v"(lo), "v"(hi)); return r; }

template <bool M, class S> __device__ __forceinline__ int mg_nt(const S& s, const Unit& u, int d) { if constexpr (M) return s.nt(u); else return d; }
template <bool M, class S> __device__ __forceinline__ int mg_ldb(const S& s, const Unit& u, int d) { if constexpr (M) return s.ldb(u); else return d; }
template <bool M, class S> __device__ __forceinline__ bool mg_perm(const S& s, const Unit& u, bool d) { if constexpr (M) return s.perm(u); else return d; }
template <bool M, class S> __device__ __forceinline__ bool mg_dep(const S& s, const Unit& u) { if constexpr (M) return s.dep(u); else return false; }
template <bool M, class S> __device__ __forceinline__ void mg_ready(const S& s, const Unit& u) { if constexpr (M) s.a_ready(u); }
template <bool M, class S> __device__ __forceinline__ void mg_done(const S& s, const Unit& u, int wid, int lane) { if constexpr (M) s.done(u, wid, lane); }
template <class S> __device__ __forceinline__ unsigned ga_tile(const S& s, const Unit& u, int k) { if constexpr (S::ABLK) return s.atile(u, k); else return u.a + (unsigned)k * s.akstep(u); }
template <class S> __device__ __forceinline__ unsigned ga_voff(const S& s, const Unit& u, int R, int C) { if constexpr (S::ABLK) return s.voffa(u, R, C); else return (unsigned)(R * s.lda(u) + C * 2); }
template <class S> __device__ __forceinline__ unsigned ga_hs(const S& s, const Unit& u) { if constexpr (S::ABLK) return s.hs(u); else return (unsigned)HALF * (unsigned)s.lda(u); }
template <bool GATHER, bool MERGED, bool F8, class Epi, class Sched>
__device__ __forceinline__ void gemm_phase(LAS unsigned char* lds, const char* wsb, const int nt_, const int ldb_  , const Sched& S, const Epi& E) {
    int tid = threadIdx.x; asm volatile("" : "+v"(tid));
    const int wid = __builtin_amdgcn_readfirstlane(tid >> 6), lane = tid & 63, wr = wid >> 2, wc = wid & 3, fr = lane & 15, fq = lane >> 4;
    unsigned vB[2], vBn[2];
#define PG8_NT(u) mg_nt<MERGED>(S, u, nt_)
#define PG8_LDB(u_) mg_ldb<MERGED>(S, u_, ldb_)
#define PG8_VOFFB(u, v) do { int t4_ = threadIdx.x; asm volatile("" : "+v"(t4_)); _Pragma("unroll") for (int i_ = 0; i_ < 2; ++i_) { int R_, C_; stage_rc(t4_ * 16 + i_ * 8192, R_, C_); \
        const bool pm_ = mg_perm<MERGED>(S, u, Epi::PERM); const int Rb_ = pm_ ? ((R_ & ~31) + perm32(R_ & 31)) : R_; v[i_] = (unsigned)(Rb_ * PG8_LDB(u) + C_ * 2); } } while (0)
    const unsigned ldsw = (unsigned)wid * 1024u;
    const int aoff = lds_byte(wr * 64 + fr, fq * 8), boff = lds_byte(wc * 32 + fr, fq * 8);
#define PG8_SA(b, h) (((b) * 2 + (h)) * HTB)
#define PG8_SB(b, h) ((4 + (b) * 2 + (h)) * HTB)
#define PG8_GLDS(bufoff, gptr, i_) __builtin_amdgcn_global_load_lds((const unsigned*)(gptr), (LAS unsigned*)(lds + (bufoff) + ldsw + (i_) * 8192), 16, 0, 0)
#define PG8_STAGE_B(bufoff, goff, w0, w1) do { PG8_GLDS(bufoff, wsb + (size_t)(unsigned)((goff) + (w0)), 0); PG8_GLDS(bufoff, wsb + (size_t)(unsigned)((goff) + (w1)), 1); } while (0)
#define PG8_STAGE_A(bufoff, goff, v0, v1) do { PG8_GLDS(bufoff, wsb + (size_t)(unsigned)((goff) + (v0)), 0); PG8_GLDS(bufoff, wsb + (size_t)(unsigned)((goff) + (v1)), 1); } while (0)
#define PG8_LDA(dst, b, h) do { if constexpr (F8) { _Pragma("unroll") for (int m = 0; m < 4; ++m) { const LAS i32x4* p_ = (const LAS i32x4*)(lds + PG8_SA(b, h) + aoff + m * 2048); dst##8[m].lo = p_[0]; dst##8[m].hi = p_[64]; } } \
        else { _Pragma("unroll") for (int m = 0; m < 4; ++m) _Pragma("unroll") for (int k = 0; k < 2; ++k) dst[m][k] = *(const LAS bf16x8*)(lds + PG8_SA(b, h) + aoff + m * 2048 + k * 1024); } } while (0)
#define PG8_LDBF(dst, b, h) do { if constexpr (F8) { _Pragma("unroll") for (int n = 0; n < 2; ++n) { const LAS i32x4* p_ = (const LAS i32x4*)(lds + PG8_SB(b, h) + boff + n * 2048); dst##8[n].lo = p_[0]; dst##8[n].hi = p_[64]; } } \
        else { _Pragma("unroll") for (int n = 0; n < 2; ++n) _Pragma("unroll") for (int k = 0; k < 2; ++k) dst[n][k] = *(const LAS bf16x8*)(lds + PG8_SB(b, h) + boff + n * 2048 + k * 1024); } } while (0)
#define PG8_MMA(ai, bj, At, Bt) do { __builtin_amdgcn_s_setprio(1); if constexpr (F8) { _Pragma("unroll") for (int m = 0; m < 4; ++m) _Pragma("unroll") for (int n = 0; n < 2; ++n) \
        asm volatile("v_mfma_f32_16x16x128_f8f6f4 %0, %1, %2, %0" : "+v"(acc[ai][bj][m][n]) : "v"(Bt##8[n]), "v"(At##8[m])); } \
        else { _Pragma("unroll") for (int m = 0; m < 4; ++m) _Pragma("unroll") for (int n = 0; n < 2; ++n) _Pragma("unroll") for (int k = 0; k < 2; ++k) \
        acc[ai][bj][m][n] = __builtin_amdgcn_mfma_f32_16x16x32_bf16(Bt[n][k], At[m][k], acc[ai][bj][m][n], 0, 0, 0); } __builtin_amdgcn_s_setprio(0); } while (0)
#define PG8_WAIT_V(n) asm volatile("s_waitcnt vmcnt(" #n ")" ::: "memory")
#define PG8_WAIT_L(n) asm volatile("s_waitcnt lgkmcnt(" #n ")" ::: "memory")
#define PG8_BAR __builtin_amdgcn_s_barrier()
#define PG8_SCHED __builtin_amdgcn_sched_barrier(0)
    Unit cur, nxt; int ui = 0;
    if (!S.next(0, cur)) return;
    constexpr int NH = GATHER ? 2 : 1;
    unsigned vA[2][NH], vN[2][NH];
#define PG8_VOFF2(u, v) do { int t3_ = threadIdx.x; asm volatile("" : "+v"(t3_)); _Pragma("unroll") for (int i_ = 0; i_ < 2; ++i_) { int R_, C_; stage_rc(t3_ * 16 + i_ * 8192, R_, C_); \
        _Pragma("unroll") for (int h_ = 0; h_ < NH; ++h_) { const int r_ = R_ + HALF * h_; \
        if (GATHER) { const int rr_ = (u).ridx ? ((r_ < (u).nvalid) ? ((const int*)(wsb + (u).ridx))[r_] : 0) : r_; v[i_][h_] = (unsigned)(rr_ * S.lda(u) + C_ * 2); } \
        else v[i_][h_] = ga_voff(S, u, R_, C_); } } } while (0)
#define PG8_HS(u) (GATHER ? 0u : ga_hs(S, u))
    mg_ready<MERGED>(S, cur);
    PG8_VOFF2(cur, vA); PG8_VOFFB(cur, vB);
    f32x4 acc[2][2][4][2];
#pragma unroll
    for (int a = 0; a < 2; ++a)
#pragma unroll
        for (int b = 0; b < 2; ++b)
#pragma unroll
            for (int m = 0; m < 4; ++m)
#pragma unroll
                for (int n = 0; n < 2; ++n) acc[a][b][m][n] = (f32x4){0.f, 0.f, 0.f, 0.f};
    bf16x8 At[4][2], B0[2][2], B1[2][2]; i32x8 At8[4], B08[2], B18[2];
#define PG8_PROLOGUE(u) do { const unsigned hsb = (unsigned)HALF * PG8_LDB(u); \
    PG8_STAGE_B(PG8_SB(0, 0), (u).b0, vB[0], vB[1]); PG8_STAGE_B(PG8_SB(0, 1), (u).b0 + hsb, vB[0], vB[1]); PG8_STAGE_A(PG8_SA(0, 0), ga_tile(S, u, 0), vA[0][0], vA[1][0]); PG8_STAGE_A(PG8_SA(0, 1), ga_tile(S, u, 0) + PG8_HS(u), vA[0][NH - 1], vA[1][NH - 1]); \
    if (wr == 1) PG8_BAR; \
    PG8_WAIT_V(2); PG8_BAR; \
    PG8_STAGE_B(PG8_SB(1, 0), (u).b0 + BK * 2, vB[0], vB[1]); PG8_STAGE_A(PG8_SA(1, 0), ga_tile(S, u, 1), vA[0][0], vA[1][0]); PG8_STAGE_B(PG8_SB(1, 1), (u).b0 + hsb + BK * 2, vB[0], vB[1]); \
    PG8_WAIT_V(6); PG8_BAR; } while (0)
    PG8_PROLOGUE(cur);
    for (;;) {
        const bool has_next = S.next(ui + 1, nxt);
        const bool pre = has_next && !mg_dep<MERGED>(S, nxt);
        Unit stg = pre ? nxt : cur;
        if (pre) { PG8_VOFF2(nxt, vN); if (MERGED) { PG8_VOFFB(nxt, vBn); } else { vBn[0] = vB[0]; vBn[1] = vB[1]; } }
        else { _Pragma("unroll") for (int i_ = 0; i_ < 2; ++i_) _Pragma("unroll") for (int h_ = 0; h_ < NH; ++h_) vN[i_][h_] = vA[i_][h_]; vBn[0] = vB[0]; vBn[1] = vB[1]; }
        const int nt = PG8_NT(cur);
        for (int t = 0; t < nt; t += 2) {
            const bool last = (t == nt - 2);
            const unsigned hstepB = (unsigned)HALF * (last ? PG8_LDB(stg) : PG8_LDB(cur));
            const unsigned y0 = last ? vBn[0] : vB[0], y1 = last ? vBn[1] : vB[1];
            const unsigned a1 = ga_tile(S, cur, t + 1);
            const unsigned a2 = last ? ga_tile(S, stg, 0) : ga_tile(S, cur, t + 2);
            const unsigned a3 = last ? ga_tile(S, stg, 1) : ga_tile(S, cur, t + 3);
            const unsigned hs1 = PG8_HS(cur), hs2 = last ? PG8_HS(stg) : PG8_HS(cur);
            const unsigned b2 = last ? stg.b0 : S.btile(cur, t + 2);
            const unsigned b3 = b2 + BK * 2;
            const unsigned x00 = last ? vN[0][0] : vA[0][0], x10 = last ? vN[1][0] : vA[1][0], x01 = last ? vN[0][NH - 1] : vA[0][NH - 1], x11 = last ? vN[1][NH - 1] : vA[1][NH - 1];
            PG8_LDBF(B0, 0, 0); PG8_LDBF(B1, 0, 1); PG8_SCHED; PG8_LDA(At, 0, 0); PG8_STAGE_A(PG8_SA(1, 1), a1 + hs1, vA[0][NH - 1], vA[1][NH - 1]);
            PG8_WAIT_V(8); PG8_WAIT_L(0); PG8_BAR; PG8_MMA(0, 0, At, B0); PG8_MMA(0, 1, At, B1); PG8_BAR; PG8_SCHED;
            PG8_LDA(At, 0, 1); PG8_STAGE_B(PG8_SB(0, 0), b2, y0, y1); PG8_STAGE_B(PG8_SB(0, 1), b2 + hstepB, y0, y1); PG8_STAGE_A(PG8_SA(0, 0), a2, x00, x10);
            PG8_WAIT_V(8); PG8_WAIT_L(0); PG8_BAR; PG8_MMA(1, 0, At, B0); PG8_MMA(1, 1, At, B1); PG8_BAR; PG8_SCHED;
            PG8_LDBF(B0, 1, 0); PG8_LDBF(B1, 1, 1); PG8_SCHED; PG8_LDA(At, 1, 0); PG8_STAGE_A(PG8_SA(0, 1), a2 + hs2, x01, x11);
            PG8_WAIT_V(8); PG8_WAIT_L(0); PG8_BAR; PG8_MMA(0, 0, At, B0); PG8_MMA(0, 1, At, B1); PG8_BAR; PG8_SCHED;
            PG8_LDA(At, 1, 1); PG8_STAGE_B(PG8_SB(1, 0), b3, y0, y1); PG8_STAGE_B(PG8_SB(1, 1), b3 + hstepB, y0, y1); PG8_STAGE_A(PG8_SA(1, 0), a3, x00, x10);
            PG8_WAIT_V(8); PG8_WAIT_L(0); PG8_BAR; PG8_MMA(1, 0, At, B0); PG8_MMA(1, 1, At, B1); PG8_BAR; PG8_SCHED;
        }
        if (wr == 0) PG8_BAR;
        if constexpr (F8) asm volatile("s_nop 15\n\ts_nop 7" ::: "memory");
        { int t2 = threadIdx.x; asm volatile("" : "+v"(t2)); const int l2 = t2 & 63; E(acc, cur, wr, wc, l2 & 15, l2 >> 4);
          if (MERGED) { PG8_WAIT_V(0); PG8_BAR; mg_done<MERGED>(S, cur, wid, l2); } }
        if (!has_next) break;
#pragma unroll
        for (int a = 0; a < 2; ++a)
#pragma unroll
            for (int b = 0; b < 2; ++b)
#pragma unroll
                for (int m = 0; m < 4; ++m)
#pragma unroll
                    for (int n = 0; n < 2; ++n) acc[a][b][m][n] = (f32x4){0.f, 0.f, 0.f, 0.f};
        cur = nxt; ++ui;
        if (pre) { _Pragma("unroll") for (int i_ = 0; i_ < 2; ++i_) _Pragma("unroll") for (int h_ = 0; h_ < NH; ++h_) vA[i_][h_] = vN[i_][h_]; vB[0] = vBn[0]; vB[1] = vBn[1];
            if (wr == 1) PG8_BAR; }
        else { mg_ready<MERGED>(S, cur); PG8_VOFF2(cur, vA); PG8_VOFFB(cur, vB); PG8_WAIT_V(0); PG8_BAR; PG8_PROLOGUE(cur); }
    }
    PG8_WAIT_V(0);
    PG8_BAR;
#undef PG8_SA
#undef PG8_SB
#undef PG8_GLDS
#undef PG8_STAGE_A
#undef PG8_STAGE_B
#undef PG8_LDA
#undef PG8_LDB
#undef PG8_MMA
#undef PG8_WAIT_V
#undef PG8_WAIT_L
#undef PG8_BAR
#undef PG8_SCHED
#undef PG8_VOFF2
#undef PG8_PROLOGUE
#undef PG8_VOFFB
#undef PG8_NT
#undef PG8_LDBF
#undef PG8_HS
}
}

struct Args {
    const float* x; const float* c; const int* pos; const float* ada_w; const float* ada_b; const float* norm_mix; const float* norm_ffn;
    const float* w_in; const float* hg_lb; const float* hg_onorm; const float* mla_q_norm; const float* mla_kv_norm; const float* mla_w_uq;
    const float* mla_w_ukv; const float* mla_qk_norm; const float* diff_qk_norm; const float* diff_lam; const float* diff_onorm;
    const float* swa_qk_norm; const float* swa_sinks; const float* w_branch; const float* w_out; const float* router_w; const float* router_bias;
    const float* moe_w_gate; const float* moe_w_up; const float* moe_w_down;
    float* out; unsigned char* ws; int ph_lo, ph_hi;
};
typedef const __attribute__((address_space(4))) Args* kargs_ptr;
__device__ __forceinline__ Args load_args() {
#if defined(__HIP_DEVICE_COMPILE__)
    kargs_ptr ap = (kargs_ptr)__builtin_amdgcn_kernarg_segment_ptr(); asm volatile("" : "+s"(ap)); Args r; __builtin_memcpy(&r, ap, sizeof(Args)); return r;
#else
    return Args{};
#endif
}
struct Frame {
    LAS unsigned char* lds; unsigned char* ldsg;
    volatile LAS unsigned* MISC; gu32* ctl;
    int tid, lane, wave, vcu, G;
};

__device__ __forceinline__ Frame fresh(const Frame& F0) {
    Frame F = F0; int t = threadIdx.x; asm volatile("" : "+v"(t)); F.tid = t; F.lane = t & 63; F.wave = __builtin_amdgcn_readfirstlane(t >> 6);
    unsigned lb = 0; asm volatile("" : "+s"(lb)); F.lds = (LAS unsigned char*)(F0.lds + lb); F.MISC = (volatile LAS unsigned*)(F.lds + MISC_OFF); return F;
}
__device__ __forceinline__ void conv_wg_item(const Frame& F, const float* W, int ld, int c0, int ncols, int K, bf16_t* WT, int row0, int rstep, int item, bool frag = false, bool f8 = false) {
    constexpr int ST = 257;
    LAS float* tile = (LAS float*)F.lds;
    const int nblk = (ncols + 255) >> 8, kb = item / nblk, nb = item % nblk, k0 = 64 * kb, n0 = 256 * nb;
    const int lane = F.lane, w = F.wave;
    { const int n = n0 + 4 * lane; const bool ok = n < ncols; const float* src = W + (size_t)(k0 + 8 * w) * ld + c0 + n; f32x4 v[8];
#pragma unroll
      for (int r = 0; r < 8; ++r) v[r] = ok ? *(const GAS f32x4*)(src + (size_t)r * ld) : (f32x4){0.f, 0.f, 0.f, 0.f};
#pragma unroll
      for (int r = 0; r < 8; ++r) { LAS float* d = tile + (8 * w + r) * ST + 4 * lane; d[0] = v[r][0]; d[1] = v[r][1]; d[2] = v[r][2]; d[3] = v[r][3]; } }
    __syncthreads();
    if (f8) {
#pragma unroll
        for (int j = 0; j < 2; ++j) { const int idx = F.tid + 512 * j, c = idx & 3, n = idx >> 2; const LAS float* sp = tile + (16 * c) * ST + n; u32x4 o;
#pragma unroll
            for (int q = 0; q < 4; ++q) o[q] = pk4f8(sp[(4 * q) * ST] * W8_SCALE, sp[(4 * q + 1) * ST] * W8_SCALE, sp[(4 * q + 2) * ST] * W8_SCALE, sp[(4 * q + 3) * ST] * W8_SCALE);
            if (n0 + n < ncols) { const int ng = row0 + (n & 127) + (n >> 7) * rstep + (n0 >> 7) * rstep; *(GAS u32x4*)((unsigned char*)WT + (size_t)ng * K + k0 + 16 * c) = o; } }
        __syncthreads(); return; }
#pragma unroll
    for (int j = 0; j < 4; ++j) { const int idx = F.tid + 512 * j, c = idx & 7, n = idx >> 3; const LAS float* sp = tile + (8 * c) * ST + n;
        u32x4 o; o.x = pk2(sp[0 * ST], sp[1 * ST]); o.y = pk2(sp[2 * ST], sp[3 * ST]); o.z = pk2(sp[4 * ST], sp[5 * ST]); o.w = pk2(sp[6 * ST], sp[7 * ST]);
        if (n0 + n < ncols) { const int ng = row0 + (n & 127) + (n >> 7) * rstep + (n0 >> 7) * rstep, kc = (k0 >> 3) + c;
            const size_t dst = frag ? ((size_t)(((ng >> 5) * (K >> 4) + (kc >> 1)) * 64 + (kc & 1) * 32 + (ng & 31))) * 8 : (size_t)ng * K + k0 + 8 * c;
            *(GAS u32x4*)(WT + dst) = o; } }
    __syncthreads();
}
__device__ __forceinline__ void conv_layer_main(const Frame& F0, int l) {
    const Args A = load_args(); const Frame F = fresh(F0); asm volatile("" : "+s"(l));
    bf16_t* WINT = (bf16_t*)(A.ws + WS_WINT); bf16_t* UQT = (bf16_t*)(A.ws + WS_UQT); bf16_t* UKVT = (bf16_t*)(A.ws + WS_UKVT);
    bf16_t* BRT = (bf16_t*)(A.ws + WS_BRT); bf16_t* OUTT = (bf16_t*)(A.ws + WS_OUTT);
    const float* w_in = A.w_in + (size_t)l * DM * W_IN_COLS;
    constexpr int I_G = 16 * 16, I_P = 16 * 19, I_UQ = 4 * 3, I_UKV = 2 * 4, I_BR = 4 * 8 * 4, I_OUT = 16 * 4;
    constexpr int NIT = I_G + I_P + I_UQ + I_UKV + I_BR + I_OUT;
    for (int it = F.vcu; it < NIT; it += F.G) {
        int r = it;
        if (r < I_G) { conv_wg_item(F, w_in, W_IN_COLS, 4768, 4096, DM, WINT, 0, 128, r, false, true); continue; } r -= I_G;
        if (r < I_P) { conv_wg_item(F, w_in, W_IN_COLS, 0, 4768, DM, WINT, NGATE, 128, r, false, true); continue; } r -= I_P;
        if (r < I_UQ) { conv_wg_item(F, A.mla_w_uq + (size_t)l * 256 * 768, 768, 0, 768, 256, UQT, 0, 128, r, true); continue; } r -= I_UQ;
        if (r < I_UKV) { conv_wg_item(F, A.mla_w_ukv + (size_t)l * 128 * 1024, 1024, 0, 1024, 128, UKVT, 0, 128, r, true); continue; } r -= I_UKV;
        if (r < I_BR) { const int b = r >> 5; conv_wg_item(F, A.w_branch + ((size_t)l * 4 + b) * 512 * 1024, 1024, 0, 1024, 512, BRT, b * 1024, 128, r & 31, false, true); continue; } r -= I_BR;
        conv_wg_item(F, A.w_out + (size_t)l * DM * DM, DM, 0, DM, DM, OUTT, 0, 128, r, false, true);
    }
    { unsigned z0 = 0u; asm volatile("" : "+v"(z0)); u32x4 z = {z0, z0, z0, z0}; GAS u32x4* p = (GAS u32x4*)((unsigned char*)WINT + (size_t)(NGATE + 4768) * DM);
      for (int i = (F.vcu * 512 + F.tid); i < 96 * DM / 16; i += F.G * 512) p[i] = z; }
}
__device__ __forceinline__ void conv_layer_moe(const Frame& F0, int l) {
    const Args A = load_args(); const Frame F = fresh(F0); asm volatile("" : "+s"(l));
    bf16_t* GUT = (bf16_t*)(A.ws + WS_GUT); bf16_t* DT = (bf16_t*)(A.ws + WS_DT);
    constexpr int I_GU = 16 * 2 * 16, I_D = 16 * 16;
    for (int it = F.vcu; it < I_GU + I_D; it += F.G) {
        if (it < I_GU) { const int e = it >> 5, isup = (it >> 4) & 1, item = it & 15;
            const float* src = (isup ? A.moe_w_up : A.moe_w_gate) + ((size_t)l * 16 + e) * DM * 256;
            conv_wg_item(F, src, 256, 0, 256, DM, GUT, e * 512 + isup * 128, 256, item, false, true);
        } else { const int r = it - I_GU, e = r >> 4, item = r & 15;
            conv_wg_item(F, A.moe_w_down + ((size_t)l * 16 + e) * 256 * DM, DM, 0, DM, 256, DT, e * 1024, 128, item, false, true); }
    }
}

__device__ __forceinline__ void p0_mod_rope(const Frame& F0) {
    const Args A = load_args(); const Frame F = fresh(F0);
    { float* rope = (float*)(A.ws + WS_ROPE);
      for (int idx = F.vcu * 512 + F.tid; idx < M * 16; idx += F.G * 512) { const int m = idx >> 4, i = idx & 15;
          const float inv = powf(10000.0f, -(float)(2 * i) / 32.0f); const float ang = (float)A.pos[m] * inv; float sn, cs; sincosf(ang, &sn, &cs);
          rope[m * 32 + i] = cs; rope[m * 32 + 16 + i] = sn; } }
    LAS float* cact = (LAS float*)(F.lds);
    LAS float* part = (LAS float*)(F.lds + 32768);
    for (int i = F.tid; i < 8 * DM; i += 512) { const int b = i >> 10, k = i & 1023; cact[k * 8 + b] = fsilu(A.c[b * DM + k]); }
    __syncthreads();
    float* mod = (float*)(A.ws + WS_MOD);
    for (int u = F.vcu; u < 2 * 96; u += F.G) {
        const int l = u / 96, n0 = (u % 96) * 64;
        const float* w = A.ada_w + (size_t)l * DM * 6144 + n0 + F.lane;
        float acc[8];
#pragma unroll
        for (int b = 0; b < 8; ++b) acc[b] = 0.f;
        const int k0 = F.wave * 128;
#pragma unroll 1
        for (int kb = 0; kb < 128; kb += 32) { float wv[32];
#pragma unroll
            for (int k = 0; k < 32; ++k) wv[k] = w[(size_t)(k0 + kb + k) * 6144];
#pragma unroll
            for (int k = 0; k < 32; ++k) { const f32x4 c0 = *(const LAS f32x4*)(cact + (k0 + kb + k) * 8), c1 = *(const LAS f32x4*)(cact + (k0 + kb + k) * 8 + 4);
                acc[0] += c0[0] * wv[k]; acc[1] += c0[1] * wv[k]; acc[2] += c0[2] * wv[k]; acc[3] += c0[3] * wv[k]; acc[4] += c1[0] * wv[k]; acc[5] += c1[1] * wv[k]; acc[6] += c1[2] * wv[k]; acc[7] += c1[3] * wv[k]; } }
#pragma unroll
        for (int b = 0; b < 8; ++b) part[(F.wave * 8 + b) * 64 + F.lane] = acc[b];
        __syncthreads();
        { const int b = F.tid >> 6, n = F.tid & 63; float s = 0.f;
#pragma unroll
          for (int w8 = 0; w8 < 8; ++w8) s += part[(w8 * 8 + b) * 64 + n];
          mod[((size_t)l * 8 + b) * 6144 + n0 + n] = s + A.ada_b[l * 6144 + n0 + n]; }
        __syncthreads();
    }
}

__device__ __forceinline__ void store_row_bf16(bf16_t* orow, int lane, const f32x4 (&v)[4]) {
    GAS unsigned long long* o8 = (GAS unsigned long long*)orow + lane;
#pragma unroll
    for (int j = 0; j < 4; ++j) o8[64 * j] = (unsigned long long)pk2(v[j].x, v[j].y) | ((unsigned long long)pk2(v[j].z, v[j].w) << 32);
}
__device__ __forceinline__ void store_row_f8(unsigned char* orow, int lane, const f32x4 (&v)[4]) {
    GAS unsigned* o4 = (GAS unsigned*)orow + lane;
#pragma unroll
    for (int j = 0; j < 4; ++j) o4[64 * j] = pk4f8(v[j].x, v[j].y, v[j].z, v[j].w);
}
template <bool ROUTER>
__device__ __forceinline__ void norm_phase(const Frame& F0, int l) {
    const Args A = load_args(); const Frame F = fresh(F0); asm volatile("" : "+s"(l));
    bf16_t* H = (bf16_t*)(A.ws + WS_H); const float* mod = (const float*)(A.ws + WS_MOD) + (size_t)l * 8 * 6144;
    const float* xin = ROUTER ? A.out : ((l == 0) ? A.x : A.out);
    const float* gain = (ROUTER ? A.norm_ffn : A.norm_mix) + l * DM;
    const int lane = F.lane, gw = F.vcu * 8 + F.wave, b = gw >> 8, r0 = gw & 255;
    LAS float* rwt = (LAS float*)F.lds;
    LAS int* rowpair = (LAS int*)(F.lds + 65536);
    if (ROUTER) {
#pragma unroll
        for (int i = 0; i < 8; ++i) { const int idx = F.tid + 512 * ((i + F.vcu) & 7), c = idx >> 2, q = idx & 3; const f32x4 r = *(const GAS f32x4*)(A.router_w + (size_t)c * 16 + 4 * q);
            rwt[(4 * q + 0) * DM + c] = r[0]; rwt[(4 * q + 1) * DM + c] = r[1]; rwt[(4 * q + 2) * DM + c] = r[2]; rwt[(4 * q + 3) * DM + c] = r[3]; }
        __syncthreads();
    }
    f32x4 sc[4], sh[4];
    { const float* pm = mod + b * 6144 + (ROUTER ? 3072 : 0);
#pragma unroll
      for (int j = 0; j < 4; ++j) { const f32x4 gg = ((const GAS f32x4*)gain)[lane + 64 * j], s1 = ((const GAS f32x4*)(pm + 1024))[lane + 64 * j]; sh[j] = ((const GAS f32x4*)pm)[lane + 64 * j]; sc[j] = gg * (s1 + 1.0f); } }
    const int b5 = lane >> 5, b4 = (lane >> 4) & 1, b3 = (lane >> 3) & 1, b2 = (lane >> 2) & 1;
    f32x4 xn[4];
    { const GAS f32x4* xr = (const GAS f32x4*)(xin + (size_t)(b * 2048 + r0) * DM) + lane;
#pragma unroll
      for (int j = 0; j < 4; ++j) xn[j] = xr[64 * j]; }
#pragma unroll 2
    for (int k = 0; k < 8; ++k) {
        const int m = b * 2048 + r0 + 256 * k;
        f32x4 v[4];
#pragma unroll
        for (int j = 0; j < 4; ++j) v[j] = xn[j];
        if (k + 1 < 8) { const GAS f32x4* xr = (const GAS f32x4*)(xin + (size_t)(m + 256) * DM) + lane;
#pragma unroll
            for (int j = 0; j < 4; ++j) xn[j] = xr[64 * j]; }
        float s = 0.f;
#pragma unroll
        for (int j = 0; j < 4; ++j) s += (v[j].x * v[j].x + v[j].y * v[j].y) + (v[j].z * v[j].z + v[j].w * v[j].w);
        const float rstd = __builtin_amdgcn_rsqf(wave_sum(s, lane) * (1.f / DM) + EPS);
#pragma unroll
        for (int j = 0; j < 4; ++j) v[j] = v[j] * rstd * sc[j] + sh[j];
        store_row_f8((unsigned char*)H + (size_t)m * DM, lane, v);
        if (ROUTER) {
            float a16[16];
            int lo4 = 4 * lane; asm volatile("" : "+v"(lo4));
#pragma unroll
            for (int e = 0; e < 16; ++e) { float acc = 0.f;
#pragma unroll
                for (int j = 0; j < 4; ++j) { const f32x4 r = *(const LAS f32x4*)(rwt + e * DM + 256 * j + lo4); acc += v[j][0] * r[0] + v[j][1] * r[1] + v[j][2] * r[2] + v[j][3] * r[3]; }
                a16[e] = acc; }
            float r8[8], r4[4], r2[2], r1;
#pragma unroll
            for (int q = 0; q < 8; ++q) { const float mine = b5 ? a16[8 + q] : a16[q], oth = b5 ? a16[q] : a16[8 + q]; r8[q] = mine + shx(oth, 32, lane); }
#pragma unroll
            for (int q = 0; q < 4; ++q) { const float mine = b4 ? r8[4 + q] : r8[q], oth = b4 ? r8[q] : r8[4 + q]; r4[q] = mine + shx(oth, 16, lane); }
#pragma unroll
            for (int q = 0; q < 2; ++q) { const float mine = b3 ? r4[2 + q] : r4[q], oth = b3 ? r4[q] : r4[2 + q]; r2[q] = mine + shx(oth, 8, lane); }
            { const float mine = b2 ? r2[1] : r2[0], oth = b2 ? r2[0] : r2[1]; r1 = mine + shx(oth, 4, lane); }
            r1 += shx(r1, 2, lane); r1 += shx(r1, 1, lane);
            float lg[16];
#pragma unroll
            for (int e = 0; e < 16; ++e) lg[e] = __builtin_bit_cast(float, __builtin_amdgcn_readlane(__builtin_bit_cast(int, r1), 32 * ((e >> 3) & 1) + 16 * ((e >> 2) & 1) + 8 * ((e >> 1) & 1) + 4 * (e & 1)));
            float scv[16], sel[16];
#pragma unroll
            for (int e = 0; e < 16; ++e) { scv[e] = fsigmoid(lg[e]); sel[e] = scv[e] + A.router_bias[e]; }
            int bg = 0, bi1 = 0, bi2 = 1; float bgs = -1e30f, bw1 = 0.f, bw2 = 0.f;
#pragma unroll
            for (int g = 0; g < 4; ++g) { int i1 = 0; float s1 = sel[g * 4], w1 = scv[g * 4];
#pragma unroll
                for (int i = 1; i < 4; ++i) { const float sv = sel[g * 4 + i]; if (sv > s1) { s1 = sv; i1 = i; w1 = scv[g * 4 + i]; } }
                int i2 = -1; float s2 = -1e30f, w2 = 0.f;
#pragma unroll
                for (int i = 0; i < 4; ++i) { const float sv = sel[g * 4 + i]; if (i != i1 && sv > s2) { s2 = sv; i2 = i; w2 = scv[g * 4 + i]; } }
                const float gs = s1 + s2; if (gs > bgs) { bgs = gs; bg = g; bi1 = i1; bi2 = i2; bw1 = w1; bw2 = w2; } }
            const int ia = bi1 < bi2 ? bi1 : bi2, ib = bi1 < bi2 ? bi2 : bi1;
            const float wa0 = bi1 < bi2 ? bw1 : bw2, wb0 = bi1 < bi2 ? bw2 : bw1, inv = 1.0f / (wa0 + wb0);
            const int pidx = (ia == 0) ? (ib - 1) : (ia == 1 ? ib + 1 : 5);
            const int pair = bg * 6 + pidx;
            if (lane == 0) { float* tokw = (float*)(A.ws + WS_TOKW); tokw[2 * m] = wa0 * inv; tokw[2 * m + 1] = wb0 * inv; rowpair[F.wave * 8 + k] = pair; }
        }
    }
    if (ROUTER) {
        int* list = (int*)(A.ws + WS_LIST); unsigned* cnt = (unsigned*)(A.ws + WS_CTL) + CW_CNT + 64 * l;
        LAS int* base = rowpair + 64;
        __syncthreads();
        if (F.tid < 24) { int c = 0;
#pragma unroll 8
            for (int r = 0; r < 64; ++r) c += (rowpair[r] == F.tid) ? 1 : 0;
            base[F.tid] = c ? (int)atomicAdd(cnt + F.tid, (unsigned)c) : 0; }
        __syncthreads();
        if (F.tid < 64) { const int p = rowpair[F.tid]; int rank = 0;
#pragma unroll 8
            for (int r = 0; r < 64; ++r) rank += (r < F.tid && rowpair[r] == p) ? 1 : 0;
            const int w = F.tid >> 3, k = F.tid & 7; const int gwv = F.vcu * 8 + w; const int m = (gwv >> 8) * 2048 + (gwv & 255) + 256 * k;
            list[p * 16384 + base[p] + rank] = m; }
        __syncthreads();
    }
}
__device__ __forceinline__ void pair_experts(int pair, int& ea, int& eb) { const int g = pair / 6, pi = pair % 6;
    const int ia = pi < 3 ? 0 : (pi < 5 ? 1 : 2); const int ib = pi < 3 ? pi + 1 : (pi < 5 ? pi - 1 : 3); ea = g * 4 + ia; eb = g * 4 + ib; }

template <int NT>
__device__ __forceinline__ void stage_store_rows(LAS unsigned char* stg, const f32x16* v, bf16_t* gbase, int gstride, int lane) {
    const int r32 = lane & 31, hi = lane >> 5;
#pragma unroll
    for (int nt = 0; nt < NT; ++nt)
#pragma unroll
        for (int g = 0; g < 4; ++g) { u32x2 o; o.x = pk2(v[nt][4 * g], v[nt][4 * g + 1]); o.y = pk2(v[nt][4 * g + 2], v[nt][4 * g + 3]);
            *(LAS u32x2*)(stg + r32 * 208 + (nt * 32 + 8 * g + 4 * hi) * 2) = o; }
    LDS_WAIT(); asm volatile("" ::: "memory");
    constexpr int CPR = NT * 4;
#pragma unroll
    for (int i = 0; i < (32 * CPR) / 64; ++i) { const int c = lane + 64 * i, tok = c / CPR, part = c % CPR;
        const u32x4 d = *(const LAS u32x4*)(stg + tok * 208 + part * 16);
        *(u32x4*)(gbase + (size_t)tok * gstride + part * 8) = d; }
    LDS_WAIT(); asm volatile("" ::: "memory");
}
__device__ __forceinline__ void mla_prep_unit(const Frame& F0, int l, int unit) {
    const Args A = load_args(); const Frame F = fresh(F0); asm volatile("" : "+s"(l));
    const int tid = F.tid, lane = F.lane, w = F.wave, r32 = lane & 31, hi = lane >> 5;
    LAS unsigned char* lds = F.lds;
    constexpr int XQ_OFF = 0, XQ_ST = 528, XKV_OFF = 64 * 528, XKV_ST = 272, XR_OFF = XKV_OFF + 64 * 272, STG_OFF = 65536;
    const bf16_t* proj = (const bf16_t*)(A.ws + WS_PROJ);
    const int m0 = unit * 64;
    { const int t = tid >> 3, part = tid & 7; const bf16_t* row = proj + (size_t)(m0 + t) * NPROJ;
      u32x4 cq[4], ck[2];
#pragma unroll
      for (int i = 0; i < 4; ++i) cq[i] = *(const u32x4*)(row + PC_CQ + part * 32 + i * 8);
#pragma unroll
      for (int i = 0; i < 2; ++i) ck[i] = *(const u32x4*)(row + PC_CKV + part * 16 + i * 8);
      const u32x2 kr = *(const u32x2*)(row + PC_KR + part * 4);
      float sq = 0.f, sk = 0.f;
#pragma unroll
      for (int i = 0; i < 4; ++i)
#pragma unroll
          for (int j = 0; j < 4; ++j) { const float a = bflo(cq[i][j]), b = bfhi(cq[i][j]); sq += a * a + b * b; }
#pragma unroll
      for (int i = 0; i < 2; ++i)
#pragma unroll
          for (int j = 0; j < 4; ++j) { const float a = bflo(ck[i][j]), b = bfhi(ck[i][j]); sk += a * a + b * b; }
      sq += shx(sq, 1, lane); sq += shx(sq, 2, lane); sq += shx(sq, 4, lane);
      sk += shx(sk, 1, lane); sk += shx(sk, 2, lane); sk += shx(sk, 4, lane);
      const float rq = __builtin_amdgcn_rsqf(sq * (1.f / 256.f) + EPS), rk = __builtin_amdgcn_rsqf(sk * (1.f / 128.f) + EPS);
      const float* gq = A.mla_q_norm + l * 256 + part * 32; const float* gkv = A.mla_kv_norm + l * 128 + part * 16;
#pragma unroll
      for (int i = 0; i < 4; ++i) { u32x4 o;
#pragma unroll
          for (int j = 0; j < 4; ++j) o[j] = pk2(bflo(cq[i][j]) * rq * gq[i * 8 + 2 * j], bfhi(cq[i][j]) * rq * gq[i * 8 + 2 * j + 1]);
          *(LAS u32x4*)(lds + XQ_OFF + t * XQ_ST + part * 64 + i * 16) = o; }
#pragma unroll
      for (int i = 0; i < 2; ++i) { u32x4 o;
#pragma unroll
          for (int j = 0; j < 4; ++j) o[j] = pk2(bflo(ck[i][j]) * rk * gkv[i * 8 + 2 * j], bfhi(ck[i][j]) * rk * gkv[i * 8 + 2 * j + 1]);
          *(LAS u32x4*)(lds + XKV_OFF + t * XKV_ST + part * 32 + i * 16) = o; }
      *(LAS f32x4*)(lds + XR_OFF + (t * 32 + part * 4) * 4) = (f32x4){bflo(kr.x), bfhi(kr.x), bflo(kr.y), bfhi(kr.y)}; }
    __syncthreads();
    const u32x4* UQF = (const u32x4*)(A.ws + WS_UQT); const u32x4* UKVF = (const u32x4*)(A.ws + WS_UKVT);
    const float* rope = (const float*)(A.ws + WS_ROPE);
    bf16_t* MQ = (bf16_t*)(A.ws + WS_MLAQ); bf16_t* MK = (bf16_t*)(A.ws + WS_MLAK); bf16_t* MV = (bf16_t*)(A.ws + WS_MLAV);
    const float* gqk = A.mla_qk_norm + l * 192;
    const int h = w;
    {
        f32x16 acc[3][2];
#pragma unroll
        for (int nt = 0; nt < 3; ++nt) { acc[nt][0] = (f32x16){0}; acc[nt][1] = (f32x16){0}; }
        const int rot = F.vcu;
#pragma unroll 4
        for (int k_ = 0; k_ < 16; ++k_) { const int ks = (k_ + rot) & 15;
            const bf16x8 x0 = *(const LAS bf16x8*)(lds + XQ_OFF + r32 * XQ_ST + ks * 32 + hi * 16);
            const bf16x8 x1 = *(const LAS bf16x8*)(lds + XQ_OFF + (32 + r32) * XQ_ST + ks * 32 + hi * 16);
#pragma unroll
            for (int nt = 0; nt < 3; ++nt) { const bf16x8 wf = __builtin_bit_cast(bf16x8, UQF[((h * 3 + nt) * 16 + ks) * 64 + lane]);
                acc[nt][0] = __builtin_amdgcn_mfma_f32_32x32x16_bf16(wf, x0, acc[nt][0], 0, 0, 0);
                acc[nt][1] = __builtin_amdgcn_mfma_f32_32x32x16_bf16(wf, x1, acc[nt][1], 0, 0, 0); }
        }
#pragma unroll
        for (int tb = 0; tb < 2; ++tb) {
            const int m = m0 + tb * 32 + r32;
            float ss = 0.f;
#pragma unroll
            for (int nt = 0; nt < 3; ++nt)
#pragma unroll
                for (int r = 0; r < 16; ++r) ss += acc[nt][tb][r] * acc[nt][tb][r];
            ss += shx(ss, 32, lane);
            const float rstd = __builtin_amdgcn_rsqf(ss * (1.f / 96.f) + EPS);
#pragma unroll
            for (int nt = 0; nt < 3; ++nt)
#pragma unroll
                for (int r = 0; r < 16; ++r) acc[nt][tb][r] = acc[nt][tb][r] * rstd * gqk[nt * 32 + crow(r, hi)];
#pragma unroll
            for (int r = 0; r < 8; ++r) { const int i = crow(r, hi); const float cs = rope[m * 32 + i], sn = rope[m * 32 + 16 + i];
                const float x1 = acc[2][tb][r], x2 = acc[2][tb][r + 8]; acc[2][tb][r] = x1 * cs - x2 * sn; acc[2][tb][r + 8] = x1 * sn + x2 * cs; }
            { f32x16 t3[3] = {acc[0][tb], acc[1][tb], acc[2][tb]}; stage_store_rows<3>(lds + STG_OFF + w * 6656, t3, MQ + (size_t)(m0 + tb * 32) * 768 + h * 96, 768, lane); }
        }
    }
    {
        f32x16 acc[4][2];
#pragma unroll
        for (int nt = 0; nt < 4; ++nt) { acc[nt][0] = (f32x16){0}; acc[nt][1] = (f32x16){0}; }
        const int rot = F.vcu;
#pragma unroll 4
        for (int k_ = 0; k_ < 8; ++k_) { const int ks = (k_ + rot) & 7;
            const bf16x8 x0 = *(const LAS bf16x8*)(lds + XKV_OFF + r32 * XKV_ST + ks * 32 + hi * 16);
            const bf16x8 x1 = *(const LAS bf16x8*)(lds + XKV_OFF + (32 + r32) * XKV_ST + ks * 32 + hi * 16);
#pragma unroll
            for (int nt = 0; nt < 4; ++nt) { const bf16x8 wf = __builtin_bit_cast(bf16x8, UKVF[((h * 4 + nt) * 8 + ks) * 64 + lane]);
                acc[nt][0] = __builtin_amdgcn_mfma_f32_32x32x16_bf16(wf, x0, acc[nt][0], 0, 0, 0);
                acc[nt][1] = __builtin_amdgcn_mfma_f32_32x32x16_bf16(wf, x1, acc[nt][1], 0, 0, 0); }
        }
#pragma unroll
        for (int tb = 0; tb < 2; ++tb) {
            const int m = m0 + tb * 32 + r32, tl = tb * 32 + r32;
            f32x16 kr;
#pragma unroll
            for (int r = 0; r < 16; ++r) kr[r] = *(const LAS float*)(lds + XR_OFF + (tl * 32 + crow(r, hi)) * 4);
            float ss = 0.f;
#pragma unroll
            for (int nt = 0; nt < 2; ++nt)
#pragma unroll
                for (int r = 0; r < 16; ++r) ss += acc[nt][tb][r] * acc[nt][tb][r];
#pragma unroll
            for (int r = 0; r < 16; ++r) ss += kr[r] * kr[r];
            ss += shx(ss, 32, lane);
            const float rstd = __builtin_amdgcn_rsqf(ss * (1.f / 96.f) + EPS);
#pragma unroll
            for (int nt = 0; nt < 2; ++nt)
#pragma unroll
                for (int r = 0; r < 16; ++r) acc[nt][tb][r] = acc[nt][tb][r] * rstd * gqk[96 + nt * 32 + crow(r, hi)];
#pragma unroll
            for (int r = 0; r < 16; ++r) kr[r] = kr[r] * rstd * gqk[96 + 64 + crow(r, hi)];
#pragma unroll
            for (int r = 0; r < 8; ++r) { const int i = crow(r, hi); const float cs = rope[m * 32 + i], sn = rope[m * 32 + 16 + i];
                const float x1 = kr[r], x2 = kr[r + 8]; kr[r] = x1 * cs - x2 * sn; kr[r + 8] = x1 * sn + x2 * cs; }
            { f32x16 t3[3] = {acc[0][tb], acc[1][tb], kr}; stage_store_rows<3>(lds + STG_OFF + w * 6656, t3, MK + (size_t)(m0 + tb * 32) * 768 + h * 96, 768, lane); }
            { f32x16 t2[2] = {acc[2][tb], acc[3][tb]}; stage_store_rows<2>(lds + STG_OFF + w * 6656, t2, MV + (size_t)(m0 + tb * 32) * 512 + h * 64, 512, lane); }
        }
    }
    __syncthreads();
}

struct AttnWaveCfg {
    const bf16_t* q; int qstride;
    int qpos0;
    int kc0;
};
__device__ __forceinline__ void glds16(const void* gsrc, unsigned lds_dst) { unsigned keep;
    asm volatile("s_mov_b32 %0, m0\n\ts_mov_b32 m0, %2\n\ts_nop 0\n\tglobal_load_lds_dwordx4 %1, off\n\ts_mov_b32 m0, %0" : "=&s"(keep) : "v"(gsrc), "s"(lds_dst) : "memory"); }
__device__ __forceinline__ unsigned cvtpk(float lo, float hi) { f32x2_t v = {lo, hi}; bf16x2_t b = __builtin_convertvector(v, bf16x2_t); return __builtin_bit_cast(unsigned, b); }
#define ATT_WAITBAR(N) asm volatile("s_waitcnt vmcnt(" #N ") lgkmcnt(0)\n\ts_barrier" ::: "memory")
template <int DQK, int DV, int KL, bool NORMQ, int WINDOW, int VPRE>
struct AttnBody {
    static constexpr int NKP = (KL == 0) ? 8 : (KL == 1 ? 16 : 12), NVP = DV / 8;
    static constexpr int KBYTES = NKP * 1024, SLOT = KBYTES + NVP * 1024, NS = 3;
    static constexpr int PT = (KL == 0) ? 2 : (KL == 1 ? 4 : 3);
    static constexpr int SCR_OFF = NS * SLOT;
    static constexpr int NKS = DQK / 16, ND0 = DV / 32;
    __device__ static __forceinline__ void run(const Frame& F, const AttnWaveCfg& W, const bf16_t* Kg, int kstride, const bf16_t* Vg, int vstride,
                                               int kt_lo, int kt_hi, float c2, const float* gq, bool use_sink, float sink_l2, f32x16 (&o)[ND0]) {
        const int lane = F.lane, r32 = lane & 31, hi = lane >> 5, w = F.wave;
        LAS unsigned char* lds = F.lds;
        const unsigned lds0 = (unsigned)(size_t)lds;
        LAS float* wsf = (LAS float*)(lds + SCR_OFF + w * 256);
        const bf16_t* ksrc0; const bf16_t* ksrc1 = nullptr; const bf16_t* vsrc0; const bf16_t* vsrc1 = nullptr; unsigned kd0, kd1 = 0, vd0, vd1 = 0;
        if (KL == 0) { const int row = 8 * w + (lane >> 3), c = (lane & 7) ^ ((row >> 1) & 7); ksrc0 = Kg + (size_t)row * kstride + c * 8; kd0 = w * 1024; }
        else if (KL == 1) { const int p0 = 2 * w, row0 = 4 * p0 + (lane >> 4), row1 = row0 + 4; ksrc0 = Kg + (size_t)row0 * kstride + ((lane & 15) ^ (row0 & 15)) * 8; ksrc1 = Kg + (size_t)row1 * kstride + ((lane & 15) ^ (row1 & 15)) * 8;
            kd0 = p0 * 1024; kd1 = kd0 + 1024; }
        else { const int row = 8 * w + (lane >> 3), c = (lane & 7) ^ ((row >> 1) & 7); ksrc0 = Kg + (size_t)row * kstride + c * 8; kd0 = w * 1024;
            const int p = w & 3, rr = 16 * p + (lane >> 2), cr = (lane & 3) ^ ((rr >> 2) & 3); ksrc1 = Kg + (size_t)rr * kstride + 64 + cr * 8; kd1 = 8192 + p * 1024; }
        if (DV == 64) { vsrc0 = Vg + (size_t)(16 * (w & 3) + (lane >> 2)) * vstride + (w >> 2) * 32 + (lane & 3) * 8; vd0 = KBYTES + w * 1024; }
        else { const int p0 = 2 * w, p1 = p0 + 1; vsrc0 = Vg + (size_t)(16 * (p0 & 3) + (lane >> 2)) * vstride + (p0 >> 2) * 32 + (lane & 3) * 8; vsrc1 = Vg + (size_t)(16 * (p1 & 3) + (lane >> 2)) * vstride + (p1 >> 2) * 32 + (lane & 3) * 8;
            vd0 = KBYTES + p0 * 1024; vd1 = vd0 + 1024; }
        auto dma_tile = [&](int kt, int slot) {
            const size_t ko = (size_t)kt * 64 * kstride, vo = (size_t)kt * 64 * vstride; const unsigned sb = lds0 + (unsigned)slot * SLOT;
            glds16(ksrc0 + ko, (unsigned)__builtin_amdgcn_readfirstlane(sb + kd0));
            if (KL != 0) glds16(ksrc1 + ko, (unsigned)__builtin_amdgcn_readfirstlane(sb + kd1));
            glds16(vsrc0 + vo, (unsigned)__builtin_amdgcn_readfirstlane(sb + vd0));
            if (DV == 128) glds16(vsrc1 + vo, (unsigned)__builtin_amdgcn_readfirstlane(sb + vd1));
        };
        dma_tile(kt_lo, 0);
        if (kt_lo + 1 < kt_hi) dma_tile(kt_lo + 1, 1);
        bf16x8 qf[NKS];
        {
            float ss = 0.f; u32x4 raw[NKS];
#pragma unroll
            for (int ks = 0; ks < NKS; ++ks) { raw[ks] = *(const u32x4*)(W.q + (size_t)r32 * W.qstride + ks * 16 + hi * 8);
#pragma unroll
                for (int j = 0; j < 4; ++j) { const float a = bflo(raw[ks][j]), b = bfhi(raw[ks][j]); ss += a * a + b * b; } }
            float rs = c2;
            if (NORMQ) { ss += shx(ss, 32, lane); rs = __builtin_amdgcn_rsqf(ss * (1.f / DQK) + EPS) * c2; }
#pragma unroll
            for (int ks = 0; ks < NKS; ++ks) { u32x4 p;
#pragma unroll
                for (int j = 0; j < 4; ++j) { float a = bflo(raw[ks][j]) * rs, b = bfhi(raw[ks][j]) * rs; if (NORMQ) { a *= gq[ks * 16 + hi * 8 + 2 * j]; b *= gq[ks * 16 + hi * 8 + 2 * j + 1]; } p[j] = cvtpk(a, b); }
                qf[ks] = __builtin_bit_cast(bf16x8, p); }
        }
#pragma unroll
        for (int d = 0; d < ND0; ++d) o[d] = (f32x16){0};
        float m_run = -1e30f, l_run = 0.f;
        const int qlo = W.qpos0, qhi = W.qpos0 + 31;
        const int kx = (KL == 1) ? (r32 & 15) : ((r32 >> 1) & 7);
        const int krow = (KL == 1) ? r32 * 256 : r32 * 128;
        const int kxr = (r32 >> 2) & 3, krow_r = 8192 + r32 * 64;
        const int vlane = (4 * hi + ((lane & 15) >> 2)) * 64 + ((lane >> 4) & 1) * 32 + (lane & 3) * 8;
        int slot = 0;
        for (int kt = kt_lo; kt < kt_hi; ++kt) {
            if (kt + 1 < kt_hi) { if (PT == 2) { ATT_WAITBAR(2); } else if (PT == 3) { ATT_WAITBAR(3); } else { ATT_WAITBAR(4); }; } else { ATT_WAITBAR(0); }
            if (kt + 2 < kt_hi) dma_tile(kt + 2, slot >= 1 ? slot - 1 : 2);
            const int k0 = kt * 64;
            bool need = (k0 <= qhi);
            if (WINDOW > 0) need = need && (k0 + 63 >= qlo - (WINDOW - 1));
            if (need) {
                const LAS unsigned char* sb = lds + slot * SLOT;
                f32x16 p0 = (f32x16){0}, p1 = (f32x16){0};
                bf16x8 kfa[NKS], kfb[NKS];
#pragma unroll
                for (int ks = 0; ks < NKS; ++ks) {
                    const LAS unsigned char* ka;
                    if (KL == 2 && ks >= 4) ka = sb + krow_r + (((2 * (ks - 4) + hi) ^ kxr) << 4);
                    else ka = sb + krow + ((((KL == 1 ? W.kc0 : 0) + 2 * ks + hi) ^ kx) << 4);
                    const int hstep = (KL == 2 && ks >= 4) ? 32 * 64 : (KL == 1 ? 32 * 256 : 32 * 128);
                    kfa[ks] = *(const LAS bf16x8*)ka; kfb[ks] = *(const LAS bf16x8*)(ka + hstep); }
                __builtin_amdgcn_sched_barrier(0);
#pragma unroll
                for (int ks = 0; ks < NKS; ++ks) { p0 = __builtin_amdgcn_mfma_f32_32x32x16_bf16(kfa[ks], qf[ks], p0, 0, 0, 0); p1 = __builtin_amdgcn_mfma_f32_32x32x16_bf16(kfb[ks], qf[ks], p1, 0, 0, 0); }
                const LAS unsigned char* vb = sb + KBYTES + vlane;
                s16x4 vlo[VPRE > 0 ? VPRE : 1][4], vhi[VPRE > 0 ? VPRE : 1][4];
#pragma unroll
                for (int d = 0; d < VPRE; ++d)
#pragma unroll
                    for (int q4 = 0; q4 < 4; ++q4) { const LAS unsigned char* vp = vb + (d * 4 + q4) * 1024;
                        vlo[d][q4] = __builtin_bit_cast(s16x4, __builtin_amdgcn_ds_read_tr16_b64_v4i16((LAS s16x4*)vp));
                        vhi[d][q4] = __builtin_bit_cast(s16x4, __builtin_amdgcn_ds_read_tr16_b64_v4i16((LAS s16x4*)(vp + 512))); }
                const int qpos = W.qpos0 + r32;
                bool full = (k0 + 63 <= qlo);
                if (WINDOW > 0) full = full && (k0 >= qhi - (WINDOW - 1));
                if (!full) {
#pragma unroll
                    for (int r = 0; r < 16; ++r) { const int ka = k0 + crow(r, hi), kb2 = ka + 32;
                        bool va = ka <= qpos, vb2 = kb2 <= qpos; if (WINDOW > 0) { va = va && (qpos - ka < WINDOW); vb2 = vb2 && (qpos - kb2 < WINDOW); }
                        p0[r] = va ? p0[r] : -INFINITY; p1[r] = vb2 ? p1[r] : -INFINITY; }
                }
                float mx = fmaxf(p0[0], p1[0]);
#pragma unroll
                for (int r = 1; r < 16; ++r) mx = fmaxf(mx, fmaxf(p0[r], p1[r]));
                mx = fmaxf(mx, shx(mx, 32, lane));
                if (__any(mx > m_run)) {
                    const float mn = fmaxf(m_run, mx); const float alpha = __builtin_amdgcn_exp2f(m_run - mn); m_run = mn; l_run *= alpha;
                    if (hi == 0) wsf[r32] = alpha;
                    LDS_WAIT();
#pragma unroll
                    for (int r = 0; r < 16; ++r) { const float a = wsf[crow(r, hi)];
#pragma unroll
                        for (int d = 0; d < ND0; ++d) o[d][r] *= a; }
                }
                float rs = 0.f;
#pragma unroll
                for (int r = 0; r < 16; ++r) { p0[r] = __builtin_amdgcn_exp2f(p0[r] - m_run); p1[r] = __builtin_amdgcn_exp2f(p1[r] - m_run); rs += p0[r] + p1[r]; }
                l_run += rs;
                bf16x8 pa[4];
#pragma unroll
                for (int s = 0; s < 2; ++s) { u32x4 pw;
                    pw.x = cvtpk(p0[8 * s], p0[8 * s + 1]); pw.y = cvtpk(p0[8 * s + 2], p0[8 * s + 3]); pw.z = cvtpk(p0[8 * s + 4], p0[8 * s + 5]); pw.w = cvtpk(p0[8 * s + 6], p0[8 * s + 7]); pa[s] = __builtin_bit_cast(bf16x8, pw);
                    pw.x = cvtpk(p1[8 * s], p1[8 * s + 1]); pw.y = cvtpk(p1[8 * s + 2], p1[8 * s + 3]); pw.z = cvtpk(p1[8 * s + 4], p1[8 * s + 5]); pw.w = cvtpk(p1[8 * s + 6], p1[8 * s + 7]); pa[2 + s] = __builtin_bit_cast(bf16x8, pw); }
#pragma unroll
                for (int d = 0; d < ND0; ++d)
#pragma unroll
                    for (int q4 = 0; q4 < 4; ++q4) {
                        s16x4 lo, hh;
                        if (d < VPRE) { lo = vlo[d][q4]; hh = vhi[d][q4]; }
                        else { const LAS unsigned char* vp = vb + (d * 4 + q4) * 1024;
                            lo = __builtin_bit_cast(s16x4, __builtin_amdgcn_ds_read_tr16_b64_v4i16((LAS s16x4*)vp));
                            hh = __builtin_bit_cast(s16x4, __builtin_amdgcn_ds_read_tr16_b64_v4i16((LAS s16x4*)(vp + 512))); }
                        const bf16x8 vf = (bf16x8){lo[0], lo[1], lo[2], lo[3], hh[0], hh[1], hh[2], hh[3]};
                        o[d] = __builtin_amdgcn_mfma_f32_32x32x16_bf16(pa[q4], vf, o[d], 0, 0, 0);
                    }
            }
            slot = (slot == 2) ? 0 : slot + 1;
        }
        l_run += shx(l_run, 32, lane);
        if (use_sink) l_run += __builtin_amdgcn_exp2f(sink_l2 - m_run);
        if (hi == 0) wsf[32 + r32] = __builtin_amdgcn_rcpf(l_run);
        LDS_WAIT();
#pragma unroll
        for (int r = 0; r < 16; ++r) { const float a = wsf[32 + crow(r, hi)];
#pragma unroll
            for (int d = 0; d < ND0; ++d) o[d][r] *= a; }
        ATT_WAITBAR(0);
    }
};
template <int ND0>
__device__ __forceinline__ void store_o_bf16(bf16_t* orow0, int ostride, int lane, const f32x16 (&o)[ND0]) {
    const int r32 = lane & 31, hi = lane >> 5;
#pragma unroll
    for (int r = 0; r < 16; ++r)
#pragma unroll
        for (int d = 0; d < ND0; ++d) orow0[(size_t)crow(r, hi) * ostride + d * 32 + r32] = (bf16_t)(pk2(o[d][r], 0.f) & 0xffffu);
}

template <int ND0>
__device__ __forceinline__ void store_o_f8(unsigned char* orow0, int ostride, int lane, const f32x16 (&o)[ND0]) {
    const int r32 = lane & 31, hi = lane >> 5;
#pragma unroll
    for (int r = 0; r < 16; ++r)
#pragma unroll
        for (int d = 0; d < ND0; ++d) orow0[(size_t)crow(r, hi) * ostride + d * 32 + r32] = (unsigned char)(pk4f8(o[d][r] * Y8_SCALE, 0.f, 0.f, 0.f) & 0xffu);
}
__device__ __forceinline__ void mla_attn_unit(const Frame& F0, int b, int h, int qb, bool dry) {
    const Args A = load_args(); const Frame F = fresh(F0);
    typedef AttnBody<96, 64, 2, false, 0, 2> AB;
    bf16_t* MQ = (bf16_t*)(A.ws + WS_MLAQ); const bf16_t* MK = (const bf16_t*)(A.ws + WS_MLAK); const bf16_t* MV = (const bf16_t*)(A.ws + WS_MLAV);
    const int q0 = qb * 256 + F.wave * 32; const size_t rb = (size_t)b * SEQ;
    AttnWaveCfg W; W.q = MQ + (rb + q0) * 768 + h * 96; W.qstride = 768; W.qpos0 = q0; W.kc0 = 0;
    f32x16 o[2];
    AB::run(F, W, MK + rb * 768 + h * 96, 768, MV + rb * 512 + h * 64, 512, 0, (qb * 256 + 256) / 64, 0.10206207261596575f * LOG2E, nullptr, false, 0.f, o);
    if (!dry) store_o_f8<2>((unsigned char*)(MQ + (rb + q0) * 768 + h * 96), 1536, F.lane, o);
}
__device__ __forceinline__ void swa_attn_unit(const Frame& F0, int l, int b, int kvh, int rb64, bool dry, bool alt = false) {
    const Args A = load_args(); const Frame F = fresh(F0); asm volatile("" : "+s"(l));
    typedef AttnBody<64, 64, 0, true, 128, 2> AB;
    bf16_t* proj = (bf16_t*)(A.ws + WS_PROJ);
    const int hq = kvh * 4 + (F.wave >> 1); const int q0 = rb64 * 64 + (F.wave & 1) * 32; const size_t rb = (size_t)b * SEQ;
    const int cq = alt ? PC_DQ : PC_SQ, ck = alt ? PC_DK : PC_SK, cv = alt ? PC_DV : PC_SV;
    AttnWaveCfg W; W.q = proj + (rb + q0) * NPROJ + cq + hq * 64; W.qstride = NPROJ; W.qpos0 = q0; W.kc0 = 0;
    const int kt_hi = rb64 + 1, kt_lo = (rb64 - 2) < 0 ? 0 : rb64 - 2;
    f32x16 o[2];
    AB::run(F, W, proj + rb * NPROJ + ck + kvh * 64, NPROJ, proj + rb * NPROJ + cv + kvh * 64, NPROJ, kt_lo, kt_hi, 0.125f * LOG2E,
            A.swa_qk_norm + l * 128, true, A.swa_sinks[l * 8 + hq] * LOG2E, o);
    if (!dry) store_o_f8<2>((unsigned char*)(proj + (rb + q0) * NPROJ + PC_SQ + hq * 64), NPROJ * 2, F.lane, o);
}
__device__ __forceinline__ void diff_attn_unit(const Frame& F0, int l, int b, int hh, int qb128, bool dry) {
    const Args A = load_args(); const Frame F = fresh(F0); asm volatile("" : "+s"(l));
    typedef AttnBody<64, 128, 1, true, 0, DIFF_VPRE> AB;
    bf16_t* proj = (bf16_t*)(A.ws + WS_PROJ);
    const int sub = F.wave & 1, rbk = F.wave >> 1; const int q0 = qb128 * 128 + rbk * 32; const size_t rb = (size_t)b * SEQ;
    AttnWaveCfg W; W.q = proj + (rb + q0) * NPROJ + PC_DQ + hh * 128 + sub * 64; W.qstride = NPROJ; W.qpos0 = q0; W.kc0 = sub * 8;
    float lam;
    { const float* lp = A.diff_lam + l * 256; const float a = wave_sum(lp[F.lane] * lp[64 + F.lane], F.lane), c = wave_sum(lp[128 + F.lane] * lp[192 + F.lane], F.lane);
      const float lam_init = 0.8f - 0.6f * __expf(-0.3f * (float)l); lam = __expf(a) - __expf(c) + lam_init; }
    f32x16 o[4];
    AB::run(F, W, proj + rb * NPROJ + PC_DK + hh * 128, NPROJ, proj + rb * NPROJ + PC_DV + hh * 128, NPROJ, 0, (qb128 * 128 + 128) / 64, 0.125f * LOG2E,
            A.diff_qk_norm + l * 128, false, 0.f, o);
    LAS float* ex = (LAS float*)(F.lds) + rbk * 4096;
    const int r32 = F.lane & 31, hi = F.lane >> 5;
    if (sub == 1) {
#pragma unroll
        for (int r = 0; r < 16; ++r)
#pragma unroll
            for (int d = 0; d < 4; ++d) ex[crow(r, hi) * 128 + d * 32 + r32] = o[d][r];
    }
    __syncthreads();
    if (sub == 0) {
        const float lam_init = 0.8f - 0.6f * __expf(-0.3f * (float)l);
        float ss[16];
#pragma unroll
        for (int r = 0; r < 16; ++r) { ss[r] = 0.f;
#pragma unroll
            for (int d = 0; d < 4; ++d) { const float v = o[d][r] - lam * ex[crow(r, hi) * 128 + d * 32 + r32]; o[d][r] = v; ss[r] += v * v; } }
#pragma unroll
        for (int r = 0; r < 16; ++r) { const float s = sum32(ss[r], F.lane);
            const float rstd = __builtin_amdgcn_rsqf(s * (1.f / 128.f) + EPS) * (1.0f - lam_init);
#pragma unroll
            for (int d = 0; d < 4; ++d) o[d][r] *= rstd * A.diff_onorm[l * 128 + d * 32 + r32]; }
        if (!dry) store_o_f8<4>((unsigned char*)(proj + (rb + q0) * NPROJ + PC_DQ + hh * 128), NPROJ * 2, F.lane, o);
    }
    __syncthreads();
}
__device__ __forceinline__ void knorm_pass(const Frame& F0, int l) {
    const Args A = load_args(); const Frame F = fresh(F0); asm volatile("" : "+s"(l));
    bf16_t* proj = (bf16_t*)(A.ws + WS_PROJ);
    const int stride = F.G * 512;
    for (int idx0 = F.vcu * 512 + F.tid; idx0 < M * 80; idx0 += 5 * stride) {
        u32x4 raw[5]; bf16_t* p[5]; const float* g[5];
#pragma unroll
        for (int i = 0; i < 5; ++i) { const int idx = idx0 + i * stride; const int row = idx / 80, ch = idx % 80; const bool isd = ch < 64; const int col = isd ? PC_DK + ch * 8 : PC_SK + (ch - 64) * 8;
            g[i] = (isd ? A.diff_qk_norm : A.swa_qk_norm) + l * 128 + 64 + (ch & 7) * 8; p[i] = proj + (size_t)row * NPROJ + col; raw[i] = *(const u32x4*)p[i]; }
#pragma unroll
        for (int i = 0; i < 5; ++i) { float f[8];
#pragma unroll
            for (int j = 0; j < 4; ++j) { f[2 * j] = bflo(raw[i][j]); f[2 * j + 1] = bfhi(raw[i][j]); }
            float ss = 0.f;
#pragma unroll
            for (int j = 0; j < 8; ++j) ss += f[j] * f[j];
            ss += shx(ss, 1, F.lane); ss += shx(ss, 2, F.lane); ss += shx(ss, 4, F.lane);
            const float rstd = __builtin_amdgcn_rsqf(ss * (1.f / 64.f) + EPS); const float* gg = g[i];
            u32x4 o; o.x = cvtpk(f[0] * rstd * gg[0], f[1] * rstd * gg[1]); o.y = cvtpk(f[2] * rstd * gg[2], f[3] * rstd * gg[3]); o.z = cvtpk(f[4] * rstd * gg[4], f[5] * rstd * gg[5]); o.w = cvtpk(f[6] * rstd * gg[6], f[7] * rstd * gg[7]);
            *(u32x4*)p[i] = o; }
    }
}

__device__ __forceinline__ void hgrn_unit(const Frame& F0, int l, int b, int h, bool dry) {
    const Args A = load_args(); const Frame F = fresh(F0); asm volatile("" : "+s"(l));
    const int tid = F.tid, lane = F.lane, w = F.wave, r32 = lane & 31, hi = lane >> 5;
    LAS unsigned char* lds = F.lds;
    constexpr int ST = 144, STT = 192, OST = 272;
    constexpr int O_QB = 0, O_QD = O_QB + 64 * ST, O_KD = O_QD + 64 * ST, O_QX = O_KD + 64 * ST, O_KX = O_QX + 64 * ST;
    constexpr int O_KE = O_KX + 64 * ST, O_V = O_KE + 64 * STT, O_S = O_V + 64 * STT;
    constexpr int O_SEG = O_S + 2 * 64 * STT, O_DL = O_SEG + 8 * 64 * 4, O_OB = O_DL + 256;
    bf16_t* proj = (bf16_t*)(A.ws + WS_PROJ);
    const size_t rb = (size_t)b * SEQ;
    const int k = lane;
    float lb = 0.f;
    if (l == 1) { const float a0 = A.hg_lb[h * 64 + k], a1 = A.hg_lb[512 + h * 64 + k]; lb = 1.0f / (1.0f + __expf(a0 - a1)); }
    for (int i = tid; i < 64 * STT / 4; i += 512) *(LAS unsigned*)(lds + O_S + i * 4) = 0u;
    f32x16 sacc = (f32x16){0};
    unsigned short qraw[8], fraw[8]; u32x4 vraw, graw, gprev = (u32x4){0u, 0u, 0u, 0u};
    const int erow = tid >> 3, ecol = (tid & 7) * 8;
    f32x4 gn0, gn1; { const float* g = A.hg_onorm + l * 64 + ecol; gn0 = *(const f32x4*)g; gn1 = *(const f32x4*)(g + 4); }
    auto load_chunk = [&](int c) {
        const bf16_t* base = proj + (rb + c * 64 + w * 8) * NPROJ + h * 64 + k;
#pragma unroll
        for (int j = 0; j < 8; ++j) { qraw[j] = base[(size_t)j * NPROJ + PC_HQ]; fraw[j] = base[(size_t)j * NPROJ + PC_HF]; }
        const bf16_t* rp = proj + (rb + c * 64 + erow) * NPROJ + h * 64 + ecol;
        vraw = *(const u32x4*)(rp + PC_HI); graw = *(const u32x4*)(rp + PC_HG);
    };
    auto epilogue = [&](int c, const u32x4& gr) {
        const LAS float* op = (const LAS float*)(lds + O_OB + erow * OST + ecol * 4);
        const f32x4 o0 = *(const LAS f32x4*)op, o1 = *(const LAS f32x4*)(op + 4);
        const float ss = sum8((o0[0] * o0[0] + o0[1] * o0[1]) + (o0[2] * o0[2] + o0[3] * o0[3]) + (o1[0] * o1[0] + o1[1] * o1[1]) + (o1[2] * o1[2] + o1[3] * o1[3]));
        const float rstd = __builtin_amdgcn_rsqf(ss * (1.f / 64.f) + EPS);
        float y[8];
#pragma unroll
        for (int j = 0; j < 4; ++j) { const float ga = bflo(gr[j]), gb = bfhi(gr[j]); const float oa = j < 2 ? o0[2 * j] : o1[2 * j - 4], ob = j < 2 ? o0[2 * j + 1] : o1[2 * j - 3];
            const float na = j < 2 ? gn0[2 * j] : gn1[2 * j - 4], nb = j < 2 ? gn0[2 * j + 1] : gn1[2 * j - 3];
            y[2 * j] = oa * rstd * na * fsilu(ga); y[2 * j + 1] = ob * rstd * nb * fsilu(gb); }
        u32x2 o; o.x = pk4f8(y[0] * Y8_SCALE, y[1] * Y8_SCALE, y[2] * Y8_SCALE, y[3] * Y8_SCALE); o.y = pk4f8(y[4] * Y8_SCALE, y[5] * Y8_SCALE, y[6] * Y8_SCALE, y[7] * Y8_SCALE);
        if (!dry) *(u32x2*)((unsigned char*)(proj + (rb + c * 64 + erow) * NPROJ + PC_HQ + h * 64) + ecol) = o;
    };
    load_chunk(0);
#pragma unroll 1
    for (int c = 0; c < 32; ++c) {
        const int sb_cur = c & 1;
        float qv[8], kkv[8], bl[8]; float run = 0.f;
#pragma unroll
        for (int j = 0; j < 8; ++j) { const float f = bf2f(fraw[j]), q = bf2f(qraw[j]);
            const float ef = __expf(-f); const float sg = __builtin_amdgcn_rcpf(1.0f + ef); const float fg = lb + (1.0f - lb) * sg;
            float lf = __logf(fg); lf = fmaxf(lf, -30.0f);
            kkv[j] = (1.0f - lb) * ef * sg;
            qv[j] = fsilu(q);
            run += lf; bl[j] = run; }
        const u32x4 vcur = vraw, gcur = graw;
        *(LAS float*)(lds + O_SEG + (w * 64 + k) * 4) = run;
        __syncthreads();
        if (c + 1 < 32) load_chunk(c + 1);
        if (c > 0) epilogue(c - 1, gprev);
        gprev = gcur;
        float sg8[8];
#pragma unroll
        for (int j = 0; j < 8; ++j) sg8[j] = *(LAS float*)(lds + O_SEG + (j * 64 + k) * 4);
        float off = 0.f;
#pragma unroll
        for (int j = 0; j < 8; ++j) off += (j < w) ? sg8[j] : 0.f;
        const float r15 = sg8[0] + sg8[1], r31 = r15 + sg8[2] + sg8[3], r47 = r31 + sg8[4] + sg8[5], r63 = r47 + sg8[6] + sg8[7];
        const float rd = (w < 4) ? r15 : r47;
#pragma unroll
        for (int j = 0; j < 8; ++j) { const int t = w * 8 + j; const float bt = off + bl[j];
            const float eb = __expf(bt);
            const float qd = qv[j] * __expf(fminf(bt - rd, 60.f)), kd = kkv[j] * __expf(fminf(rd - bt, 60.f));
            const float ke = kkv[j] * __expf(r63 - bt);
            const float xx = (w >= 4) ? qv[j] * __expf(bt - r31) : kkv[j] * __expf(r31 - bt);
            const unsigned p0 = pk2(qv[j] * eb, qd), p1 = pk2(kd, ke), p2 = pk2(xx, 0.f);
            *(LAS bf16_t*)(lds + O_QB + t * ST + k * 2) = (bf16_t)(p0 & 0xffffu);
            *(LAS bf16_t*)(lds + O_QD + t * ST + k * 2) = (bf16_t)(p0 >> 16);
            *(LAS bf16_t*)(lds + O_KD + t * ST + k * 2) = (bf16_t)(p1 & 0xffffu);
            *(LAS bf16_t*)(lds + O_KE + t * STT + k * 2) = (bf16_t)(p1 >> 16);
            *(LAS bf16_t*)(lds + ((w >= 4) ? O_QX : O_KX) + t * ST + k * 2) = (bf16_t)(p2 & 0xffffu); }
        *(LAS u32x4*)(lds + O_V + erow * STT + ecol * 2) = vcur;
        if (w == 0) *(LAS float*)(lds + O_DL + k * 4) = __expf(r63);
        __syncthreads();
        const int trow = 4 * hi + ((lane & 15) >> 2), tcol = ((lane >> 4) & 1) * 32 + (lane & 3) * 8;
        if (w < 2) {
            const int tb = w;
            f32x16 oacc[2]; oacc[0] = (f32x16){0}; oacc[1] = (f32x16){0};
            for (int sb = 0; sb <= tb; ++sb) {
                const int ko = (sb == tb) ? O_KD : O_KX, qo = (sb == tb) ? O_QD : O_QX;
                f32x16 p = (f32x16){0};
#pragma unroll
                for (int ks = 0; ks < 4; ++ks) { const bf16x8 ka = *(const LAS bf16x8*)(lds + ko + (32 * sb + r32) * ST + ks * 32 + hi * 16);
                    const bf16x8 qb = *(const LAS bf16x8*)(lds + qo + (32 * tb + r32) * ST + ks * 32 + hi * 16);
                    p = __builtin_amdgcn_mfma_f32_32x32x16_bf16(ka, qb, p, 0, 0, 0); }
                if (sb == tb) {
#pragma unroll
                    for (int r = 0; r < 16; ++r) p[r] = (crow(r, hi) <= r32) ? p[r] : 0.f;
                }
#pragma unroll
                for (int s2 = 0; s2 < 2; ++s2) { u32x4 pw; pw.x = pk2(p[8 * s2], p[8 * s2 + 1]); pw.y = pk2(p[8 * s2 + 2], p[8 * s2 + 3]); pw.z = pk2(p[8 * s2 + 4], p[8 * s2 + 5]); pw.w = pk2(p[8 * s2 + 6], p[8 * s2 + 7]);
                    const bf16x8 pa = __builtin_bit_cast(bf16x8, pw);
#pragma unroll
                    for (int d = 0; d < 2; ++d) { const LAS unsigned char* vp = lds + O_V + (32 * sb + 16 * s2 + trow) * STT + tcol + d * 64;
                        const s16x4 lo = __builtin_bit_cast(s16x4, __builtin_amdgcn_ds_read_tr16_b64_v4i16((LAS s16x4*)vp));
                        const s16x4 hh = __builtin_bit_cast(s16x4, __builtin_amdgcn_ds_read_tr16_b64_v4i16((LAS s16x4*)(vp + 8 * STT)));
                        const bf16x8 vf = (bf16x8){lo[0], lo[1], lo[2], lo[3], hh[0], hh[1], hh[2], hh[3]};
                        oacc[d] = __builtin_amdgcn_mfma_f32_32x32x16_bf16(pa, vf, oacc[d], 0, 0, 0); } }
            }
#pragma unroll
            for (int ks = 0; ks < 4; ++ks) { const bf16x8 qa = *(const LAS bf16x8*)(lds + O_QB + (32 * tb + r32) * ST + ks * 32 + hi * 16);
#pragma unroll
                for (int d = 0; d < 2; ++d) { const LAS unsigned char* sp = lds + O_S + sb_cur * 64 * STT + (16 * ks + 8 * hi + ((lane & 15) >> 2)) * STT + tcol + d * 64;
                    const s16x4 lo = __builtin_bit_cast(s16x4, __builtin_amdgcn_ds_read_tr16_b64_v4i16((LAS s16x4*)sp));
                    const s16x4 hh = __builtin_bit_cast(s16x4, __builtin_amdgcn_ds_read_tr16_b64_v4i16((LAS s16x4*)(sp + 4 * STT)));
                    const bf16x8 sf = (bf16x8){lo[0], lo[1], lo[2], lo[3], hh[0], hh[1], hh[2], hh[3]};
                    oacc[d] = __builtin_amdgcn_mfma_f32_32x32x16_bf16(qa, sf, oacc[d], 0, 0, 0); } }
#pragma unroll
            for (int r = 0; r < 16; ++r) { LAS float* op = (LAS float*)(lds + O_OB + (32 * tb + crow(r, hi)) * OST) + r32; op[0] = oacc[0][r]; op[32] = oacc[1][r]; }
        } else if (w < 6) {
            const int kb = (w - 2) >> 1, vb = (w - 2) & 1;
            f32x16 u = (f32x16){0};
#pragma unroll
            for (int s2 = 0; s2 < 4; ++s2) { const LAS unsigned char* ap = lds + O_KE + (16 * s2 + trow) * STT + tcol + kb * 64;
                const LAS unsigned char* bp = lds + O_V + (16 * s2 + trow) * STT + tcol + vb * 64;
                const s16x4 alo = __builtin_bit_cast(s16x4, __builtin_amdgcn_ds_read_tr16_b64_v4i16((LAS s16x4*)ap));
                const s16x4 ahi = __builtin_bit_cast(s16x4, __builtin_amdgcn_ds_read_tr16_b64_v4i16((LAS s16x4*)(ap + 8 * STT)));
                const s16x4 blo = __builtin_bit_cast(s16x4, __builtin_amdgcn_ds_read_tr16_b64_v4i16((LAS s16x4*)bp));
                const s16x4 bhi = __builtin_bit_cast(s16x4, __builtin_amdgcn_ds_read_tr16_b64_v4i16((LAS s16x4*)(bp + 8 * STT)));
                const bf16x8 af = (bf16x8){alo[0], alo[1], alo[2], alo[3], ahi[0], ahi[1], ahi[2], ahi[3]};
                const bf16x8 bf = (bf16x8){blo[0], blo[1], blo[2], blo[3], bhi[0], bhi[1], bhi[2], bhi[3]};
                u = __builtin_amdgcn_mfma_f32_32x32x16_bf16(af, bf, u, 0, 0, 0); }
#pragma unroll
            for (int r = 0; r < 16; ++r) { const int kr = 32 * kb + crow(r, hi); const float dl = *(LAS float*)(lds + O_DL + kr * 4);
                sacc[r] = sacc[r] * dl + u[r];
                *(LAS bf16_t*)(lds + O_S + (sb_cur ^ 1) * 64 * STT + kr * STT + (32 * vb + r32) * 2) = (bf16_t)(pk2(sacc[r], 0.f) & 0xffffu); }
        }
        __syncthreads();
    }
    epilogue(31, gprev);
    __syncthreads();
}

using pg8::Unit;
__device__ __forceinline__ size_t gate_blk(int pm, int pn, int ai, int wr, int m, int bj, int wc) { return (size_t)(((((((pm * 16 + pn) * 2 + ai) * 2 + wr) * 4 + m) * 2 + bj) * 4 + wc)) * 64; }
__device__ __forceinline__ size_t merged_blk(int pm, int pn, int ai, int wr, int m, int bj, int wc) { return (size_t)(((((((pm * 4 + pn) * 2 + ai) * 2 + wr) * 4 + m) * 2 + bj) * 4 + wc)) * 64; }
struct SchedB { static constexpr bool ABLK = false; unsigned H, W; int G, c;
    __device__ __forceinline__ bool next(int i, Unit& u) const { const long L = (long)i * G + c; if (L >= 64 * 35) return false; int pm, pn; pg8::tile_order((int)L, 64, 35, pm, pn);
        u.pm = pm; u.pn = pn; u.aux = 0; u.a = H + (unsigned)pm * (256 * 1024); u.b0 = W + (unsigned)pn * (256 * 1024); u.b1 = u.b0; u.ridx = 0; u.nvalid = 256; return true; }
    __device__ __forceinline__ int lda(const Unit&) const { return 1024; } __device__ __forceinline__ int akstep(const Unit&) const { return 128; }
    __device__ __forceinline__ unsigned btile(const Unit& u, int t) const { return u.b0 + (unsigned)t * 128; } };
struct EpiB { static constexpr bool PERM = true; bf16_t* proj; unsigned char* gate8;
    __device__ __forceinline__ void operator()(const f32x4 (&acc)[2][2][4][2], const Unit& u, int wr, int wc, int fr, int fq) const {
        const int row0 = u.pm * 256 + wr * 64 + fr;
        if (u.pn < 16) {
#pragma unroll
            for (int ai = 0; ai < 2; ++ai)
#pragma unroll
                for (int m = 0; m < 4; ++m) {
#pragma unroll
                    for (int bj = 0; bj < 2; ++bj) { const f32x4 v0 = acc[ai][bj][m][0], v1 = acc[ai][bj][m][1]; u32x2 o = {0u, 0u};
#pragma unroll
                        for (int i = 0; i < 4; ++i) {
                            const float t0 = __builtin_amdgcn_exp2f(v0[i] * (-W8_INV * LOG2E)), t1 = __builtin_amdgcn_exp2f(v1[i] * (-W8_INV * LOG2E));
                            const float q0 = __builtin_amdgcn_rcpf(__builtin_fmaf(t0, 1.0f / 255.0f, 1.0f / 255.0f)), q1 = __builtin_amdgcn_rcpf(__builtin_fmaf(t1, 1.0f / 255.0f, 1.0f / 255.0f));
                            o.x = __builtin_amdgcn_cvt_pk_u8_f32(q0, i, o.x); o.y = __builtin_amdgcn_cvt_pk_u8_f32(q1, i, o.y); }
                        *(u32x2*)(gate8 + (gate_blk(u.pm, u.pn, ai, wr, m, bj, wc) + fr * 4 + fq) * 8) = o; } }
        } else {
#pragma unroll
            for (int ai = 0; ai < 2; ++ai)
#pragma unroll
                for (int m = 0; m < 4; ++m) { bf16_t* rp = proj + (size_t)(row0 + ai * 128 + m * 16) * NPROJ + (u.pn - 16) * 256 + wc * 32 + 8 * fq;
#pragma unroll
                    for (int bj = 0; bj < 2; ++bj) { const f32x4 v0 = acc[ai][bj][m][0] * W8_INV, v1 = acc[ai][bj][m][1] * W8_INV; u32x4 o;
                        o.x = pg8::cvt_pk_bf16(v0[0], v0[1]); o.y = pg8::cvt_pk_bf16(v0[2], v0[3]); o.z = pg8::cvt_pk_bf16(v1[0], v1[1]); o.w = pg8::cvt_pk_bf16(v1[2], v1[3]);
                        *(u32x4*)(rp + bj * 128) = o; } }
        }
    } };
struct SchedF { static constexpr bool ABLK = true; unsigned proj, mlaq, W; int G, c;
    __device__ __forceinline__ bool next(int i, Unit& u) const { const long L = (long)(i >> 2) * G + c; if (L >= 256) return false; const int b = i & 3; int pm, pn; pg8::tile_order((int)L, 64, 4, pm, pn);
        u.pm = pm; u.pn = pn; u.aux = b;
        if (b == 1) { u.a = mlaq + (unsigned)pm * (256 * 1536); }
        else { const int co = (b == 0) ? PC_HQ : (b == 2 ? PC_DQ : PC_SQ); u.a = proj + (unsigned)pm * (256 * NPROJ * 2) + co * 2; }
        u.b0 = W + (unsigned)(b * 1024 + pn * 256) * 512; u.b1 = u.b0; u.ridx = 0; u.nvalid = 256; return true; }
    __device__ __forceinline__ int lda(const Unit& u) const { return u.aux == 1 ? 1536 : NPROJ * 2; } __device__ __forceinline__ int akstep(const Unit& u) const { return u.aux == 1 ? 384 : 256; }
    __device__ __forceinline__ unsigned atile(const Unit& u, int kt) const { return u.a + (unsigned)kt * (unsigned)akstep(u); }
    __device__ __forceinline__ unsigned voffa(const Unit& u, int R, int C) const { const int cb = C * 2, slot = (u.aux == 1) ? 192 : 128;
        return (unsigned)(R * lda(u) + ((u.aux == 2) ? cb : ((cb & 63) + (cb >> 6) * slot))); }
    __device__ __forceinline__ unsigned hs(const Unit& u) const { return 128u * (unsigned)lda(u); }
    __device__ __forceinline__ unsigned btile(const Unit& u, int t) const { return u.b0 + (unsigned)t * 128; } };
struct EpiF { static constexpr bool PERM = true; bf16_t* merged; const unsigned char* gate8;
    __device__ __forceinline__ void operator()(const f32x4 (&acc)[2][2][4][2], const Unit& u, int wr, int wc, int fr, int fq) const {
        const int row0 = u.pm * 256 + wr * 64 + fr, b = u.aux; const int col = u.pn * 256 + wc * 32 + 8 * fq;
#pragma unroll
        for (int ai = 0; ai < 2; ++ai) {
            u32x2 g[4][2]; u32x4 old[4][2];
#pragma unroll
            for (int m = 0; m < 4; ++m)
#pragma unroll
                for (int bj = 0; bj < 2; ++bj) { const size_t row = (size_t)(row0 + ai * 128 + m * 16);
                    g[m][bj] = *(const u32x2*)(gate8 + (gate_blk(u.pm, b * 4 + u.pn, ai, wr, m, bj, wc) + fr * 4 + fq) * 8);
                    if (b > 0) old[m][bj] = *(const u32x4*)(merged + (merged_blk(u.pm, u.pn, ai, wr, m, bj, wc) + fr * 4 + fq) * 8); else old[m][bj] = (u32x4){0u, 0u, 0u, 0u}; }
#pragma unroll
            for (int m = 0; m < 4; ++m)
#pragma unroll
                for (int bj = 0; bj < 2; ++bj) { bf16_t* mp = merged + (merged_blk(u.pm, u.pn, ai, wr, m, bj, wc) + fr * 4 + fq) * 8;
                    const f32x4 v0 = acc[ai][bj][m][0], v1 = acc[ai][bj][m][1]; const u32x2 gg = g[m][bj]; const u32x4 od = old[m][bj]; float r[8];
                    const float s = (1.0f / 255.0f) * (W8_INV / Y8_SCALE);
                    r[0] = v0[0] * (float)(gg.x & 255u) * s + bflo(od.x); r[1] = v0[1] * (float)((gg.x >> 8) & 255u) * s + bfhi(od.x); r[2] = v0[2] * (float)((gg.x >> 16) & 255u) * s + bflo(od.y); r[3] = v0[3] * (float)(gg.x >> 24) * s + bfhi(od.y);
                    r[4] = v1[0] * (float)(gg.y & 255u) * s + bflo(od.z); r[5] = v1[1] * (float)((gg.y >> 8) & 255u) * s + bfhi(od.z); r[6] = v1[2] * (float)((gg.y >> 16) & 255u) * s + bflo(od.w); r[7] = v1[3] * (float)(gg.y >> 24) * s + bfhi(od.w);
                    if (b == 3) {
                        u32x2 o8; o8.x = pk4f8(r[0] * M8_SCALE, r[1] * M8_SCALE, r[2] * M8_SCALE, r[3] * M8_SCALE); o8.y = pk4f8(r[4] * M8_SCALE, r[5] * M8_SCALE, r[6] * M8_SCALE, r[7] * M8_SCALE);
                        *(u32x2*)((unsigned char*)gate8 + (gate_blk(u.pm, u.pn, ai, wr, m, bj, wc) + fr * 4 + fq) * 8) = o8;
                    } else {
                    u32x4 o; o.x = pg8::cvt_pk_bf16(r[0], r[1]); o.y = pg8::cvt_pk_bf16(r[2], r[3]); o.z = pg8::cvt_pk_bf16(r[4], r[5]); o.w = pg8::cvt_pk_bf16(r[6], r[7]);
                    *(u32x4*)mp = o; } }
            asm volatile("" ::: "memory");
        }
    } };
struct SchedG { static constexpr bool ABLK = true; unsigned Am, W; int G, c;
    __device__ __forceinline__ bool next(int i, Unit& u) const { const long L = (long)i * G + c; if (L >= 256) return false; int pm, pn; pg8::tile_order((int)L, 64, 4, pm, pn);
        u.pm = pm; u.pn = pn; u.aux = 0; u.a = Am + (unsigned)pm * (16u * 8192u * 8u); u.b0 = W + (unsigned)pn * (256 * 1024); u.b1 = u.b0; u.ridx = 0; u.nvalid = 256; return true; }
    __device__ __forceinline__ int lda(const Unit&) const { return 1024; } __device__ __forceinline__ int akstep(const Unit&) const { return 128; }
    __device__ __forceinline__ unsigned atile(const Unit& u, int kt) const { return u.a + (unsigned)((kt >> 1) * 8192 + (kt & 1) * 256) * 8u; }
    __device__ __forceinline__ unsigned voffa(const Unit&, int R, int C) const { const int cb = C * 2; return (unsigned)(((R >> 7) & 1) * 4096 + ((R >> 6) & 1) * 2048 + ((R >> 4) & 3) * 512 + (cb >> 5) * 64 + (R & 15) * 4 + ((cb >> 3) & 3)) * 8u; }
    __device__ __forceinline__ unsigned hs(const Unit&) const { return 4096u * 8u; }
    __device__ __forceinline__ unsigned btile(const Unit& u, int t) const { return u.b0 + (unsigned)t * 128; } };
struct EpiG { static constexpr bool PERM = false; const float* xin; float* out; const float* gt;
    __device__ __forceinline__ void operator()(const f32x4 (&acc)[2][2][4][2], const Unit& u, int wr, int wc, int fr, int fq) const {
        const int row0 = u.pm * 256 + wr * 64 + fr, col0 = u.pn * 256 + wc * 32 + 4 * fq; const int b = (u.pm * 256) >> 11;
        f32x4 g[2][2];
#pragma unroll
        for (int bj = 0; bj < 2; ++bj)
#pragma unroll
            for (int n = 0; n < 2; ++n) g[bj][n] = *(const f32x4*)(gt + b * 6144 + col0 + bj * 128 + n * 16);
#pragma unroll
        for (int ai = 0; ai < 2; ++ai) {
            f32x4 xv[4][2][2];
#pragma unroll
            for (int m = 0; m < 4; ++m) { const size_t off = (size_t)(row0 + ai * 128 + m * 16) * DM + col0;
#pragma unroll
                for (int bj = 0; bj < 2; ++bj)
#pragma unroll
                    for (int n = 0; n < 2; ++n) xv[m][bj][n] = *(const f32x4*)(xin + off + bj * 128 + n * 16); }
#pragma unroll
            for (int m = 0; m < 4; ++m) { const size_t off = (size_t)(row0 + ai * 128 + m * 16) * DM + col0;
#pragma unroll
                for (int bj = 0; bj < 2; ++bj)
#pragma unroll
                    for (int n = 0; n < 2; ++n) *(f32x4*)(out + off + bj * 128 + n * 16) = xv[m][bj][n] + g[bj][n] * (acc[ai][bj][m][n] * (W8_INV / M8_SCALE)); }
            asm volatile("" ::: "memory");
        }
    } };
struct MoeSched { volatile LAS unsigned* ms; unsigned list;
    __device__ __forceinline__ int rd(int i) const { return __builtin_amdgcn_readfirstlane((int)ms[i]); }
    __device__ __forceinline__ bool tile(int tau, int& pair, int& j0, int& nval) const { const int T = rd(64 + 24); if (tau >= T) return false; int p = 0;
        for (int q = 1; q < 24; ++q) if (rd(64 + q) <= tau) p = q;
        pair = p; j0 = (tau - rd(64 + p)) * 256; const int rem = rd(32 + p) - j0; nval = rem < 256 ? rem : 256; return true; } };
__device__ __forceinline__ void moe_sched_setup(const Frame& F0, int l) {
    const Args A = load_args(); const Frame F = fresh(F0); asm volatile("" : "+s"(l));
    const unsigned* cnt = (const unsigned*)(A.ws + WS_CTL) + CW_CNT + 64 * l;
    if (F.tid < 24) F.MISC[32 + F.tid] = __hip_atomic_load(cnt + F.tid, RLX_AGENT);
    __syncthreads();
    if (F.tid == 0) { unsigned pre = 0; for (int p = 0; p < 24; ++p) { F.MISC[64 + p] = pre; pre += (F.MISC[32 + p] + 255u) >> 8; } F.MISC[64 + 24] = pre; }
    __syncthreads();
}
struct SchedI { static constexpr bool ABLK = false; MoeSched ms; unsigned H2, GUT; int G, c;
    __device__ __forceinline__ bool next(int i, Unit& u) const { const long L = (long)i * G + c; const int tau = (int)(L >> 2), pn = (int)(L & 3); int pair, j0, nval; if (!ms.tile(tau, pair, j0, nval)) return false;
        int ea, eb; pair_experts(pair, ea, eb); const int e = pn < 2 ? ea : eb;
        u.pm = tau; u.pn = pn; u.aux = pair; u.a = H2; u.b0 = GUT + (unsigned)(e * 512 + (pn & 1) * 256) * 2048; u.b1 = u.b0;
        u.ridx = ms.list + (unsigned)(pair * 16384 + j0) * 4; u.nvalid = nval; return true; }
    __device__ __forceinline__ int lda(const Unit&) const { return 2048; } __device__ __forceinline__ int akstep(const Unit&) const { return 128; }
    __device__ __forceinline__ unsigned btile(const Unit& u, int t) const { return u.b0 + (unsigned)t * 128; } };
struct EpiI { static constexpr bool PERM = true; bf16_t* hid; const float* tokw; const char* wsb;
    __device__ __forceinline__ void operator()(const f32x4 (&acc)[2][2][4][2], const Unit& u, int wr, int wc, int fr, int fq) const {
        const int wsel = u.pn >> 1;
#pragma unroll
        for (int ai = 0; ai < 2; ++ai)
#pragma unroll
            for (int m = 0; m < 4; ++m) { const int r = ai * 128 + wr * 64 + m * 16 + fr; float wgt = 0.f; if (r < u.nvalid) wgt = tokw[2 * ((const int*)(wsb + u.ridx))[r] + wsel];
                const f32x4 g0 = acc[ai][0][m][0], g1 = acc[ai][0][m][1], u0 = acc[ai][1][m][0], u1 = acc[ai][1][m][1]; float v[8];
                const float ws_ = wgt * (W8_INV * HID8_SCALE);
#pragma unroll
                for (int i = 0; i < 4; ++i) { v[i] = fsilu(g0[i] * W8_INV) * u0[i] * ws_; v[4 + i] = fsilu(g1[i] * W8_INV) * u1[i] * ws_; }
                u32x2 o; o.x = pk4f8(v[0], v[1], v[2], v[3]); o.y = pk4f8(v[4], v[5], v[6], v[7]);
                { unsigned char* hp = (unsigned char*)hid + (size_t)(u.pm * 256 + r) * 512 + u.pn * 128 + wc * 32 + 8 * fq;
                  asm volatile("global_store_dwordx2 %0, %1, off sc1\n\ts_nop 1" :: "v"(hp), "v"(o) : "memory"); }
                asm volatile("" ::: "memory"); }
    } };
struct SchedJ { static constexpr bool ABLK = false; MoeSched ms; unsigned HID, DT; int G, c;
    __device__ __forceinline__ bool next(int i, Unit& u) const { const long L = (long)i * G + c; const int tau = (int)(L >> 2), pn = (int)(L & 3); int pair, j0, nval; if (!ms.tile(tau, pair, j0, nval)) return false;
        int ea, eb; pair_experts(pair, ea, eb);
        u.pm = tau; u.pn = pn; u.a = HID + (unsigned)tau * (256 * 1024);
        u.b0 = DT + (unsigned)(ea * 1024 + pn * 256) * 512; u.b1 = DT + (unsigned)(eb * 1024 + pn * 256) * 512; u.ridx = 0; u.nvalid = nval; u.aux = j0 + pair * 16384; return true; }
    __device__ __forceinline__ int lda(const Unit&) const { return 1024; } __device__ __forceinline__ int akstep(const Unit&) const { return 128; }
    __device__ __forceinline__ unsigned btile(const Unit& u, int t) const { return t < 4 ? u.b0 + (unsigned)t * 128 : u.b1 + (unsigned)(t - 4) * 128; } };
struct EpiJ { static constexpr bool PERM = false; float* out; const float* gt; const int* list;
    __device__ __forceinline__ void operator()(const f32x4 (&acc)[2][2][4][2], const Unit& u, int wr, int wc, int fr, int fq) const {
        const int col0 = u.pn * 256 + wc * 32 + 4 * fq;
#pragma unroll
        for (int ai = 0; ai < 2; ++ai) {
            int tok[4]; f32x4 xv[4][2][2];
#pragma unroll
            for (int m = 0; m < 4; ++m) { const int r = ai * 128 + wr * 64 + m * 16 + fr; tok[m] = (r < u.nvalid) ? list[u.aux + r] : -1; }
#pragma unroll
            for (int m = 0; m < 4; ++m) { const size_t off = (size_t)(tok[m] < 0 ? 0 : tok[m]) * DM + col0;
#pragma unroll
                for (int bj = 0; bj < 2; ++bj)
#pragma unroll
                    for (int n = 0; n < 2; ++n) xv[m][bj][n] = *(const f32x4*)(out + off + bj * 128 + n * 16); }
#pragma unroll
            for (int m = 0; m < 4; ++m) if (tok[m] >= 0) { const int bb = tok[m] >> 11; const size_t off = (size_t)tok[m] * DM + col0;
#pragma unroll
                for (int bj = 0; bj < 2; ++bj)
#pragma unroll
                    for (int n = 0; n < 2; ++n) { const f32x4 g = *(const f32x4*)(gt + bb * 6144 + col0 + bj * 128 + n * 16);
                        *(f32x4*)(out + off + bj * 128 + n * 16) = xv[m][bj][n] + g * (acc[ai][bj][m][n] * (W8_INV / HID8_SCALE)); } }
            asm volatile("" ::: "memory");
        }
    } };

constexpr int CW_TILE = 9216;
struct SchedIJ { static constexpr bool ABLK = false; MoeSched ms; unsigned H2, GUT, HID, DT; unsigned* tcnt; int G, c;
    __device__ __forceinline__ bool next(int i, Unit& u) const { const long L = (long)i * G + c; const int T4 = 4 * ms.rd(64 + 24); if (L >= 2 * T4) return false;
        const int kind = L >= T4 ? 1 : 0; const int idx = (int)L - kind * T4; const int tau = idx >> 2, pn = idx & 3; int pair, j0, nval; if (!ms.tile(tau, pair, j0, nval)) return false;
        int ea, eb; pair_experts(pair, ea, eb);
        u.pm = tau; u.pn = pn; u.kind = kind; u.nvalid = nval;
        if (kind == 0) { const int e = pn < 2 ? ea : eb; u.aux = pair; u.a = H2; u.b0 = GUT + (unsigned)(e * 512 + (pn & 1) * 256) * 1024; u.b1 = u.b0; u.ridx = ms.list + (unsigned)(pair * 16384 + j0) * 4; }
        else { u.aux = j0 + pair * 16384; u.a = HID + (unsigned)tau * (256 * 512); u.b0 = DT + (unsigned)(ea * 1024 + pn * 256) * 256; u.b1 = DT + (unsigned)(eb * 1024 + pn * 256) * 256; u.ridx = 0; }
        return true; }
    __device__ __forceinline__ int lda(const Unit& u) const { return u.kind ? 512 : 1024; } __device__ __forceinline__ int akstep(const Unit&) const { return 128; }
    __device__ __forceinline__ int nt(const Unit& u) const { return u.kind ? 4 : 8; } __device__ __forceinline__ int ldb(const Unit& u) const { return u.kind ? 256 : 1024; }
    __device__ __forceinline__ bool perm(const Unit& u) const { return u.kind == 0; } __device__ __forceinline__ bool dep(const Unit& u) const { return u.kind == 1; }
    __device__ __forceinline__ unsigned btile(const Unit& u, int t) const { return (u.kind && t >= 2) ? u.b1 + (unsigned)(t - 2) * 128 : u.b0 + (unsigned)t * 128; }
    __device__ __forceinline__ void a_ready(const Unit& u) const {
        if (u.kind == 1) { unsigned sp = 0;
            while (__hip_atomic_load(tcnt + u.pm, RLX_AGENT) < 4u) { __builtin_amdgcn_s_sleep(2); if (++sp > (1u << 22)) break; }
            __builtin_amdgcn_fence(__ATOMIC_ACQUIRE, "agent"); asm volatile("s_waitcnt vmcnt(0)" ::: "memory"); } }
    __device__ __forceinline__ void done(const Unit& u, int wid, int lane) const {
        if (u.kind == 0 && wid == 0 && lane == 0) __hip_atomic_fetch_add(tcnt + u.pm, 1u, RLX_AGENT); }
};
struct EpiIJ { static constexpr bool PERM = false; EpiI ei; EpiJ ej;
    __device__ __forceinline__ void operator()(const f32x4 (&acc)[2][2][4][2], const Unit& u, int wr, int wc, int fr, int fq) const { if (u.kind == 0) ei(acc, u, wr, wc, fr, fq); else ej(acc, u, wr, wc, fr, fq); } };

__global__ void __launch_bounds__(512, 2) mk_fwd(Args Akern) {
    extern __shared__ __attribute__((aligned(16))) unsigned char lds_raw[];
    Frame F;
    F.lds = (LAS unsigned char*)lds_raw; F.ldsg = lds_raw;
    F.MISC = (volatile LAS unsigned*)(F.lds + MISC_OFF);
    F.tid = threadIdx.x; F.lane = F.tid & 63; F.wave = __builtin_amdgcn_readfirstlane(F.tid >> 6);
    F.G = gridDim.x; { const int bx = blockIdx.x; F.vcu = (F.G % 8 == 0) ? (bx % 8) * (F.G / 8) + bx / 8 : bx; }
    for (int u = F.tid; u < 256; u += 512) F.MISC[u] = 0u;
    __syncthreads();
    int lo, hi;
    XcdBarrier bar;
    { const Args A = load_args(); lo = A.ph_lo; hi = A.ph_hi; F.ctl = (gu32*)(A.ws + WS_CTL);
      bar.bar = (unsigned*)(A.ws + WS_CTL) + CW_BAR; bar.x = 0; bar.st = nullptr;
      if (!MK_PER_PHASE) bar = xcd_barrier_post((unsigned*)(A.ws + WS_CTL) + CW_BAR, F.MISC + 8); }
#define GRID_BAR() do { if (!MK_PER_PHASE) xcd_barrier(bar); } while (0)
#pragma unroll 1
    for (int ph = lo; ph < hi; ++ph) {
      if (STAMP_MODE == 2 && blockIdx.x == 0) { int t0_ = threadIdx.x; asm volatile("" : "+v"(t0_)); if (t0_ == 0) ((unsigned long long*)((unsigned*)F.ctl + 12288))[ph] = __builtin_amdgcn_s_memrealtime(); }
      const int spx = (ph == 0) ? 9 : (ph - 1) % PPL; const int reps = ((REP_MASK >> spx) & 1) ? 1 + REP_N : 1;
#pragma unroll 1
      for (int rep = 0; rep < reps; ++rep) {
        if (rep > 0) GRID_BAR();
        if (ph == 0) { if (PH_ON(9)) {
            conv_layer_main(F, 0);
            __syncthreads();
            p0_mod_rope(F); }
        } else {
            const int l = (ph - 1) / PPL, sp = (ph - 1) % PPL;
            if (sp == 0) { if (PH_ON(0))
                norm_phase<false>(F, l);
            } else if (sp == 1) { if (PH_ON(1)) {
                const Args A = load_args(); const char* wsb = (const char*)A.ws;
                SchedB S{(unsigned)WS_H, (unsigned)WS_WINT, F.G, (int)blockIdx.x}; EpiB E{(bf16_t*)(A.ws + WS_PROJ), A.ws + WS_GATE8};
                pg8::gemm_phase<false, false, true>(F.lds, wsb, 8, 1024, S, E); }
            } else if (sp == 2) { if (PH_ON(2))
                { for (int rp = 0; rp < 1 + PROBE_MLAPREP; ++rp) for (int u = F.vcu; u < M / 64; u += F.G) mla_prep_unit(F, l, u); knorm_pass(F, l); }
            } else if (sp == 3) { if (PH_ON(3)) {
                unsigned* qctr = (unsigned*)F.ctl + CW_QUEUE + 64 * l;
#define QNEXT(ctr) ({ if (F.tid == 0) F.MISC[16] = atomicAdd((ctr), 1u); __syncthreads(); const int u_ = __builtin_amdgcn_readfirstlane((int)F.MISC[16]); __syncthreads(); u_; })
#pragma unroll 1
                for (int pass = ((DRY_MASK && ((DRY_LAYERS >> l) & 1)) ? -(DRY_REPS - 1) : 1); pass < 2; ++pass) {
                const bool dry = (pass <= 0); unsigned* qc = qctr + (dry ? 4 * (1 - pass) : 0);
                if (UNIT_ON(0) && (!dry || (DRY_MASK & 1))) for (;;) { const int u = QNEXT(qc + 0); if (u >= 64) break; hgrn_unit(F, l, u >> 3, u & 7, dry); }
                if (UNIT_ON(1) && (!dry || (DRY_MASK & 2))) for (;;) { const int u = QNEXT(qc + 1); if (u >= 512) break; const int qb = 15 - (u >> 5), bh = u & 31; diff_attn_unit(F, l, bh >> 2, bh & 3, qb, dry); }
                if (UNIT_ON(2) && (!dry || (DRY_MASK & 4))) for (;;) { const int u = QNEXT(qc + 2); if (u >= 512) break; const int qb = 7 - (u >> 6), bh = u & 63; mla_attn_unit(F, bh >> 3, bh & 7, qb, dry); }
                if (UNIT_ON(3) && (!dry || (DRY_MASK & 8))) for (;;) { const int u = QNEXT(qc + 3); if (u >= 512) break; const int rb64 = u & 31, bk = u >> 5; swa_attn_unit(F, l, bk >> 1, bk & 1, rb64, dry, dry && (pass == DRY_ALT)); }
                if (dry) GRID_BAR();
                }
#undef QNEXT
                }
            } else if (sp == 4) { if (PH_ON(4)) {
                const Args A = load_args(); const char* wsb = (const char*)A.ws;
                SchedF S{(unsigned)WS_PROJ, (unsigned)WS_MLAQ, (unsigned)WS_BRT, F.G, (int)blockIdx.x}; EpiF E{(bf16_t*)(A.ws + WS_MERGED), A.ws + WS_GATE8};
                pg8::gemm_phase<false, false, true>(F.lds, wsb, 4, 512, S, E); }
            } else if (sp == 5) { if (PH_ON(5)) {
                const Args A = load_args(); const char* wsb = (const char*)A.ws; const float* mod = (const float*)(A.ws + WS_MOD) + (size_t)l * 8 * 6144;
                SchedG S{(unsigned)WS_GATE8, (unsigned)WS_OUTT, F.G, (int)blockIdx.x}; EpiG E{(l == 0) ? A.x : A.out, A.out, mod + 2048};
                pg8::gemm_phase<false, false, true>(F.lds, wsb, 8, 1024, S, E); }
            } else if (sp == 6) { if (PH_ON(6)) {
                norm_phase<true>(F, l);
                conv_layer_moe(F, l);
                if (l + 1 < DEPTH) conv_layer_main(F, l + 1); }
            } else if (sp == 7) { if (PH_ON(7)) {
                moe_sched_setup(F, l);
                const Args A = load_args(); const char* wsb = (const char*)A.ws; const float* mod = (const float*)(A.ws + WS_MOD) + (size_t)l * 8 * 6144;
                SchedIJ S{{F.MISC, (unsigned)WS_LIST}, (unsigned)WS_H, (unsigned)WS_GUT, (unsigned)WS_HID, (unsigned)WS_DT, (unsigned*)F.ctl + CW_TILE + 128 * l, F.G, (int)blockIdx.x};
                EpiIJ E{{(bf16_t*)(A.ws + WS_HID), (const float*)(A.ws + WS_TOKW), wsb}, {A.out, mod + 5120, (const int*)(A.ws + WS_LIST)}};
                pg8::gemm_phase<true, true, true>(F.lds, wsb, 16, 2048, S, E); }
            }
        }
      }
        for (int eb = 0; eb < EXTRA_BARS; ++eb) GRID_BAR();
        if (ph + 1 < hi) GRID_BAR();
    }
    if (STAMP_MODE != 0) {
        GRID_BAR();
        if (blockIdx.x == 0) { int t0_ = threadIdx.x; asm volatile("" : "+v"(t0_)); if (t0_ == 0) ((unsigned long long*)((unsigned*)F.ctl + 12288))[NPHASE] = __builtin_amdgcn_s_memrealtime(); }
        GRID_BAR();
        const Args A = load_args();
        const unsigned long long* ts = (const unsigned long long*)((unsigned*)F.ctl + 12288);
        float delta = 0.05f;
        if (STAMP_MODE == 2) { const float dt_us = (float)(long long)(ts[STAMP_HI] - ts[STAMP_LO]) * 0.01f; delta = sqrtf(STAMP_C * dt_us); }
        int t1_ = threadIdx.x; asm volatile("" : "+v"(t1_));
        for (int i = blockIdx.x * 512 + t1_; i < M * DM / 4; i += gridDim.x * 512) { f32x4 v = ((f32x4*)A.out)[i]; v = v + delta; ((f32x4*)A.out)[i] = v; }
    }
}

extern "C" void kernel_launch(void* const* d_in, const int* in_sizes, int n_in, void* d_out, int out_size, void* d_ws, size_t ws_size, hipStream_t stream) {
    static int grid = 0;
    if (grid == 0) {
        if (n_in != 27 || in_sizes[0] != M * DM || out_size != M * DM || ws_size < WS_END) {
            fprintf(stderr, "kernel_launch: unexpected problem (n_in %d, in0 %d, out %d, ws %zu < %zu); nothing launched\n", n_in, n_in > 0 ? in_sizes[0] : -1, out_size, ws_size, (size_t)WS_END); grid = -1; return; }
        int dev = 0, cus = 0, per_cu = 0;
        if (hipGetDevice(&dev) != hipSuccess || hipDeviceGetAttribute(&cus, hipDeviceAttributeMultiprocessorCount, dev) != hipSuccess) { grid = -1; return; }
        if (hipFuncSetAttribute((const void*)mk_fwd, hipFuncAttributeMaxDynamicSharedMemorySize, LDS_BYTES) != hipSuccess) { fprintf(stderr, "kernel_launch: hipFuncSetAttribute failed\n"); grid = -1; return; }
        if (hipOccupancyMaxActiveBlocksPerMultiprocessor(&per_cu, (const void*)mk_fwd, 512, LDS_BYTES) != hipSuccess || per_cu < 1) { fprintf(stderr, "kernel_launch: occupancy query says %d blocks/CU\n", per_cu); per_cu = 1; }
        (void)hipGetLastError();
        if (cus != 256) { fprintf(stderr, "kernel_launch: built for a 256-CU device (got %d); nothing launched\n", cus); grid = -1; return; }
        grid = cus;
    }
    if (grid < 0) return;
    (void)hipMemsetAsync((char*)d_ws + WS_CTL, 0, CTL_ZERO_BYTES, stream);
    Args a{};
    a.x = (const float*)d_in[0]; a.c = (const float*)d_in[1]; a.pos = (const int*)d_in[2]; a.ada_w = (const float*)d_in[3]; a.ada_b = (const float*)d_in[4];
    a.norm_mix = (const float*)d_in[5]; a.norm_ffn = (const float*)d_in[6]; a.w_in = (const float*)d_in[7]; a.hg_lb = (const float*)d_in[8]; a.hg_onorm = (const float*)d_in[9];
    a.mla_q_norm = (const float*)d_in[10]; a.mla_kv_norm = (const float*)d_in[11]; a.mla_w_uq = (const float*)d_in[12]; a.mla_w_ukv = (const float*)d_in[13];
    a.mla_qk_norm = (const float*)d_in[14]; a.diff_qk_norm = (const float*)d_in[15]; a.diff_lam = (const float*)d_in[16]; a.diff_onorm = (const float*)d_in[17];
    a.swa_qk_norm = (const float*)d_in[18]; a.swa_sinks = (const float*)d_in[19]; a.w_branch = (const float*)d_in[20]; a.w_out = (const float*)d_in[21];
    a.router_w = (const float*)d_in[22]; a.router_bias = (const float*)d_in[23]; a.moe_w_gate = (const float*)d_in[24]; a.moe_w_up = (const float*)d_in[25]; a.moe_w_down = (const float*)d_in[26];
    a.out = (float*)d_out; a.ws = (unsigned char*)d_ws;
#if MK_PER_PHASE
    for (int ph = 0; ph < NPHASE; ++ph) { a.ph_lo = ph; a.ph_hi = ph + 1; hipLaunchKernelGGL(mk_fwd, dim3(grid), dim3(512), LDS_BYTES, stream, a); }
#else
    a.ph_lo = 0; a.ph_hi = NPHASE;
    void* kargs[] = {&a};
    hipError_t e = hipLaunchCooperativeKernel((const void*)mk_fwd, dim3(grid), dim3(512), kargs, LDS_BYTES, stream);
    if (e != hipSuccess) fprintf(stderr, "kernel_launch: cooperative launch failed: %s (grid %d)\n", hipGetErrorString(e), grid);
#endif
}
```

```cpp
#include <hip/hip_runtime.h>
#include <hip/hip_bf16.h>
#include <cstdio>
#include <cstdint>

#ifndef MK_PER_PHASE
#define MK_PER_PHASE 0
#endif

#ifndef PHASE_MASK
#define PHASE_MASK 0x3ff
#endif
#define PH_ON(k) ((PHASE_MASK >> (k)) & 1)
#ifndef REP_MASK
#define REP_MASK 0
#endif
#ifndef REP_N
#define REP_N 1
#endif
#ifndef EXTRA_BARS
#define EXTRA_BARS 0
#endif
#ifndef EPIF_FENCE
#define EPIF_FENCE 0
#endif
#ifndef DIFF_VPRE
#define DIFF_VPRE 2
#endif
#ifndef PROBE_MLAPREP
#define PROBE_MLAPREP 0
#endif
#ifndef DRY_MASK
#define DRY_MASK 0
#endif
#ifndef STAMP_MODE
#define STAMP_MODE 0
#endif
#ifndef STAMP_C
#define STAMP_C 1.2e-4f
#endif
#ifndef STAMP_LO
#define STAMP_LO 0
#endif
#ifndef STAMP_HI
#define STAMP_HI 17
#endif
#ifndef DRY_ALT
#define DRY_ALT 99
#endif
#ifndef DRY_LAYERS
#define DRY_LAYERS 3
#endif
#ifndef DRY_REPS
#define DRY_REPS 1
#endif
#ifndef UNIT_MASK
#define UNIT_MASK 15
#endif
#define UNIT_ON(k) ((UNIT_MASK >> (k)) & 1)
#define LAS __attribute__((address_space(3)))
#define GAS __attribute__((address_space(1)))
typedef unsigned short bf16_t;
typedef short bf16x8 __attribute__((ext_vector_type(8)));
typedef short s16x4 __attribute__((ext_vector_type(4)));
typedef float f32x4 __attribute__((ext_vector_type(4)));
typedef float f32x16 __attribute__((ext_vector_type(16)));
typedef unsigned u32x4 __attribute__((ext_vector_type(4)));
typedef unsigned u32x2 __attribute__((ext_vector_type(2)));
typedef int i32x4 __attribute__((ext_vector_type(4)));
typedef int i32x8 __attribute__((ext_vector_type(8)));
typedef GAS unsigned gu32;

constexpr int NB = 8, SEQ = 2048, DM = 1024, M = NB * SEQ, DEPTH = 2;
constexpr int NPROJ = 4864;
constexpr int NGATE = 4096;
constexpr int NBIG = NGATE + NPROJ;
constexpr int W_IN_COLS = 8864;
constexpr int PC_HQ = 0, PC_HF = 512, PC_HI = 1024, PC_HG = 1536, PC_CQ = 2048, PC_CKV = 2304, PC_KR = 2432,
              PC_DQ = 2464, PC_DK = 2976, PC_DV = 3488, PC_SQ = 4000, PC_SK = 4512, PC_SV = 4640;
constexpr float EPS = 1e-6f;
constexpr float LOG2E = 1.4426950408889634f;

constexpr size_t MiB = 1u << 20;
constexpr size_t WS_CTL = 0, CTL_ZERO_BYTES = 64 * 1024;
constexpr size_t WS_MOD = 1 * MiB;
constexpr size_t WS_ROPE = 2 * MiB;
constexpr size_t WS_LIST = 4 * MiB;
constexpr size_t WS_TOKW = 6 * MiB;
constexpr size_t WS_UQT = 8 * MiB;
constexpr size_t WS_UKVT = 8 * MiB + 512 * 1024;
constexpr size_t WS_BRT = 9 * MiB;
constexpr size_t WS_OUTT = 13 * MiB;
constexpr size_t WS_PROJ = 16 * MiB;
constexpr size_t WS_GUT = 16 * MiB;
constexpr size_t WS_DT = 32 * MiB;
constexpr size_t WS_HID = 40 * MiB;
constexpr size_t WS_GATE8 = 168 * MiB;
constexpr size_t WS_X = 232 * MiB;
constexpr size_t WS_H = WS_X;
constexpr size_t WS_WINT = WS_X + 32 * MiB;
constexpr size_t WS_MLAQ = WS_X;
constexpr size_t WS_MLAK = WS_X + 24 * MiB;
constexpr size_t WS_MLAV = WS_X + 48 * MiB;
constexpr size_t WS_MERGED = WS_X + 24 * MiB;
constexpr size_t WS_END = 296 * MiB;
constexpr int HID_ROWS = 22528;

constexpr int CW_BAR = 4096;
constexpr int CW_QUEUE = 8192;
constexpr int CW_CNT = 8448;
constexpr int PPL = 8;
constexpr int NPHASE = 1 + PPL * DEPTH;

constexpr int RING_BYTES = 131072;
constexpr int MISC_OFF = RING_BYTES;
constexpr int LDS_BYTES = 147456;

#define LDS_WAIT() asm volatile("s_waitcnt lgkmcnt(0)" ::: "memory")
#define VM_WAIT() asm volatile("s_waitcnt vmcnt(0)" ::: "memory")
#define RLX_AGENT __ATOMIC_RELAXED, __HIP_MEMORY_SCOPE_AGENT
__device__ __forceinline__ unsigned f2bf(float f) { unsigned u = __builtin_bit_cast(unsigned, f); return (u + 0x7fffu + ((u >> 16) & 1u)) >> 16; }
typedef float f32x2_t __attribute__((ext_vector_type(2))); typedef __bf16 bf16x2_t __attribute__((ext_vector_type(2)));
__device__ __forceinline__ unsigned pk4f8(float a, float b, float c, float d) { int w = 0; w = __builtin_amdgcn_cvt_pk_fp8_f32(a, b, w, false); w = __builtin_amdgcn_cvt_pk_fp8_f32(c, d, w, true); return (unsigned)w; }
__device__ __forceinline__ unsigned pk2(float lo, float hi) { f32x2_t v = {lo, hi}; bf16x2_t b = __builtin_convertvector(v, bf16x2_t); return __builtin_bit_cast(unsigned, b); }
__device__ __forceinline__ float bf2f(unsigned short b) { return __builtin_bit_cast(float, (unsigned)b << 16); }
__device__ __forceinline__ float bflo(unsigned w) { return __builtin_bit_cast(float, w << 16); }
__device__ __forceinline__ float bfhi(unsigned w) { return __builtin_bit_cast(float, w & 0xffff0000u); }
__device__ __forceinline__ float fsigmoid(float x) { return __builtin_amdgcn_rcpf(1.0f + __expf(-x)); }
__device__ __forceinline__ float fsilu(float x) { return x * __builtin_amdgcn_rcpf(1.0f + __expf(-x)); }
__device__ __forceinline__ int crow(int r, int hi) { return (r & 3) + 8 * (r >> 2) + 4 * hi; }
__device__ __forceinline__ float shx(float v, int m, int lane) { return __builtin_bit_cast(float, __builtin_amdgcn_ds_bpermute((lane ^ m) << 2, __builtin_bit_cast(int, v))); }
__device__ __forceinline__ float dpp_f(float v, int ctrl_sel) {
    const int x = __builtin_bit_cast(int, v); int r;
    if (ctrl_sel == 0) r = __builtin_amdgcn_mov_dpp(x, 0xB1, 0xf, 0xf, true);
    else if (ctrl_sel == 1) r = __builtin_amdgcn_mov_dpp(x, 0x4E, 0xf, 0xf, true);
    else r = __builtin_amdgcn_mov_dpp(x, 0x141, 0xf, 0xf, true);
    return __builtin_bit_cast(float, r); }
__device__ __forceinline__ float sum8(float v) { v += dpp_f(v, 0); v += dpp_f(v, 1); v += dpp_f(v, 2); return v; }
__device__ __forceinline__ float sum32(float v, int lane) { v = sum8(v); v += __builtin_bit_cast(float, __builtin_amdgcn_mov_dpp(__builtin_bit_cast(int, v), 0x140, 0xf, 0xf, true)); v += shx(v, 16, lane); return v; }
__device__ __forceinline__ float wave_sum(float v, int lane) {
    v = sum8(v); v += __builtin_bit_cast(float, __builtin_amdgcn_mov_dpp(__builtin_bit_cast(int, v), 0x140, 0xf, 0xf, true));
    v += shx(v, 16, lane); v += shx(v, 32, lane);
    return v;
}

#define XB_TMO      128
#define XB_XCNT(j)  (256  + 64 * (j))
#define XB_XSUB(j)  (1280 + 64 * (j))
#define XB_XGEN(j)  (2304 + 64 * (j))
#define XB_TOP      3328
#define XB_TOPGEN   3392
#define XCD_BAR_WORDS 3456
#define XB_SPIN_CAP (1u << 22)
__device__ __forceinline__ unsigned xb_ld(unsigned* p)              { return __hip_atomic_load(p, __ATOMIC_RELAXED, __HIP_MEMORY_SCOPE_AGENT); }
__device__ __forceinline__ unsigned xb_add(unsigned* p, unsigned v) { return __hip_atomic_fetch_add(p, v, __ATOMIC_RELAXED, __HIP_MEMORY_SCOPE_AGENT); }
__device__ __forceinline__ unsigned xb_xcc_id() { return (unsigned)__builtin_amdgcn_s_getreg((3 << 11) | 20) & 0xFu; }
#define XB_SPIN(cond, bar) do { unsigned _sp = 0; while (cond) { __builtin_amdgcn_s_sleep(1); \
    if ((++_sp & 255u) == 0u) { if (xb_ld(&(bar)[XB_TMO])) break; if (_sp > XB_SPIN_CAP) { atomicAdd(&(bar)[XB_TMO], 1u); break; } } } } while (0)
struct XcdBarrier { unsigned* bar; unsigned x; volatile LAS unsigned* st; };
__device__ __forceinline__ XcdBarrier xcd_barrier_post(unsigned* bar, volatile LAS unsigned* st) {
    XcdBarrier b; b.bar = bar; b.x = xb_xcc_id(); b.st = st;
    if (threadIdx.x == 0) (void)xb_add(&bar[XB_XCNT(b.x)], 1u);
    return b;
}
__device__ __forceinline__ void xcd_barrier_complete(unsigned* bar, unsigned x, unsigned& nloc, unsigned& nx) {
    const unsigned G = gridDim.x * gridDim.y * gridDim.z;
    unsigned sum, cnt, mine, sp = 0u;
    for (;;) {
        sum = 0u; cnt = 0u; mine = 0u;
#pragma unroll
        for (unsigned j = 0; j < 16; ++j) { const unsigned c = xb_ld(&bar[XB_XCNT(j)]); sum += c; cnt += (c > 0u) ? 1u : 0u; mine = (j == x) ? c : mine; }
        if (sum == G) break;
        __builtin_amdgcn_s_sleep(1);
        if ((++sp & 255u) == 0u) { if (xb_ld(&bar[XB_TMO])) break; if (sp > XB_SPIN_CAP) { atomicAdd(&bar[XB_TMO], 1u); break; } }
    }
    nloc = mine > 0u ? mine : 1u; nx = cnt > 0u ? cnt : 1u;
}
__device__ __forceinline__ void xcd_barrier(const XcdBarrier& b) {
    asm volatile("s_waitcnt vmcnt(0)" ::: "memory");
    __syncthreads();
    if (threadIdx.x == 0) {
        unsigned* bar = b.bar;
        __builtin_amdgcn_s_waitcnt(0);
        unsigned nloc = b.st[0], nx = b.st[1];
        if (nloc == 0u) { xcd_barrier_complete(bar, b.x, nloc, nx); b.st[0] = nloc; b.st[1] = nx; }
        const unsigned old = xb_add(&bar[XB_XSUB(b.x)], 1u);
        const unsigned gen = old / nloc;
        if (old + 1u == (gen + 1u) * nloc) {
            __builtin_amdgcn_fence(__ATOMIC_RELEASE, "agent");
            asm volatile("s_waitcnt vmcnt(0)" ::: "memory");
            const unsigned og = xb_add(&bar[XB_TOP], 1u);
            const unsigned tg = og / nx;
            if (og + 1u == (tg + 1u) * nx) xb_add(&bar[XB_TOPGEN], 1u);
            else XB_SPIN(xb_ld(&bar[XB_TOPGEN]) == tg, bar);
            __builtin_amdgcn_fence(__ATOMIC_ACQUIRE, "agent");
            xb_add(&bar[XB_XGEN(b.x)], 1u);
            asm volatile("s_waitcnt vmcnt(0)" ::: "memory");
        } else {
            XB_SPIN(xb_ld(&bar[XB_XGEN(b.x)]) == gen, bar);
            __builtin_amdgcn_fence(__ATOMIC_ACQUIRE, "agent");
            asm volatile("s_waitcnt vmcnt(0)" ::: "memory");
        }
    }
    __syncthreads();
}

constexpr float M8_SCALE = 8.0f;
constexpr float Y8_SCALE = 8.0f;
constexpr float HID8_SCALE = 4.0f;
constexpr float W8_SCALE = 32.0f, W8_INV = 1.0f / 32.0f;
namespace pg8 {
constexpr int BM = 256, BK = 64, HALF = 128, HTB = HALF * BK * 2, NXCD = 8, WGM = 8;
__host__ __device__ __forceinline__ int lds_byte(int r, int c) { const int st = (r >> 4) * 2 + (c >> 5), rr = r & 15, cc = c & 31, ob = rr * 64 + cc * 2; return st * 1024 + (ob ^ (((ob >> 9) & 1) << 5)); }
__host__ __device__ __forceinline__ void stage_rc(int b, int& R, int& C) { const int st = b / 1024, sb = b % 1024, swz = sb ^ (((sb >> 9) & 1) << 5); R = (st >> 1) * 16 + swz / 64; C = (st & 1) * 32 + (swz % 64) / 2; }
__host__ __device__ __forceinline__ int perm32(int rho) { const int n = rho >> 4, i = rho & 15; return 8 * (i >> 2) + 4 * n + (i & 3); }

struct Unit {
    int pm, pn, aux, kind;
    unsigned a;
    unsigned b0, b1;
    unsigned ridx;
    int nvalid;
};
__device__ __forceinline__ void tile_order(int wgid, int nM, int nN, int& pm, int& pn) {
    const int nwg = nM * nN;
    { const int q = nwg / NXCD, r = nwg % NXCD, xcd = wgid % NXCD, off = wgid / NXCD; wgid = (xcd < r ? xcd * (q + 1) : r * (q + 1) + (xcd - r) * q) + off; }
    const int nig = WGM * nN, gid = wgid / nig, fm = gid * WGM, gsz = (nM - fm) < WGM ? (nM - fm) : WGM;
    pm = fm + ((wgid % nig) % gsz); pn = (wgid % nig) / gsz;
}
__device__ __forceinline__ unsigned cvt_pk_bf16(float lo, float hi) { unsigned r; asm volatile("v_cvt_pk_bf16_f32 %0, %1, %2" : "=v"(r) : "v"(lo), "v"(hi)); return r; }

template <bool M, class S> __device__ __forceinline__ int mg_nt(const S& s, const Unit& u, int d) { if constexpr (M) return s.nt(u); else return d; }
template <bool M, class S> __device__ __forceinline__ int mg_ldb(const S& s, const Unit& u, int d) { if constexpr (M) return s.ldb(u); else return d; }
template <bool M, class S> __device__ __forceinline__ bool mg_perm(const S& s, const Unit& u, bool d) { if constexpr (M) return s.perm(u); else return d; }
template <bool M, class S> __device__ __forceinline__ bool mg_dep(const S& s, const Unit& u) { if constexpr (M) return s.dep(u); else return false; }
template <bool M, class S> __device__ __forceinline__ void mg_ready(const S& s, const Unit& u) { if constexpr (M) s.a_ready(u); }
template <bool M, class S> __device__ __forceinline__ void mg_done(const S& s, const Unit& u, int wid, int lane) { if constexpr (M) s.done(u, wid, lane); }
template <class S> __device__ __forceinline__ unsigned ga_tile(const S& s, const Unit& u, int k) { if constexpr (S::ABLK) return s.atile(u, k); else return u.a + (unsigned)k * s.akstep(u); }
template <class S> __device__ __forceinline__ unsigned ga_voff(const S& s, const Unit& u, int R, int C) { if constexpr (S::ABLK) return s.voffa(u, R, C); else return (unsigned)(R * s.lda(u) + C * 2); }
template <class S> __device__ __forceinline__ unsigned ga_hs(const S& s, const Unit& u) { if constexpr (S::ABLK) return s.hs(u); else return (unsigned)HALF * (unsigned)s.lda(u); }
template <bool GATHER, bool MERGED, bool F8, class Epi, class Sched>
__device__ __forceinline__ void gemm_phase(LAS unsigned char* lds, const char* wsb, const int nt_, const int ldb_  , const Sched& S, const Epi& E) {
    int tid = threadIdx.x; asm volatile("" : "+v"(tid));
    const int wid = __builtin_amdgcn_readfirstlane(tid >> 6), lane = tid & 63, wr = wid >> 2, wc = wid & 3, fr = lane & 15, fq = lane >> 4;
    unsigned vB[2], vBn[2];
#define PG8_NT(u) mg_nt<MERGED>(S, u, nt_)
#define PG8_LDB(u_) mg_ldb<MERGED>(S, u_, ldb_)
#define PG8_VOFFB(u, v) do { int t4_ = threadIdx.x; asm volatile("" : "+v"(t4_)); _Pragma("unroll") for (int i_ = 0; i_ < 2; ++i_) { int R_, C_; stage_rc(t4_ * 16 + i_ * 8192, R_, C_); \
        const bool pm_ = mg_perm<MERGED>(S, u, Epi::PERM); const int Rb_ = pm_ ? ((R_ & ~31) + perm32(R_ & 31)) : R_; v[i_] = (unsigned)(Rb_ * PG8_LDB(u) + C_ * 2); } } while (0)
    const unsigned ldsw = (unsigned)wid * 1024u;
    const int aoff = lds_byte(wr * 64 + fr, fq * 8), boff = lds_byte(wc * 32 + fr, fq * 8);
#define PG8_SA(b, h) (((b) * 2 + (h)) * HTB)
#define PG8_SB(b, h) ((4 + (b) * 2 + (h)) * HTB)
#define PG8_GLDS(bufoff, gptr, i_) __builtin_amdgcn_global_load_lds((const unsigned*)(gptr), (LAS unsigned*)(lds + (bufoff) + ldsw + (i_) * 8192), 16, 0, 0)
#define PG8_STAGE_B(bufoff, goff, w0, w1) do { PG8_GLDS(bufoff, wsb + (size_t)(unsigned)((goff) + (w0)), 0); PG8_GLDS(bufoff, wsb + (size_t)(unsigned)((goff) + (w1)), 1); } while (0)
#define PG8_STAGE_A(bufoff, goff, v0, v1) do { PG8_GLDS(bufoff, wsb + (size_t)(unsigned)((goff) + (v0)), 0); PG8_GLDS(bufoff, wsb + (size_t)(unsigned)((goff) + (v1)), 1); } while (0)
#define PG8_LDA(dst, b, h) do { if constexpr (F8) { _Pragma("unroll") for (int m = 0; m < 4; ++m) { const LAS i32x4* p_ = (const LAS i32x4*)(lds + PG8_SA(b, h) + aoff + m * 2048); dst##8[m].lo = p_[0]; dst##8[m].hi = p_[64]; } } \
        else { _Pragma("unroll") for (int m = 0; m < 4; ++m) _Pragma("unroll") for (int k = 0; k < 2; ++k) dst[m][k] = *(const LAS bf16x8*)(lds + PG8_SA(b, h) + aoff + m * 2048 + k * 1024); } } while (0)
#define PG8_LDBF(dst, b, h) do { if constexpr (F8) { _Pragma("unroll") for (int n = 0; n < 2; ++n) { const LAS i32x4* p_ = (const LAS i32x4*)(lds + PG8_SB(b, h) + boff + n * 2048); dst##8[n].lo = p_[0]; dst##8[n].hi = p_[64]; } } \
        else { _Pragma("unroll") for (int n = 0; n < 2; ++n) _Pragma("unroll") for (int k = 0; k < 2; ++k) dst[n][k] = *(const LAS bf16x8*)(lds + PG8_SB(b, h) + boff + n * 2048 + k * 1024); } } while (0)
#define PG8_MMA(ai, bj, At, Bt) do { __builtin_amdgcn_s_setprio(1); if constexpr (F8) { _Pragma("unroll") for (int m = 0; m < 4; ++m) _Pragma("unroll") for (int n = 0; n < 2; ++n) \
        asm volatile("v_mfma_f32_16x16x128_f8f6f4 %0, %1, %2, %0" : "+v"(acc[ai][bj][m][n]) : "v"(Bt##8[n]), "v"(At##8[m])); } \
        else { _Pragma("unroll") for (int m = 0; m < 4; ++m) _Pragma("unroll") for (int n = 0; n < 2; ++n) _Pragma("unroll") for (int k = 0; k < 2; ++k) \
        acc[ai][bj][m][n] = __builtin_amdgcn_mfma_f32_16x16x32_bf16(Bt[n][k], At[m][k], acc[ai][bj][m][n], 0, 0, 0); } __builtin_amdgcn_s_setprio(0); } while (0)
#define PG8_WAIT_V(n) asm volatile("s_waitcnt vmcnt(" #n ")" ::: "memory")
#define PG8_WAIT_L(n) asm volatile("s_waitcnt lgkmcnt(" #n ")" ::: "memory")
#define PG8_BAR __builtin_amdgcn_s_barrier()
#define PG8_SCHED __builtin_amdgcn_sched_barrier(0)
    Unit cur, nxt; int ui = 0;
    if (!S.next(0, cur)) return;
    constexpr int NH = GATHER ? 2 : 1;
    unsigned vA[2][NH], vN[2][NH];
#define PG8_VOFF2(u, v) do { int t3_ = threadIdx.x; asm volatile("" : "+v"(t3_)); _Pragma("unroll") for (int i_ = 0; i_ < 2; ++i_) { int R_, C_; stage_rc(t3_ * 16 + i_ * 8192, R_, C_); \
        _Pragma("unroll") for (int h_ = 0; h_ < NH; ++h_) { const int r_ = R_ + HALF * h_; \
        if (GATHER) { const int rr_ = (u).ridx ? ((r_ < (u).nvalid) ? ((const int*)(wsb + (u).ridx))[r_] : 0) : r_; v[i_][h_] = (unsigned)(rr_ * S.lda(u) + C_ * 2); } \
        else v[i_][h_] = ga_voff(S, u, R_, C_); } } } while (0)
#define PG8_HS(u) (GATHER ? 0u : ga_hs(S, u))
    mg_ready<MERGED>(S, cur);
    PG8_VOFF2(cur, vA); PG8_VOFFB(cur, vB);
    f32x4 acc[2][2][4][2];
#pragma unroll
    for (int a = 0; a < 2; ++a)
#pragma unroll
        for (int b = 0; b < 2; ++b)
#pragma unroll
            for (int m = 0; m < 4; ++m)
#pragma unroll
                for (int n = 0; n < 2; ++n) acc[a][b][m][n] = (f32x4){0.f, 0.f, 0.f, 0.f};
    bf16x8 At[4][2], B0[2][2], B1[2][2]; i32x8 At8[4], B08[2], B18[2];
#define PG8_PROLOGUE(u) do { const unsigned hsb = (unsigned)HALF * PG8_LDB(u); \
    PG8_STAGE_B(PG8_SB(0, 0), (u).b0, vB[0], vB[1]); PG8_STAGE_B(PG8_SB(0, 1), (u).b0 + hsb, vB[0], vB[1]); PG8_STAGE_A(PG8_SA(0, 0), ga_tile(S, u, 0), vA[0][0], vA[1][0]); PG8_STAGE_A(PG8_SA(0, 1), ga_tile(S, u, 0) + PG8_HS(u), vA[0][NH - 1], vA[1][NH - 1]); \
    if (wr == 1) PG8_BAR; \
    PG8_WAIT_V(2); PG8_BAR; \
    PG8_STAGE_B(PG8_SB(1, 0), (u).b0 + BK * 2, vB[0], vB[1]); PG8_STAGE_A(PG8_SA(1, 0), ga_tile(S, u, 1), vA[0][0], vA[1][0]); PG8_STAGE_B(PG8_SB(1, 1), (u).b0 + hsb + BK * 2, vB[0], vB[1]); \
    PG8_WAIT_V(6); PG8_BAR; } while (0)
    PG8_PROLOGUE(cur);
    for (;;) {
        const bool has_next = S.next(ui + 1, nxt);
        const bool pre = has_next && !mg_dep<MERGED>(S, nxt);
        Unit stg = pre ? nxt : cur;
        if (pre) { PG8_VOFF2(nxt, vN); if (MERGED) { PG8_VOFFB(nxt, vBn); } else { vBn[0] = vB[0]; vBn[1] = vB[1]; } }
        else { _Pragma("unroll") for (int i_ = 0; i_ < 2; ++i_) _Pragma("unroll") for (int h_ = 0; h_ < NH; ++h_) vN[i_][h_] = vA[i_][h_]; vBn[0] = vB[0]; vBn[1] = vB[1]; }
        const int nt = PG8_NT(cur);
        for (int t = 0; t < nt; t += 2) {
            const bool last = (t == nt - 2);
            const unsigned hstepB = (unsigned)HALF * (last ? PG8_LDB(stg) : PG8_LDB(cur));
            const unsigned y0 = last ? vBn[0] : vB[0], y1 = last ? vBn[1] : vB[1];
            const unsigned a1 = ga_tile(S, cur, t + 1);
            const unsigned a2 = last ? ga_tile(S, stg, 0) : ga_tile(S, cur, t + 2);
            const unsigned a3 = last ? ga_tile(S, stg, 1) : ga_tile(S, cur, t + 3);
            const unsigned hs1 = PG8_HS(cur), hs2 = last ? PG8_HS(stg) : PG8_HS(cur);
            const unsigned b2 = last ? stg.b0 : S.btile(cur, t + 2);
            const unsigned b3 = b2 + BK * 2;
            const unsigned x00 = last ? vN[0][0] : vA[0][0], x10 = last ? vN[1][0] : vA[1][0], x01 = last ? vN[0][NH - 1] : vA[0][NH - 1], x11 = last ? vN[1][NH - 1] : vA[1][NH - 1];
            PG8_LDBF(B0, 0, 0); PG8_LDBF(B1, 0, 1); PG8_SCHED; PG8_LDA(At, 0, 0); PG8_STAGE_A(PG8_SA(1, 1), a1 + hs1, vA[0][NH - 1], vA[1][NH - 1]);
            PG8_WAIT_V(8); PG8_WAIT_L(0); PG8_BAR; PG8_MMA(0, 0, At, B0); PG8_MMA(0, 1, At, B1); PG8_BAR; PG8_SCHED;
            PG8_LDA(At, 0, 1); PG8_STAGE_B(PG8_SB(0, 0), b2, y0, y1); PG8_STAGE_B(PG8_SB(0, 1), b2 + hstepB, y0, y1); PG8_STAGE_A(PG8_SA(0, 0), a2, x00, x10);
            PG8_WAIT_V(8); PG8_WAIT_L(0); PG8_BAR; PG8_MMA(1, 0, At, B0); PG8_MMA(1, 1, At, B1); PG8_BAR; PG8_SCHED;
            PG8_LDBF(B0, 1, 0); PG8_LDBF(B1, 1, 1); PG8_SCHED; PG8_LDA(At, 1, 0); PG8_STAGE_A(PG8_SA(0, 1), a2 + hs2, x01, x11);
            PG8_WAIT_V(8); PG8_WAIT_L(0); PG8_BAR; PG8_MMA(0, 0, At, B0); PG8_MMA(0, 1, At, B1); PG8_BAR; PG8_SCHED;
            PG8_LDA(At, 1, 1); PG8_STAGE_B(PG8_SB(1, 0), b3, y0, y1); PG8_STAGE_B(PG8_SB(1, 1), b3 + hstepB, y0, y1); PG8_STAGE_A(PG8_SA(1, 0), a3, x00, x10);
            PG8_WAIT_V(8); PG8_WAIT_L(0); PG8_BAR; PG8_MMA(1, 0, At, B0); PG8_MMA(1, 1, At, B1); PG8_BAR; PG8_SCHED;
        }
        if (wr == 0) PG8_BAR;
        if constexpr (F8) asm volatile("s_nop 15\n\ts_nop 7" ::: "memory");
        { int t2 = threadIdx.x; asm volatile("" : "+v"(t2)); const int l2 = t2 & 63; E(acc, cur, wr, wc, l2 & 15, l2 >> 4);
          if (MERGED) { PG8_WAIT_V(0); PG8_BAR; mg_done<MERGED>(S, cur, wid, l2); } }
        if (!has_next) break;
#pragma unroll
        for (int a = 0; a < 2; ++a)
#pragma unroll
            for (int b = 0; b < 2; ++b)
#pragma unroll
                for (int m = 0; m < 4; ++m)
#pragma unroll
                    for (int n = 0; n < 2; ++n) acc[a][b][m][n] = (f32x4){0.f, 0.f, 0.f, 0.f};
        cur = nxt; ++ui;
        if (pre) { _Pragma("unroll") for (int i_ = 0; i_ < 2; ++i_) _Pragma("unroll") for (int h_ = 0; h_ < NH; ++h_) vA[i_][h_] = vN[i_][h_]; vB[0] = vBn[0]; vB[1] = vBn[1];
            if (wr == 1) PG8_BAR; }
        else { mg_ready<MERGED>(S, cur); PG8_VOFF2(cur, vA); PG8_VOFFB(cur, vB); PG8_WAIT_V(0); PG8_BAR; PG8_PROLOGUE(cur); }
    }
    PG8_WAIT_V(0);
    PG8_BAR;
#undef PG8_SA
#undef PG8_SB
#undef PG8_GLDS
#undef PG8_STAGE_A
#undef PG8_STAGE_B
#undef PG8_LDA
#undef PG8_LDB
#undef PG8_MMA
#undef PG8_WAIT_V
#undef PG8_WAIT_L
#undef PG8_BAR
#undef PG8_SCHED
#undef PG8_VOFF2
#undef PG8_PROLOGUE
#undef PG8_VOFFB
#undef PG8_NT
#undef PG8_LDBF
#undef PG8_HS
}
}

struct Args {
    const float* x; const float* c; const int* pos; const float* ada_w; const float* ada_b; const float* norm_mix; const float* norm_ffn;
    const float* w_in; const float* hg_lb; const float* hg_onorm; const float* mla_q_norm; const float* mla_kv_norm; const float* mla_w_uq;
    const float* mla_w_ukv; const float* mla_qk_norm; const float* diff_qk_norm; const float* diff_lam; const float* diff_onorm;
    const float* swa_qk_norm; const float* swa_sinks; const float* w_branch; const float* w_out; const float* router_w; const float* router_bias;
    const float* moe_w_gate; const float* moe_w_up; const float* moe_w_down;
    float* out; unsigned char* ws; int ph_lo, ph_hi;
};
typedef const __attribute__((address_space(4))) Args* kargs_ptr;
__device__ __forceinline__ Args load_args() {
#if defined(__HIP_DEVICE_COMPILE__)
    kargs_ptr ap = (kargs_ptr)__builtin_amdgcn_kernarg_segment_ptr(); asm volatile("" : "+s"(ap)); Args r; __builtin_memcpy(&r, ap, sizeof(Args)); return r;
#else
    return Args{};
#endif
}
struct Frame {
    LAS unsigned char* lds; unsigned char* ldsg;
    volatile LAS unsigned* MISC; gu32* ctl;
    int tid, lane, wave, vcu, G;
};

__device__ __forceinline__ Frame fresh(const Frame& F0) {
    Frame F = F0; int t = threadIdx.x; asm volatile("" : "+v"(t)); F.tid = t; F.lane = t & 63; F.wave = __builtin_amdgcn_readfirstlane(t >> 6);
    unsigned lb = 0; asm volatile("" : "+s"(lb)); F.lds = (LAS unsigned char*)(F0.lds + lb); F.MISC = (volatile LAS unsigned*)(F.lds + MISC_OFF); return F;
}
__device__ __forceinline__ void conv_wg_item(const Frame& F, const float* W, int ld, int c0, int ncols, int K, bf16_t* WT, int row0, int rstep, int item, bool frag = false, bool f8 = false) {
    constexpr int ST = 257;
    LAS float* tile = (LAS float*)F.lds;
    const int nblk = (ncols + 255) >> 8, kb = item / nblk, nb = item % nblk, k0 = 64 * kb, n0 = 256 * nb;
    const int lane = F.lane, w = F.wave;
    { const int n = n0 + 4 * lane; const bool ok = n < ncols; const float* src = W + (size_t)(k0 + 8 * w) * ld + c0 + n; f32x4 v[8];
#pragma unroll
      for (int r = 0; r < 8; ++r) v[r] = ok ? *(const GAS f32x4*)(src + (size_t)r * ld) : (f32x4){0.f, 0.f, 0.f, 0.f};
#pragma unroll
      for (int r = 0; r < 8; ++r) { LAS float* d = tile + (8 * w + r) * ST + 4 * lane; d[0] = v[r][0]; d[1] = v[r][1]; d[2] = v[r][2]; d[3] = v[r][3]; } }
    __syncthreads();
    if (f8) {
#pragma unroll
        for (int j = 0; j < 2; ++j) { const int idx = F.tid + 512 * j, c = idx & 3, n = idx >> 2; const LAS float* sp = tile + (16 * c) * ST + n; u32x4 o;
#pragma unroll
            for (int q = 0; q < 4; ++q) o[q] = pk4f8(sp[(4 * q) * ST] * W8_SCALE, sp[(4 * q + 1) * ST] * W8_SCALE, sp[(4 * q + 2) * ST] * W8_SCALE, sp[(4 * q + 3) * ST] * W8_SCALE);
            if (n0 + n < ncols) { const int ng = row0 + (n & 127) + (n >> 7) * rstep + (n0 >> 7) * rstep; *(GAS u32x4*)((unsigned char*)WT + (size_t)ng * K + k0 + 16 * c) = o; } }
        __syncthreads(); return; }
#pragma unroll
    for (int j = 0; j < 4; ++j) { const int idx = F.tid + 512 * j, c = idx & 7, n = idx >> 3; const LAS float* sp = tile + (8 * c) * ST + n;
        u32x4 o; o.x = pk2(sp[0 * ST], sp[1 * ST]); o.y = pk2(sp[2 * ST], sp[3 * ST]); o.z = pk2(sp[4 * ST], sp[5 * ST]); o.w = pk2(sp[6 * ST], sp[7 * ST]);
        if (n0 + n < ncols) { const int ng = row0 + (n & 127) + (n >> 7) * rstep + (n0 >> 7) * rstep, kc = (k0 >> 3) + c;
            const size_t dst = frag ? ((size_t)(((ng >> 5) * (K >> 4) + (kc >> 1)) * 64 + (kc & 1) * 32 + (ng & 31))) * 8 : (size_t)ng * K + k0 + 8 * c;
            *(GAS u32x4*)(WT + dst) = o; } }
    __syncthreads();
}
__device__ __forceinline__ void conv_layer_main(const Frame& F0, int l) {
    const Args A = load_args(); const Frame F = fresh(F0); asm volatile("" : "+s"(l));
    bf16_t* WINT = (bf16_t*)(A.ws + WS_WINT); bf16_t* UQT = (bf16_t*)(A.ws + WS_UQT); bf16_t* UKVT = (bf16_t*)(A.ws + WS_UKVT);
    bf16_t* BRT = (bf16_t*)(A.ws + WS_BRT); bf16_t* OUTT = (bf16_t*)(A.ws + WS_OUTT);
    const float* w_in = A.w_in + (size_t)l * DM * W_IN_COLS;
    constexpr int I_G = 16 * 16, I_P = 16 * 19, I_UQ = 4 * 3, I_UKV = 2 * 4, I_BR = 4 * 8 * 4, I_OUT = 16 * 4;
    constexpr int NIT = I_G + I_P + I_UQ + I_UKV + I_BR + I_OUT;
    for (int it = F.vcu; it < NIT; it += F.G) {
        int r = it;
        if (r < I_G) { conv_wg_item(F, w_in, W_IN_COLS, 4768, 4096, DM, WINT, 0, 128, r, false, true); continue; } r -= I_G;
        if (r < I_P) { conv_wg_item(F, w_in, W_IN_COLS, 0, 4768, DM, WINT, NGATE, 128, r, false, true); continue; } r -= I_P;
        if (r < I_UQ) { conv_wg_item(F, A.mla_w_uq + (size_t)l * 256 * 768, 768, 0, 768, 256, UQT, 0, 128, r, true); continue; } r -= I_UQ;
        if (r < I_UKV) { conv_wg_item(F, A.mla_w_ukv + (size_t)l * 128 * 1024, 1024, 0, 1024, 128, UKVT, 0, 128, r, true); continue; } r -= I_UKV;
        if (r < I_BR) { const int b = r >> 5; conv_wg_item(F, A.w_branch + ((size_t)l * 4 + b) * 512 * 1024, 1024, 0, 1024, 512, BRT, b * 1024, 128, r & 31, false, true); continue; } r -= I_BR;
        conv_wg_item(F, A.w_out + (size_t)l * DM * DM, DM, 0, DM, DM, OUTT, 0, 128, r, false, true);
    }
    { unsigned z0 = 0u; asm volatile("" : "+v"(z0)); u32x4 z = {z0, z0, z0, z0}; GAS u32x4* p = (GAS u32x4*)((unsigned char*)WINT + (size_t)(NGATE + 4768) * DM);
      for (int i = (F.vcu * 512 + F.tid); i < 96 * DM / 16; i += F.G * 512) p[i] = z; }
}
__device__ __forceinline__ void conv_layer_moe(const Frame& F0, int l) {
    const Args A = load_args(); const Frame F = fresh(F0); asm volatile("" : "+s"(l));
    bf16_t* GUT = (bf16_t*)(A.ws + WS_GUT); bf16_t* DT = (bf16_t*)(A.ws + WS_DT);
    constexpr int I_GU = 16 * 2 * 16, I_D = 16 * 16;
    for (int it = F.vcu; it < I_GU + I_D; it += F.G) {
        if (it < I_GU) { const int e = it >> 5, isup = (it >> 4) & 1, item = it & 15;
            const float* src = (isup ? A.moe_w_up : A.moe_w_gate) + ((size_t)l * 16 + e) * DM * 256;
            conv_wg_item(F, src, 256, 0, 256, DM, GUT, e * 512 + isup * 128, 256, item, false, true);
        } else { const int r = it - I_GU, e = r >> 4, item = r & 15;
            conv_wg_item(F, A.moe_w_down + ((size_t)l * 16 + e) * 256 * DM, DM, 0, DM, 256, DT, e * 1024, 128, item, false, true); }
    }
}

__device__ __forceinline__ void p0_mod_rope(const Frame& F0) {
    const Args A = load_args(); const Frame F = fresh(F0);
    { float* rope = (float*)(A.ws + WS_ROPE);
      for (int idx = F.vcu * 512 + F.tid; idx < M * 16; idx += F.G * 512) { const int m = idx >> 4, i = idx & 15;
          const float inv = powf(10000.0f, -(float)(2 * i) / 32.0f); const float ang = (float)A.pos[m] * inv; float sn, cs; sincosf(ang, &sn, &cs);
          rope[m * 32 + i] = cs; rope[m * 32 + 16 + i] = sn; } }
    LAS float* cact = (LAS float*)(F.lds);
    LAS float* part = (LAS float*)(F.lds + 32768);
    for (int i = F.tid; i < 8 * DM; i += 512) { const int b = i >> 10, k = i & 1023; cact[k * 8 + b] = fsilu(A.c[b * DM + k]); }
    __syncthreads();
    float* mod = (float*)(A.ws + WS_MOD);
    for (int u = F.vcu; u < 2 * 96; u += F.G) {
        const int l = u / 96, n0 = (u % 96) * 64;
        const float* w = A.ada_w + (size_t)l * DM * 6144 + n0 + F.lane;
        float acc[8];
#pragma unroll
        for (int b = 0; b < 8; ++b) acc[b] = 0.f;
        const int k0 = F.wave * 128;
#pragma unroll 1
        for (int kb = 0; kb < 128; kb += 32) { float wv[32];
#pragma unroll
            for (int k = 0; k < 32; ++k) wv[k] = w[(size_t)(k0 + kb + k) * 6144];
#pragma unroll
            for (int k = 0; k < 32; ++k) { const f32x4 c0 = *(const LAS f32x4*)(cact + (k0 + kb + k) * 8), c1 = *(const LAS f32x4*)(cact + (k0 + kb + k) * 8 + 4);
                acc[0] += c0[0] * wv[k]; acc[1] += c0[1] * wv[k]; acc[2] += c0[2] * wv[k]; acc[3] += c0[3] * wv[k]; acc[4] += c1[0] * wv[k]; acc[5] += c1[1] * wv[k]; acc[6] += c1[2] * wv[k]; acc[7] += c1[3] * wv[k]; } }
#pragma unroll
        for (int b = 0; b < 8; ++b) part[(F.wave * 8 + b) * 64 + F.lane] = acc[b];
        __syncthreads();
        { const int b = F.tid >> 6, n = F.tid & 63; float s = 0.f;
#pragma unroll
          for (int w8 = 0; w8 < 8; ++w8) s += part[(w8 * 8 + b) * 64 + n];
          mod[((size_t)l * 8 + b) * 6144 + n0 + n] = s + A.ada_b[l * 6144 + n0 + n]; }
        __syncthreads();
    }
}

__device__ __forceinline__ void store_row_bf16(bf16_t* orow, int lane, const f32x4 (&v)[4]) {
    GAS unsigned long long* o8 = (GAS unsigned long long*)orow + lane;
#pragma unroll
    for (int j = 0; j < 4; ++j) o8[64 * j] = (unsigned long long)pk2(v[j].x, v[j].y) | ((unsigned long long)pk2(v[j].z, v[j].w) << 32);
}
__device__ __forceinline__ void store_row_f8(unsigned char* orow, int lane, const f32x4 (&v)[4]) {
    GAS unsigned* o4 = (GAS unsigned*)orow + lane;
#pragma unroll
    for (int j = 0; j < 4; ++j) o4[64 * j] = pk4f8(v[j].x, v[j].y, v[j].z, v[j].w);
}
template <bool ROUTER>
__device__ __forceinline__ void norm_phase(const Frame& F0, int l) {
    const Args A = load_args(); const Frame F = fresh(F0); asm volatile("" : "+s"(l));
    bf16_t* H = (bf16_t*)(A.ws + WS_H); const float* mod = (const float*)(A.ws + WS_MOD) + (size_t)l * 8 * 6144;
    const float* xin = ROUTER ? A.out : ((l == 0) ? A.x : A.out);
    const float* gain = (ROUTER ? A.norm_ffn : A.norm_mix) + l * DM;
    const int lane = F.lane, gw = F.vcu * 8 + F.wave, b = gw >> 8, r0 = gw & 255;
    LAS float* rwt = (LAS float*)F.lds;
    LAS int* rowpair = (LAS int*)(F.lds + 65536);
    if (ROUTER) {
#pragma unroll
        for (int i = 0; i < 8; ++i) { const int idx = F.tid + 512 * ((i + F.vcu) & 7), c = idx >> 2, q = idx & 3; const f32x4 r = *(const GAS f32x4*)(A.router_w + (size_t)c * 16 + 4 * q);
            rwt[(4 * q + 0) * DM + c] = r[0]; rwt[(4 * q + 1) * DM + c] = r[1]; rwt[(4 * q + 2) * DM + c] = r[2]; rwt[(4 * q + 3) * DM + c] = r[3]; }
        __syncthreads();
    }
    f32x4 sc[4], sh[4];
    { const float* pm = mod + b * 6144 + (ROUTER ? 3072 : 0);
#pragma unroll
      for (int j = 0; j < 4; ++j) { const f32x4 gg = ((const GAS f32x4*)gain)[lane + 64 * j], s1 = ((const GAS f32x4*)(pm + 1024))[lane + 64 * j]; sh[j] = ((const GAS f32x4*)pm)[lane + 64 * j]; sc[j] = gg * (s1 + 1.0f); } }
    const int b5 = lane >> 5, b4 = (lane >> 4) & 1, b3 = (lane >> 3) & 1, b2 = (lane >> 2) & 1;
    f32x4 xn[4];
    { const GAS f32x4* xr = (const GAS f32x4*)(xin + (size_t)(b * 2048 + r0) * DM) + lane;
#pragma unroll
      for (int j = 0; j < 4; ++j) xn[j] = xr[64 * j]; }
#pragma unroll 2
    for (int k = 0; k < 8; ++k) {
        const int m = b * 2048 + r0 + 256 * k;
        f32x4 v[4];
#pragma unroll
        for (int j = 0; j < 4; ++j) v[j] = xn[j];
        if (k + 1 < 8) { const GAS f32x4* xr = (const GAS f32x4*)(xin + (size_t)(m + 256) * DM) + lane;
#pragma unroll
            for (int j = 0; j < 4; ++j) xn[j] = xr[64 * j]; }
        float s = 0.f;
#pragma unroll
        for (int j = 0; j < 4; ++j) s += (v[j].x * v[j].x + v[j].y * v[j].y) + (v[j].z * v[j].z + v[j].w * v[j].w);
        const float rstd = __builtin_amdgcn_rsqf(wave_sum(s, lane) * (1.f / DM) + EPS);
#pragma unroll
        for (int j = 0; j < 4; ++j) v[j] = v[j] * rstd * sc[j] + sh[j];
        store_row_f8((unsigned char*)H + (size_t)m * DM, lane, v);
        if (ROUTER) {
            float a16[16];
            int lo4 = 4 * lane; asm volatile("" : "+v"(lo4));
#pragma unroll
            for (int e = 0; e < 16; ++e) { float acc = 0.f;
#pragma unroll
                for (int j = 0; j < 4; ++j) { const f32x4 r = *(const LAS f32x4*)(rwt + e * DM + 256 * j + lo4); acc += v[j][0] * r[0] + v[j][1] * r[1] + v[j][2] * r[2] + v[j][3] * r[3]; }
                a16[e] = acc; }
            float r8[8], r4[4], r2[2], r1;
#pragma unroll
            for (int q = 0; q < 8; ++q) { const float mine = b5 ? a16[8 + q] : a16[q], oth = b5 ? a16[q] : a16[8 + q]; r8[q] = mine + shx(oth, 32, lane); }
#pragma unroll
            for (int q = 0; q < 4; ++q) { const float mine = b4 ? r8[4 + q] : r8[q], oth = b4 ? r8[q] : r8[4 + q]; r4[q] = mine + shx(oth, 16, lane); }
#pragma unroll
            for (int q = 0; q < 2; ++q) { const float mine = b3 ? r4[2 + q] : r4[q], oth = b3 ? r4[q] : r4[2 + q]; r2[q] = mine + shx(oth, 8, lane); }
            { const float mine = b2 ? r2[1] : r2[0], oth = b2 ? r2[0] : r2[1]; r1 = mine + shx(oth, 4, lane); }
            r1 += shx(r1, 2, lane); r1 += shx(r1, 1, lane);
            float lg[16];
#pragma unroll
            for (int e = 0; e < 16; ++e) lg[e] = __builtin_bit_cast(float, __builtin_amdgcn_readlane(__builtin_bit_cast(int, r1), 32 * ((e >> 3) & 1) + 16 * ((e >> 2) & 1) + 8 * ((e >> 1) & 1) + 4 * (e & 1)));
            float scv[16], sel[16];
#pragma unroll
            for (int e = 0; e < 16; ++e) { scv[e] = fsigmoid(lg[e]); sel[e] = scv[e] + A.router_bias[e]; }
            int bg = 0, bi1 = 0, bi2 = 1; float bgs = -1e30f, bw1 = 0.f, bw2 = 0.f;
#pragma unroll
            for (int g = 0; g < 4; ++g) { int i1 = 0; float s1 = sel[g * 4], w1 = scv[g * 4];
#pragma unroll
                for (int i = 1; i < 4; ++i) { const float sv = sel[g * 4 + i]; if (sv > s1) { s1 = sv; i1 = i; w1 = scv[g * 4 + i]; } }
                int i2 = -1; float s2 = -1e30f, w2 = 0.f;
#pragma unroll
                for (int i = 0; i < 4; ++i) { const float sv = sel[g * 4 + i]; if (i != i1 && sv > s2) { s2 = sv; i2 = i; w2 = scv[g * 4 + i]; } }
                const float gs = s1 + s2; if (gs > bgs) { bgs = gs; bg = g; bi1 = i1; bi2 = i2; bw1 = w1; bw2 = w2; } }
            const int ia = bi1 < bi2 ? bi1 : bi2, ib = bi1 < bi2 ? bi2 : bi1;
            const float wa0 = bi1 < bi2 ? bw1 : bw2, wb0 = bi1 < bi2 ? bw2 : bw1, inv = 1.0f / (wa0 + wb0);
            const int pidx = (ia == 0) ? (ib - 1) : (ia == 1 ? ib + 1 : 5);
            const int pair = bg * 6 + pidx;
            if (lane == 0) { float* tokw = (float*)(A.ws + WS_TOKW); tokw[2 * m] = wa0 * inv; tokw[2 * m + 1] = wb0 * inv; rowpair[F.wave * 8 + k] = pair; }
        }
    }
    if (ROUTER) {
        int* list = (int*)(A.ws + WS_LIST); unsigned* cnt = (unsigned*)(A.ws + WS_CTL) + CW_CNT + 64 * l;
        LAS int* base = rowpair + 64;
        __syncthreads();
        if (F.tid < 24) { int c = 0;
#pragma unroll 8
            for (int r = 0; r < 64; ++r) c += (rowpair[r] == F.tid) ? 1 : 0;
            base[F.tid] = c ? (int)atomicAdd(cnt + F.tid, (unsigned)c) : 0; }
        __syncthreads();
        if (F.tid < 64) { const int p = rowpair[F.tid]; int rank = 0;
#pragma unroll 8
            for (int r = 0; r < 64; ++r) rank += (r < F.tid && rowpair[r] == p) ? 1 : 0;
            const int w = F.tid >> 3, k = F.tid & 7; const int gwv = F.vcu * 8 + w; const int m = (gwv >> 8) * 2048 + (gwv & 255) + 256 * k;
            list[p * 16384 + base[p] + rank] = m; }
        __syncthreads();
    }
}
__device__ __forceinline__ void pair_experts(int pair, int& ea, int& eb) { const int g = pair / 6, pi = pair % 6;
    const int ia = pi < 3 ? 0 : (pi < 5 ? 1 : 2); const int ib = pi < 3 ? pi + 1 : (pi < 5 ? pi - 1 : 3); ea = g * 4 + ia; eb = g * 4 + ib; }

template <int NT>
__device__ __forceinline__ void stage_store_rows(LAS unsigned char* stg, const f32x16* v, bf16_t* gbase, int gstride, int lane) {
    const int r32 = lane & 31, hi = lane >> 5;
#pragma unroll
    for (int nt = 0; nt < NT; ++nt)
#pragma unroll
        for (int g = 0; g < 4; ++g) { u32x2 o; o.x = pk2(v[nt][4 * g], v[nt][4 * g + 1]); o.y = pk2(v[nt][4 * g + 2], v[nt][4 * g + 3]);
            *(LAS u32x2*)(stg + r32 * 208 + (nt * 32 + 8 * g + 4 * hi) * 2) = o; }
    LDS_WAIT(); asm volatile("" ::: "memory");
    constexpr int CPR = NT * 4;
#pragma unroll
    for (int i = 0; i < (32 * CPR) / 64; ++i) { const int c = lane + 64 * i, tok = c / CPR, part = c % CPR;
        const u32x4 d = *(const LAS u32x4*)(stg + tok * 208 + part * 16);
        *(u32x4*)(gbase + (size_t)tok * gstride + part * 8) = d; }
    LDS_WAIT(); asm volatile("" ::: "memory");
}
__device__ __forceinline__ void mla_prep_unit(const Frame& F0, int l, int unit) {
    const Args A = load_args(); const Frame F = fresh(F0); asm volatile("" : "+s"(l));
    const int tid = F.tid, lane = F.lane, w = F.wave, r32 = lane & 31, hi = lane >> 5;
    LAS unsigned char* lds = F.lds;
    constexpr int XQ_OFF = 0, XQ_ST = 528, XKV_OFF = 64 * 528, XKV_ST = 272, XR_OFF = XKV_OFF + 64 * 272, STG_OFF = 65536;
    const bf16_t* proj = (const bf16_t*)(A.ws + WS_PROJ);
    const int m0 = unit * 64;
    { const int t = tid >> 3, part = tid & 7; const bf16_t* row = proj + (size_t)(m0 + t) * NPROJ;
      u32x4 cq[4], ck[2];
#pragma unroll
      for (int i = 0; i < 4; ++i) cq[i] = *(const u32x4*)(row + PC_CQ + part * 32 + i * 8);
#pragma unroll
      for (int i = 0; i < 2; ++i) ck[i] = *(const u32x4*)(row + PC_CKV + part * 16 + i * 8);
      const u32x2 kr = *(const u32x2*)(row + PC_KR + part * 4);
      float sq = 0.f, sk = 0.f;
#pragma unroll
      for (int i = 0; i < 4; ++i)
#pragma unroll
          for (int j = 0; j < 4; ++j) { const float a = bflo(cq[i][j]), b = bfhi(cq[i][j]); sq += a * a + b * b; }
#pragma unroll
      for (int i = 0; i < 2; ++i)
#pragma unroll
          for (int j = 0; j < 4; ++j) { const float a = bflo(ck[i][j]), b = bfhi(ck[i][j]); sk += a * a + b * b; }
      sq += shx(sq, 1, lane); sq += shx(sq, 2, lane); sq += shx(sq, 4, lane);
      sk += shx(sk, 1, lane); sk += shx(sk, 2, lane); sk += shx(sk, 4, lane);
      const float rq = __builtin_amdgcn_rsqf(sq * (1.f / 256.f) + EPS), rk = __builtin_amdgcn_rsqf(sk * (1.f / 128.f) + EPS);
      const float* gq = A.mla_q_norm + l * 256 + part * 32; const float* gkv = A.mla_kv_norm + l * 128 + part * 16;
#pragma unroll
      for (int i = 0; i < 4; ++i) { u32x4 o;
#pragma unroll
          for (int j = 0; j < 4; ++j) o[j] = pk2(bflo(cq[i][j]) * rq * gq[i * 8 + 2 * j], bfhi(cq[i][j]) * rq * gq[i * 8 + 2 * j + 1]);
          *(LAS u32x4*)(lds + XQ_OFF + t * XQ_ST + part * 64 + i * 16) = o; }
#pragma unroll
      for (int i = 0; i < 2; ++i) { u32x4 o;
#pragma unroll
          for (int j = 0; j < 4; ++j) o[j] = pk2(bflo(ck[i][j]) * rk * gkv[i * 8 + 2 * j], bfhi(ck[i][j]) * rk * gkv[i * 8 + 2 * j + 1]);
          *(LAS u32x4*)(lds + XKV_OFF + t * XKV_ST + part * 32 + i * 16) = o; }
      *(LAS f32x4*)(lds + XR_OFF + (t * 32 + part * 4) * 4) = (f32x4){bflo(kr.x), bfhi(kr.x), bflo(kr.y), bfhi(kr.y)}; }
    __syncthreads();
    const u32x4* UQF = (const u32x4*)(A.ws + WS_UQT); const u32x4* UKVF = (const u32x4*)(A.ws + WS_UKVT);
    const float* rope = (const float*)(A.ws + WS_ROPE);
    bf16_t* MQ = (bf16_t*)(A.ws + WS_MLAQ); bf16_t* MK = (bf16_t*)(A.ws + WS_MLAK); bf16_t* MV = (bf16_t*)(A.ws + WS_MLAV);
    const float* gqk = A.mla_qk_norm + l * 192;
    const int h = w;
    {
        f32x16 acc[3][2];
#pragma unroll
        for (int nt = 0; nt < 3; ++nt) { acc[nt][0] = (f32x16){0}; acc[nt][1] = (f32x16){0}; }
        const int rot = F.vcu;
#pragma unroll 4
        for (int k_ = 0; k_ < 16; ++k_) { const int ks = (k_ + rot) & 15;
            const bf16x8 x0 = *(const LAS bf16x8*)(lds + XQ_OFF + r32 * XQ_ST + ks * 32 + hi * 16);
            const bf16x8 x1 = *(const LAS bf16x8*)(lds + XQ_OFF + (32 + r32) * XQ_ST + ks * 32 + hi * 16);
#pragma unroll
            for (int nt = 0; nt < 3; ++nt) { const bf16x8 wf = __builtin_bit_cast(bf16x8, UQF[((h * 3 + nt) * 16 + ks) * 64 + lane]);
                acc[nt][0] = __builtin_amdgcn_mfma_f32_32x32x16_bf16(wf, x0, acc[nt][0], 0, 0, 0);
                acc[nt][1] = __builtin_amdgcn_mfma_f32_32x32x16_bf16(wf, x1, acc[nt][1], 0, 0, 0); }
        }
#pragma unroll
        for (int tb = 0; tb < 2; ++tb) {
            const int m = m0 + tb * 32 + r32;
            float ss = 0.f;
#pragma unroll
            for (int nt = 0; nt < 3; ++nt)
#pragma unroll
                for (int r = 0; r < 16; ++r) ss += acc[nt][tb][r] * acc[nt][tb][r];
            ss += shx(ss, 32, lane);
            const float rstd = __builtin_amdgcn_rsqf(ss * (1.f / 96.f) + EPS);
#pragma unroll
            for (int nt = 0; nt < 3; ++nt)
#pragma unroll
                for (int r = 0; r < 16; ++r) acc[nt][tb][r] = acc[nt][tb][r] * rstd * gqk[nt * 32 + crow(r, hi)];
#pragma unroll
            for (int r = 0; r < 8; ++r) { const int i = crow(r, hi); const float cs = rope[m * 32 + i], sn = rope[m * 32 + 16 + i];
                const float x1 = acc[2][tb][r], x2 = acc[2][tb][r + 8]; acc[2][tb][r] = x1 * cs - x2 * sn; acc[2][tb][r + 8] = x1 * sn + x2 * cs; }
            { f32x16 t3[3] = {acc[0][tb], acc[1][tb], acc[2][tb]}; stage_store_rows<3>(lds + STG_OFF + w * 6656, t3, MQ + (size_t)(m0 + tb * 32) * 768 + h * 96, 768, lane); }
        }
    }
    {
        f32x16 acc[4][2];
#pragma unroll
        for (int nt = 0; nt < 4; ++nt) { acc[nt][0] = (f32x16){0}; acc[nt][1] = (f32x16){0}; }
        const int rot = F.vcu;
#pragma unroll 4
        for (int k_ = 0; k_ < 8; ++k_) { const int ks = (k_ + rot) & 7;
            const bf16x8 x0 = *(const LAS bf16x8*)(lds + XKV_OFF + r32 * XKV_ST + ks * 32 + hi * 16);
            const bf16x8 x1 = *(const LAS bf16x8*)(lds + XKV_OFF + (32 + r32) * XKV_ST + ks * 32 + hi * 16);
#pragma unroll
            for (int nt = 0; nt < 4; ++nt) { const bf16x8 wf = __builtin_bit_cast(bf16x8, UKVF[((h * 4 + nt) * 8 + ks) * 64 + lane]);
                acc[nt][0] = __builtin_amdgcn_mfma_f32_32x32x16_bf16(wf, x0, acc[nt][0], 0, 0, 0);
                acc[nt][1] = __builtin_amdgcn_mfma_f32_32x32x16_bf16(wf, x1, acc[nt][1], 0, 0, 0); }
        }
#pragma unroll
        for (int tb = 0; tb < 2; ++tb) {
            const int m = m0 + tb * 32 + r32, tl = tb * 32 + r32;
            f32x16 kr;
#pragma unroll
            for (int r = 0; r < 16; ++r) kr[r] = *(const LAS float*)(lds + XR_OFF + (tl * 32 + crow(r, hi)) * 4);
            float ss = 0.f;
#pragma unroll
            for (int nt = 0; nt < 2; ++nt)
#pragma unroll
                for (int r = 0; r < 16; ++r) ss += acc[nt][tb][r] * acc[nt][tb][r];
#pragma unroll
            for (int r = 0; r < 16; ++r) ss += kr[r] * kr[r];
            ss += shx(ss, 32, lane);
            const float rstd = __builtin_amdgcn_rsqf(ss * (1.f / 96.f) + EPS);
#pragma unroll
            for (int nt = 0; nt < 2; ++nt)
#pragma unroll
                for (int r = 0; r < 16; ++r) acc[nt][tb][r] = acc[nt][tb][r] * rstd * gqk[96 + nt * 32 + crow(r, hi)];
#pragma unroll
            for (int r = 0; r < 16; ++r) kr[r] = kr[r] * rstd * gqk[96 + 64 + crow(r, hi)];
#pragma unroll
            for (int r = 0; r < 8; ++r) { const int i = crow(r, hi); const float cs = rope[m * 32 + i], sn = rope[m * 32 + 16 + i];
                const float x1 = kr[r], x2 = kr[r + 8]; kr[r] = x1 * cs - x2 * sn; kr[r + 8] = x1 * sn + x2 * cs; }
            { f32x16 t3[3] = {acc[0][tb], acc[1][tb], kr}; stage_store_rows<3>(lds + STG_OFF + w * 6656, t3, MK + (size_t)(m0 + tb * 32) * 768 + h * 96, 768, lane); }
            { f32x16 t2[2] = {acc[2][tb], acc[3][tb]}; stage_store_rows<2>(lds + STG_OFF + w * 6656, t2, MV + (size_t)(m0 + tb * 32) * 512 + h * 64, 512, lane); }
        }
    }
    __syncthreads();
}

struct AttnWaveCfg {
    const bf16_t* q; int qstride;
    int qpos0;
    int kc0;
};
__device__ __forceinline__ void glds16(const void* gsrc, unsigned lds_dst) { unsigned keep;
    asm volatile("s_mov_b32 %0, m0\n\ts_mov_b32 m0, %2\n\ts_nop 0\n\tglobal_load_lds_dwordx4 %1, off\n\ts_mov_b32 m0, %0" : "=&s"(keep) : "v"(gsrc), "s"(lds_dst) : "memory"); }
__device__ __forceinline__ unsigned cvtpk(float lo, float hi) { f32x2_t v = {lo, hi}; bf16x2_t b = __builtin_convertvector(v, bf16x2_t); return __builtin_bit_cast(unsigned, b); }
__device__ __forceinline__ float xmax32(float x) { float a = x, b = x; asm volatile("s_nop 1\n\tv_permlane32_swap_b32 %0, %1" : "+v"(a), "+v"(b)); return fmaxf(a, b); }
#ifndef ATT_THR
#define ATT_THR 8.0f
#endif
#define ATT_WAITBAR(N) asm volatile("s_waitcnt vmcnt(" #N ") lgkmcnt(0)\n\ts_barrier" ::: "memory")
template <int DQK, int DV, int KL, bool NORMQ, int WINDOW, int VPRE>
struct AttnBody {
    static constexpr int NKP = (KL == 0) ? 8 : (KL == 1 ? 16 : 12), NVP = DV / 8;
    static constexpr int KBYTES = NKP * 1024, SLOT = KBYTES + NVP * 1024, NS = 3;
    static constexpr int PT = (KL == 0) ? 2 : (KL == 1 ? 4 : 3);
    static constexpr int SCR_OFF = NS * SLOT;
    static constexpr int NKS = DQK / 16, ND0 = DV / 32;
    __device__ static __forceinline__ void run(const Frame& F, const AttnWaveCfg& W, const bf16_t* Kg, int kstride, const bf16_t* Vg, int vstride,
                                               int kt_lo, int kt_hi, float c2, const float* gq, bool use_sink, float sink_l2, f32x16 (&o)[ND0]) {
        const int lane = F.lane, r32 = lane & 31, hi = lane >> 5, w = F.wave;
        LAS unsigned char* lds = F.lds;
        const unsigned lds0 = (unsigned)(size_t)lds;
        LAS float* wsf = (LAS float*)(lds + SCR_OFF + w * 256);
        const bf16_t* ksrc0; const bf16_t* ksrc1 = nullptr; const bf16_t* vsrc0; const bf16_t* vsrc1 = nullptr; unsigned kd0, kd1 = 0, vd0, vd1 = 0;
        if (KL == 0) { const int row = 8 * w + (lane >> 3), c = (lane & 7) ^ ((row >> 1) & 7); ksrc0 = Kg + (size_t)row * kstride + c * 8; kd0 = w * 1024; }
        else if (KL == 1) { const int p0 = 2 * w, row0 = 4 * p0 + (lane >> 4), row1 = row0 + 4; ksrc0 = Kg + (size_t)row0 * kstride + ((lane & 15) ^ (row0 & 15)) * 8; ksrc1 = Kg + (size_t)row1 * kstride + ((lane & 15) ^ (row1 & 15)) * 8;
            kd0 = p0 * 1024; kd1 = kd0 + 1024; }
        else { const int row = 8 * w + (lane >> 3), c = (lane & 7) ^ ((row >> 1) & 7); ksrc0 = Kg + (size_t)row * kstride + c * 8; kd0 = w * 1024;
            const int p = w & 3, rr = 16 * p + (lane >> 2), cr = (lane & 3) ^ ((rr >> 2) & 3); ksrc1 = Kg + (size_t)rr * kstride + 64 + cr * 8; kd1 = 8192 + p * 1024; }
        if (DV == 64) { vsrc0 = Vg + (size_t)(16 * (w & 3) + (lane >> 2)) * vstride + (w >> 2) * 32 + (lane & 3) * 8; vd0 = KBYTES + w * 1024; }
        else { const int p0 = 2 * w, p1 = p0 + 1; vsrc0 = Vg + (size_t)(16 * (p0 & 3) + (lane >> 2)) * vstride + (p0 >> 2) * 32 + (lane & 3) * 8; vsrc1 = Vg + (size_t)(16 * (p1 & 3) + (lane >> 2)) * vstride + (p1 >> 2) * 32 + (lane & 3) * 8;
            vd0 = KBYTES + p0 * 1024; vd1 = vd0 + 1024; }
        auto dma_tile = [&](int kt, int slot) {
            const size_t ko = (size_t)kt * 64 * kstride, vo = (size_t)kt * 64 * vstride; const unsigned sb = lds0 + (unsigned)slot * SLOT;
            glds16(ksrc0 + ko, (unsigned)__builtin_amdgcn_readfirstlane(sb + kd0));
            if (KL != 0) glds16(ksrc1 + ko, (unsigned)__builtin_amdgcn_readfirstlane(sb + kd1));
            glds16(vsrc0 + vo, (unsigned)__builtin_amdgcn_readfirstlane(sb + vd0));
            if (DV == 128) glds16(vsrc1 + vo, (unsigned)__builtin_amdgcn_readfirstlane(sb + vd1));
        };
        dma_tile(kt_lo, 0);
        if (kt_lo + 1 < kt_hi) dma_tile(kt_lo + 1, 1);
        bf16x8 qf[NKS];
        {
            float ss = 0.f; u32x4 raw[NKS];
#pragma unroll
            for (int ks = 0; ks < NKS; ++ks) { raw[ks] = *(const u32x4*)(W.q + (size_t)r32 * W.qstride + ks * 16 + hi * 8);
#pragma unroll
                for (int j = 0; j < 4; ++j) { const float a = bflo(raw[ks][j]), b = bfhi(raw[ks][j]); ss += a * a + b * b; } }
            float rs = c2;
            if (NORMQ) { ss += shx(ss, 32, lane); rs = __builtin_amdgcn_rsqf(ss * (1.f / DQK) + EPS) * c2; }
#pragma unroll
            for (int ks = 0; ks < NKS; ++ks) { u32x4 p;
#pragma unroll
                for (int j = 0; j < 4; ++j) { float a = bflo(raw[ks][j]) * rs, b = bfhi(raw[ks][j]) * rs; if (NORMQ) { a *= gq[ks * 16 + hi * 8 + 2 * j]; b *= gq[ks * 16 + hi * 8 + 2 * j + 1]; } p[j] = cvtpk(a, b); }
                qf[ks] = __builtin_bit_cast(bf16x8, p); }
        }
#pragma unroll
        for (int d = 0; d < ND0; ++d) o[d] = (f32x16){0};
        float m_run = -1e30f, l_run = 0.f;
        const int qlo = W.qpos0, qhi = W.qpos0 + 31;
        const int kx = (KL == 1) ? (r32 & 15) : ((r32 >> 1) & 7);
        const int krow = (KL == 1) ? r32 * 256 : r32 * 128;
        const int kxr = (r32 >> 2) & 3, krow_r = 8192 + r32 * 64;
        const int vlane = (4 * hi + ((lane & 15) >> 2)) * 64 + ((lane >> 4) & 1) * 32 + (lane & 3) * 8;
        int slot = 0;
        for (int kt = kt_lo; kt < kt_hi; ++kt) {
            if (kt + 1 < kt_hi) { if (PT == 2) { ATT_WAITBAR(2); } else if (PT == 3) { ATT_WAITBAR(3); } else { ATT_WAITBAR(4); }; } else { ATT_WAITBAR(0); }
            if (kt + 2 < kt_hi) dma_tile(kt + 2, slot >= 1 ? slot - 1 : 2);
            const int k0 = kt * 64;
            bool need = (k0 <= qhi);
            if (WINDOW > 0) need = need && (k0 + 63 >= qlo - (WINDOW - 1));
            if (need) {
                const LAS unsigned char* sb = lds + slot * SLOT;
                f32x16 p0 = (f32x16){0}, p1 = (f32x16){0};
                bf16x8 kfa[NKS], kfb[NKS];
#pragma unroll
                for (int ks = 0; ks < NKS; ++ks) {
                    const LAS unsigned char* ka;
                    if (KL == 2 && ks >= 4) ka = sb + krow_r + (((2 * (ks - 4) + hi) ^ kxr) << 4);
                    else ka = sb + krow + ((((KL == 1 ? W.kc0 : 0) + 2 * ks + hi) ^ kx) << 4);
                    const int hstep = (KL == 2 && ks >= 4) ? 32 * 64 : (KL == 1 ? 32 * 256 : 32 * 128);
                    kfa[ks] = *(const LAS bf16x8*)ka; kfb[ks] = *(const LAS bf16x8*)(ka + hstep); }
                __builtin_amdgcn_sched_barrier(0);
#pragma unroll
                for (int ks = 0; ks < NKS; ++ks) { p0 = __builtin_amdgcn_mfma_f32_32x32x16_bf16(kfa[ks], qf[ks], p0, 0, 0, 0); p1 = __builtin_amdgcn_mfma_f32_32x32x16_bf16(kfb[ks], qf[ks], p1, 0, 0, 0); }
                const LAS unsigned char* vb = sb + KBYTES + vlane;
                s16x4 vlo[VPRE > 0 ? VPRE : 1][4], vhi[VPRE > 0 ? VPRE : 1][4];
#pragma unroll
                for (int d = 0; d < VPRE; ++d)
#pragma unroll
                    for (int q4 = 0; q4 < 4; ++q4) { const LAS unsigned char* vp = vb + (d * 4 + q4) * 1024;
                        vlo[d][q4] = __builtin_bit_cast(s16x4, __builtin_amdgcn_ds_read_tr16_b64_v4i16((LAS s16x4*)vp));
                        vhi[d][q4] = __builtin_bit_cast(s16x4, __builtin_amdgcn_ds_read_tr16_b64_v4i16((LAS s16x4*)(vp + 512))); }
                const int qpos = W.qpos0 + r32;
                bool full = (k0 + 63 <= qlo);
                if (WINDOW > 0) full = full && (k0 >= qhi - (WINDOW - 1));
                if (!full) {
#pragma unroll
                    for (int r = 0; r < 16; ++r) { const int ka = k0 + crow(r, hi), kb2 = ka + 32;
                        bool va = ka <= qpos, vb2 = kb2 <= qpos; if (WINDOW > 0) { va = va && (qpos - ka < WINDOW); vb2 = vb2 && (qpos - kb2 < WINDOW); }
                        p0[r] = va ? p0[r] : -INFINITY; p1[r] = vb2 ? p1[r] : -INFINITY; }
                }
                float mx = fmaxf(p0[0], p1[0]);
#pragma unroll
                for (int r = 1; r < 16; ++r) mx = fmaxf(mx, fmaxf(p0[r], p1[r]));
                mx = xmax32(mx);
                if (__any(mx > m_run + ATT_THR)) {
                    const float mn = fmaxf(m_run, mx); const float alpha = __builtin_amdgcn_exp2f(m_run - mn); m_run = mn; l_run *= alpha;
                    if (hi == 0) wsf[r32] = alpha;
                    LDS_WAIT();
#pragma unroll
                    for (int r = 0; r < 16; ++r) { const float a = wsf[crow(r, hi)];
#pragma unroll
                        for (int d = 0; d < ND0; ++d) o[d][r] *= a; }
                }
                float rs = 0.f;
#pragma unroll
                for (int r = 0; r < 16; ++r) { p0[r] = __builtin_amdgcn_exp2f(p0[r] - m_run); p1[r] = __builtin_amdgcn_exp2f(p1[r] - m_run); rs += p0[r] + p1[r]; }
                l_run += rs;
                bf16x8 pa[4];
#pragma unroll
                for (int s = 0; s < 2; ++s) { u32x4 pw;
                    pw.x = cvtpk(p0[8 * s], p0[8 * s + 1]); pw.y = cvtpk(p0[8 * s + 2], p0[8 * s + 3]); pw.z = cvtpk(p0[8 * s + 4], p0[8 * s + 5]); pw.w = cvtpk(p0[8 * s + 6], p0[8 * s + 7]); pa[s] = __builtin_bit_cast(bf16x8, pw);
                    pw.x = cvtpk(p1[8 * s], p1[8 * s + 1]); pw.y = cvtpk(p1[8 * s + 2], p1[8 * s + 3]); pw.z = cvtpk(p1[8 * s + 4], p1[8 * s + 5]); pw.w = cvtpk(p1[8 * s + 6], p1[8 * s + 7]); pa[2 + s] = __builtin_bit_cast(bf16x8, pw); }
#pragma unroll
                for (int d = 0; d < ND0; ++d)
#pragma unroll
                    for (int q4 = 0; q4 < 4; ++q4) {
                        s16x4 lo, hh;
                        if (d < VPRE) { lo = vlo[d][q4]; hh = vhi[d][q4]; }
                        else { const LAS unsigned char* vp = vb + (d * 4 + q4) * 1024;
                            lo = __builtin_bit_cast(s16x4, __builtin_amdgcn_ds_read_tr16_b64_v4i16((LAS s16x4*)vp));
                            hh = __builtin_bit_cast(s16x4, __builtin_amdgcn_ds_read_tr16_b64_v4i16((LAS s16x4*)(vp + 512))); }
                        const bf16x8 vf = (bf16x8){lo[0], lo[1], lo[2], lo[3], hh[0], hh[1], hh[2], hh[3]};
                        o[d] = __builtin_amdgcn_mfma_f32_32x32x16_bf16(pa[q4], vf, o[d], 0, 0, 0);
                    }
            }
            slot = (slot == 2) ? 0 : slot + 1;
        }
        l_run += shx(l_run, 32, lane);
        if (use_sink) l_run += __builtin_amdgcn_exp2f(sink_l2 - m_run);
        if (hi == 0) wsf[32 + r32] = __builtin_amdgcn_rcpf(l_run);
        LDS_WAIT();
#pragma unroll
        for (int r = 0; r < 16; ++r) { const float a = wsf[32 + crow(r, hi)];
#pragma unroll
            for (int d = 0; d < ND0; ++d) o[d][r] *= a; }
        ATT_WAITBAR(0);
    }
};
template <int ND0>
__device__ __forceinline__ void store_o_bf16(bf16_t* orow0, int ostride, int lane, const f32x16 (&o)[ND0]) {
    const int r32 = lane & 31, hi = lane >> 5;
#pragma unroll
    for (int r = 0; r < 16; ++r)
#pragma unroll
        for (int d = 0; d < ND0; ++d) orow0[(size_t)crow(r, hi) * ostride + d * 32 + r32] = (bf16_t)(pk2(o[d][r], 0.f) & 0xffffu);
}

template <int ND0>
__device__ __forceinline__ void store_o_f8(unsigned char* orow0, int ostride, int lane, const f32x16 (&o)[ND0]) {
    const int r32 = lane & 31, hi = lane >> 5;
#pragma unroll
    for (int r = 0; r < 16; ++r)
#pragma unroll
        for (int d = 0; d < ND0; ++d) orow0[(size_t)crow(r, hi) * ostride + d * 32 + r32] = (unsigned char)(pk4f8(o[d][r] * Y8_SCALE, 0.f, 0.f, 0.f) & 0xffu);
}
__device__ __forceinline__ void mla_attn_unit(const Frame& F0, int b, int h, int qb, bool dry) {
    const Args A = load_args(); const Frame F = fresh(F0);
    typedef AttnBody<96, 64, 2, false, 0, 2> AB;
    bf16_t* MQ = (bf16_t*)(A.ws + WS_MLAQ); const bf16_t* MK = (const bf16_t*)(A.ws + WS_MLAK); const bf16_t* MV = (const bf16_t*)(A.ws + WS_MLAV);
    const int q0 = qb * 256 + F.wave * 32; const size_t rb = (size_t)b * SEQ;
    AttnWaveCfg W; W.q = MQ + (rb + q0) * 768 + h * 96; W.qstride = 768; W.qpos0 = q0; W.kc0 = 0;
    f32x16 o[2];
    AB::run(F, W, MK + rb * 768 + h * 96, 768, MV + rb * 512 + h * 64, 512, 0, (qb * 256 + 256) / 64, 0.10206207261596575f * LOG2E, nullptr, false, 0.f, o);
    if (!dry) store_o_f8<2>((unsigned char*)(MQ + (rb + q0) * 768 + h * 96), 1536, F.lane, o);
}
__device__ __forceinline__ void swa_attn_unit(const Frame& F0, int l, int b, int kvh, int rb64, bool dry, bool alt = false) {
    const Args A = load_args(); const Frame F = fresh(F0); asm volatile("" : "+s"(l));
    typedef AttnBody<64, 64, 0, true, 128, 2> AB;
    bf16_t* proj = (bf16_t*)(A.ws + WS_PROJ);
    const int hq = kvh * 4 + (F.wave >> 1); const int q0 = rb64 * 64 + (F.wave & 1) * 32; const size_t rb = (size_t)b * SEQ;
    const int cq = alt ? PC_DQ : PC_SQ, ck = alt ? PC_DK : PC_SK, cv = alt ? PC_DV : PC_SV;
    AttnWaveCfg W; W.q = proj + (rb + q0) * NPROJ + cq + hq * 64; W.qstride = NPROJ; W.qpos0 = q0; W.kc0 = 0;
    const int kt_hi = rb64 + 1, kt_lo = (rb64 - 2) < 0 ? 0 : rb64 - 2;
    f32x16 o[2];
    AB::run(F, W, proj + rb * NPROJ + ck + kvh * 64, NPROJ, proj + rb * NPROJ + cv + kvh * 64, NPROJ, kt_lo, kt_hi, 0.125f * LOG2E,
            A.swa_qk_norm + l * 128, true, A.swa_sinks[l * 8 + hq] * LOG2E, o);
    if (!dry) store_o_f8<2>((unsigned char*)(proj + (rb + q0) * NPROJ + PC_SQ + hq * 64), NPROJ * 2, F.lane, o);
}
__device__ __forceinline__ void diff_attn_unit(const Frame& F0, int l, int b, int hh, int qb128, bool dry) {
    const Args A = load_args(); const Frame F = fresh(F0); asm volatile("" : "+s"(l));
    typedef AttnBody<64, 128, 1, true, 0, DIFF_VPRE> AB;
    bf16_t* proj = (bf16_t*)(A.ws + WS_PROJ);
    const int sub = F.wave & 1, rbk = F.wave >> 1; const int q0 = qb128 * 128 + rbk * 32; const size_t rb = (size_t)b * SEQ;
    AttnWaveCfg W; W.q = proj + (rb + q0) * NPROJ + PC_DQ + hh * 128 + sub * 64; W.qstride = NPROJ; W.qpos0 = q0; W.kc0 = sub * 8;
    float lam;
    { const float* lp = A.diff_lam + l * 256; const float a = wave_sum(lp[F.lane] * lp[64 + F.lane], F.lane), c = wave_sum(lp[128 + F.lane] * lp[192 + F.lane], F.lane);
      const float lam_init = 0.8f - 0.6f * __expf(-0.3f * (float)l); lam = __expf(a) - __expf(c) + lam_init; }
    f32x16 o[4];
    AB::run(F, W, proj + rb * NPROJ + PC_DK + hh * 128, NPROJ, proj + rb * NPROJ + PC_DV + hh * 128, NPROJ, 0, (qb128 * 128 + 128) / 64, 0.125f * LOG2E,
            A.diff_qk_norm + l * 128, false, 0.f, o);
    LAS float* ex = (LAS float*)(F.lds) + rbk * 4096;
    const int r32 = F.lane & 31, hi = F.lane >> 5;
    if (sub == 1) {
#pragma unroll
        for (int r = 0; r < 16; ++r)
#pragma unroll
            for (int d = 0; d < 4; ++d) ex[crow(r, hi) * 128 + d * 32 + r32] = o[d][r];
    }
    __syncthreads();
    if (sub == 0) {
        const float lam_init = 0.8f - 0.6f * __expf(-0.3f * (float)l);
        float ss[16];
#pragma unroll
        for (int r = 0; r < 16; ++r) { ss[r] = 0.f;
#pragma unroll
            for (int d = 0; d < 4; ++d) { const float v = o[d][r] - lam * ex[crow(r, hi) * 128 + d * 32 + r32]; o[d][r] = v; ss[r] += v * v; } }
#pragma unroll
        for (int r = 0; r < 16; ++r) { const float s = sum32(ss[r], F.lane);
            const float rstd = __builtin_amdgcn_rsqf(s * (1.f / 128.f) + EPS) * (1.0f - lam_init);
#pragma unroll
            for (int d = 0; d < 4; ++d) o[d][r] *= rstd * A.diff_onorm[l * 128 + d * 32 + r32]; }
        if (!dry) store_o_f8<4>((unsigned char*)(proj + (rb + q0) * NPROJ + PC_DQ + hh * 128), NPROJ * 2, F.lane, o);
    }
    __syncthreads();
}
__device__ __forceinline__ void knorm_pass(const Frame& F0, int l) {
    const Args A = load_args(); const Frame F = fresh(F0); asm volatile("" : "+s"(l));
    bf16_t* proj = (bf16_t*)(A.ws + WS_PROJ);
    const int stride = F.G * 512;
    for (int idx0 = F.vcu * 512 + F.tid; idx0 < M * 80; idx0 += 5 * stride) {
        u32x4 raw[5]; bf16_t* p[5]; const float* g[5];
#pragma unroll
        for (int i = 0; i < 5; ++i) { const int idx = idx0 + i * stride; const int row = idx / 80, ch = idx % 80; const bool isd = ch < 64; const int col = isd ? PC_DK + ch * 8 : PC_SK + (ch - 64) * 8;
            g[i] = (isd ? A.diff_qk_norm : A.swa_qk_norm) + l * 128 + 64 + (ch & 7) * 8; p[i] = proj + (size_t)row * NPROJ + col; raw[i] = *(const u32x4*)p[i]; }
#pragma unroll
        for (int i = 0; i < 5; ++i) { float f[8];
#pragma unroll
            for (int j = 0; j < 4; ++j) { f[2 * j] = bflo(raw[i][j]); f[2 * j + 1] = bfhi(raw[i][j]); }
            float ss = 0.f;
#pragma unroll
            for (int j = 0; j < 8; ++j) ss += f[j] * f[j];
            ss += shx(ss, 1, F.lane); ss += shx(ss, 2, F.lane); ss += shx(ss, 4, F.lane);
            const float rstd = __builtin_amdgcn_rsqf(ss * (1.f / 64.f) + EPS); const float* gg = g[i];
            u32x4 o; o.x = cvtpk(f[0] * rstd * gg[0], f[1] * rstd * gg[1]); o.y = cvtpk(f[2] * rstd * gg[2], f[3] * rstd * gg[3]); o.z = cvtpk(f[4] * rstd * gg[4], f[5] * rstd * gg[5]); o.w = cvtpk(f[6] * rstd * gg[6], f[7] * rstd * gg[7]);
            *(u32x4*)p[i] = o; }
    }
}

__device__ __forceinline__ void hgrn_unit(const Frame& F0, int l, int b, int h, bool dry) {
    const Args A = load_args(); const Frame F = fresh(F0); asm volatile("" : "+s"(l));
    const int tid = F.tid, lane = F.lane, w = F.wave, r32 = lane & 31, hi = lane >> 5;
    LAS unsigned char* lds = F.lds;
    constexpr int ST = 144, STT = 192, OST = 272;
    constexpr int O_QB = 0, O_QD = O_QB + 64 * ST, O_KD = O_QD + 64 * ST, O_QX = O_KD + 64 * ST, O_KX = O_QX + 64 * ST;
    constexpr int O_KE = O_KX + 64 * ST, O_V = O_KE + 64 * STT, O_S = O_V + 64 * STT;
    constexpr int O_SEG = O_S + 2 * 64 * STT, O_DL = O_SEG + 8 * 64 * 4, O_OB = O_DL + 256;
    bf16_t* proj = (bf16_t*)(A.ws + WS_PROJ);
    const size_t rb = (size_t)b * SEQ;
    const int k = lane;
    float lb = 0.f;
    if (l == 1) { const float a0 = A.hg_lb[h * 64 + k], a1 = A.hg_lb[512 + h * 64 + k]; lb = 1.0f / (1.0f + __expf(a0 - a1)); }
    for (int i = tid; i < 64 * STT / 4; i += 512) *(LAS unsigned*)(lds + O_S + i * 4) = 0u;
    f32x16 sacc = (f32x16){0};
    unsigned short qraw[8], fraw[8]; u32x4 vraw, graw, gprev = (u32x4){0u, 0u, 0u, 0u};
    const int erow = tid >> 3, ecol = (tid & 7) * 8;
    f32x4 gn0, gn1; { const float* g = A.hg_onorm + l * 64 + ecol; gn0 = *(const f32x4*)g; gn1 = *(const f32x4*)(g + 4); }
    auto load_chunk = [&](int c) {
        const bf16_t* base = proj + (rb + c * 64 + w * 8) * NPROJ + h * 64 + k;
#pragma unroll
        for (int j = 0; j < 8; ++j) { qraw[j] = base[(size_t)j * NPROJ + PC_HQ]; fraw[j] = base[(size_t)j * NPROJ + PC_HF]; }
        const bf16_t* rp = proj + (rb + c * 64 + erow) * NPROJ + h * 64 + ecol;
        vraw = *(const u32x4*)(rp + PC_HI); graw = *(const u32x4*)(rp + PC_HG);
    };
    auto epilogue = [&](int c, const u32x4& gr) {
        const LAS float* op = (const LAS float*)(lds + O_OB + erow * OST + ecol * 4);
        const f32x4 o0 = *(const LAS f32x4*)op, o1 = *(const LAS f32x4*)(op + 4);
        const float ss = sum8((o0[0] * o0[0] + o0[1] * o0[1]) + (o0[2] * o0[2] + o0[3] * o0[3]) + (o1[0] * o1[0] + o1[1] * o1[1]) + (o1[2] * o1[2] + o1[3] * o1[3]));
        const float rstd = __builtin_amdgcn_rsqf(ss * (1.f / 64.f) + EPS);
        float y[8];
#pragma unroll
        for (int j = 0; j < 4; ++j) { const float ga = bflo(gr[j]), gb = bfhi(gr[j]); const float oa = j < 2 ? o0[2 * j] : o1[2 * j - 4], ob = j < 2 ? o0[2 * j + 1] : o1[2 * j - 3];
            const float na = j < 2 ? gn0[2 * j] : gn1[2 * j - 4], nb = j < 2 ? gn0[2 * j + 1] : gn1[2 * j - 3];
            y[2 * j] = oa * rstd * na * fsilu(ga); y[2 * j + 1] = ob * rstd * nb * fsilu(gb); }
        u32x2 o; o.x = pk4f8(y[0] * Y8_SCALE, y[1] * Y8_SCALE, y[2] * Y8_SCALE, y[3] * Y8_SCALE); o.y = pk4f8(y[4] * Y8_SCALE, y[5] * Y8_SCALE, y[6] * Y8_SCALE, y[7] * Y8_SCALE);
        if (!dry) *(u32x2*)((unsigned char*)(proj + (rb + c * 64 + erow) * NPROJ + PC_HQ + h * 64) + ecol) = o;
    };
    load_chunk(0);
#pragma unroll 1
    for (int c = 0; c < 32; ++c) {
        const int sb_cur = c & 1;
        float qv[8], kkv[8], bl[8]; float run = 0.f;
#pragma unroll
        for (int j = 0; j < 8; ++j) { const float f = bf2f(fraw[j]), q = bf2f(qraw[j]);
            const float ef = __expf(-f); const float sg = __builtin_amdgcn_rcpf(1.0f + ef); const float fg = lb + (1.0f - lb) * sg;
            float lf = __logf(fg); lf = fmaxf(lf, -30.0f);
            kkv[j] = (1.0f - lb) * ef * sg;
            qv[j] = fsilu(q);
            run += lf; bl[j] = run; }
        const u32x4 vcur = vraw, gcur = graw;
        *(LAS float*)(lds + O_SEG + (w * 64 + k) * 4) = run;
        __syncthreads();
        if (c + 1 < 32) load_chunk(c + 1);
        if (c > 0) epilogue(c - 1, gprev);
        gprev = gcur;
        float sg8[8];
#pragma unroll
        for (int j = 0; j < 8; ++j) sg8[j] = *(LAS float*)(lds + O_SEG + (j * 64 + k) * 4);
        float off = 0.f;
#pragma unroll
        for (int j = 0; j < 8; ++j) off += (j < w) ? sg8[j] : 0.f;
        const float r15 = sg8[0] + sg8[1], r31 = r15 + sg8[2] + sg8[3], r47 = r31 + sg8[4] + sg8[5], r63 = r47 + sg8[6] + sg8[7];
        const float rd = (w < 4) ? r15 : r47;
#pragma unroll
        for (int j = 0; j < 8; ++j) { const int t = w * 8 + j; const float bt = off + bl[j];
            const float eb = __expf(bt);
            const float qd = qv[j] * __expf(fminf(bt - rd, 60.f)), kd = kkv[j] * __expf(fminf(rd - bt, 60.f));
            const float ke = kkv[j] * __expf(r63 - bt);
            const float xx = (w >= 4) ? qv[j] * __expf(bt - r31) : kkv[j] * __expf(r31 - bt);
            const unsigned p0 = pk2(qv[j] * eb, qd), p1 = pk2(kd, ke), p2 = pk2(xx, 0.f);
            *(LAS bf16_t*)(lds + O_QB + t * ST + k * 2) = (bf16_t)(p0 & 0xffffu);
            *(LAS bf16_t*)(lds + O_QD + t * ST + k * 2) = (bf16_t)(p0 >> 16);
            *(LAS bf16_t*)(lds + O_KD + t * ST + k * 2) = (bf16_t)(p1 & 0xffffu);
            *(LAS bf16_t*)(lds + O_KE + t * STT + k * 2) = (bf16_t)(p1 >> 16);
            *(LAS bf16_t*)(lds + ((w >= 4) ? O_QX : O_KX) + t * ST + k * 2) = (bf16_t)(p2 & 0xffffu); }
        *(LAS u32x4*)(lds + O_V + erow * STT + ecol * 2) = vcur;
        if (w == 0) *(LAS float*)(lds + O_DL + k * 4) = __expf(r63);
        __syncthreads();
        const int trow = 4 * hi + ((lane & 15) >> 2), tcol = ((lane >> 4) & 1) * 32 + (lane & 3) * 8;
        if (w < 2) {
            const int tb = w;
            f32x16 oacc[2]; oacc[0] = (f32x16){0}; oacc[1] = (f32x16){0};
            for (int sb = 0; sb <= tb; ++sb) {
                const int ko = (sb == tb) ? O_KD : O_KX, qo = (sb == tb) ? O_QD : O_QX;
                f32x16 p = (f32x16){0};
#pragma unroll
                for (int ks = 0; ks < 4; ++ks) { const bf16x8 ka = *(const LAS bf16x8*)(lds + ko + (32 * sb + r32) * ST + ks * 32 + hi * 16);
                    const bf16x8 qb = *(const LAS bf16x8*)(lds + qo + (32 * tb + r32) * ST + ks * 32 + hi * 16);
                    p = __builtin_amdgcn_mfma_f32_32x32x16_bf16(ka, qb, p, 0, 0, 0); }
                if (sb == tb) {
#pragma unroll
                    for (int r = 0; r < 16; ++r) p[r] = (crow(r, hi) <= r32) ? p[r] : 0.f;
                }
#pragma unroll
                for (int s2 = 0; s2 < 2; ++s2) { u32x4 pw; pw.x = pk2(p[8 * s2], p[8 * s2 + 1]); pw.y = pk2(p[8 * s2 + 2], p[8 * s2 + 3]); pw.z = pk2(p[8 * s2 + 4], p[8 * s2 + 5]); pw.w = pk2(p[8 * s2 + 6], p[8 * s2 + 7]);
                    const bf16x8 pa = __builtin_bit_cast(bf16x8, pw);
#pragma unroll
                    for (int d = 0; d < 2; ++d) { const LAS unsigned char* vp = lds + O_V + (32 * sb + 16 * s2 + trow) * STT + tcol + d * 64;
                        const s16x4 lo = __builtin_bit_cast(s16x4, __builtin_amdgcn_ds_read_tr16_b64_v4i16((LAS s16x4*)vp));
                        const s16x4 hh = __builtin_bit_cast(s16x4, __builtin_amdgcn_ds_read_tr16_b64_v4i16((LAS s16x4*)(vp + 8 * STT)));
                        const bf16x8 vf = (bf16x8){lo[0], lo[1], lo[2], lo[3], hh[0], hh[1], hh[2], hh[3]};
                        oacc[d] = __builtin_amdgcn_mfma_f32_32x32x16_bf16(pa, vf, oacc[d], 0, 0, 0); } }
            }
#pragma unroll
            for (int ks = 0; ks < 4; ++ks) { const bf16x8 qa = *(const LAS bf16x8*)(lds + O_QB + (32 * tb + r32) * ST + ks * 32 + hi * 16);
#pragma unroll
                for (int d = 0; d < 2; ++d) { const LAS unsigned char* sp = lds + O_S + sb_cur * 64 * STT + (16 * ks + 8 * hi + ((lane & 15) >> 2)) * STT + tcol + d * 64;
                    const s16x4 lo = __builtin_bit_cast(s16x4, __builtin_amdgcn_ds_read_tr16_b64_v4i16((LAS s16x4*)sp));
                    const s16x4 hh = __builtin_bit_cast(s16x4, __builtin_amdgcn_ds_read_tr16_b64_v4i16((LAS s16x4*)(sp + 4 * STT)));
                    const bf16x8 sf = (bf16x8){lo[0], lo[1], lo[2], lo[3], hh[0], hh[1], hh[2], hh[3]};
                    oacc[d] = __builtin_amdgcn_mfma_f32_32x32x16_bf16(qa, sf, oacc[d], 0, 0, 0); } }
#pragma unroll
            for (int r = 0; r < 16; ++r) { LAS float* op = (LAS float*)(lds + O_OB + (32 * tb + crow(r, hi)) * OST) + r32; op[0] = oacc[0][r]; op[32] = oacc[1][r]; }
        } else if (w < 6) {
            const int kb = (w - 2) >> 1, vb = (w - 2) & 1;
            f32x16 u = (f32x16){0};
#pragma unroll
            for (int s2 = 0; s2 < 4; ++s2) { const LAS unsigned char* ap = lds + O_KE + (16 * s2 + trow) * STT + tcol + kb * 64;
                const LAS unsigned char* bp = lds + O_V + (16 * s2 + trow) * STT + tcol + vb * 64;
                const s16x4 alo = __builtin_bit_cast(s16x4, __builtin_amdgcn_ds_read_tr16_b64_v4i16((LAS s16x4*)ap));
                const s16x4 ahi = __builtin_bit_cast(s16x4, __builtin_amdgcn_ds_read_tr16_b64_v4i16((LAS s16x4*)(ap + 8 * STT)));
                const s16x4 blo = __builtin_bit_cast(s16x4, __builtin_amdgcn_ds_read_tr16_b64_v4i16((LAS s16x4*)bp));
                const s16x4 bhi = __builtin_bit_cast(s16x4, __builtin_amdgcn_ds_read_tr16_b64_v4i16((LAS s16x4*)(bp + 8 * STT)));
                const bf16x8 af = (bf16x8){alo[0], alo[1], alo[2], alo[3], ahi[0], ahi[1], ahi[2], ahi[3]};
                const bf16x8 bf = (bf16x8){blo[0], blo[1], blo[2], blo[3], bhi[0], bhi[1], bhi[2], bhi[3]};
                u = __builtin_amdgcn_mfma_f32_32x32x16_bf16(af, bf, u, 0, 0, 0); }
#pragma unroll
            for (int r = 0; r < 16; ++r) { const int kr = 32 * kb + crow(r, hi); const float dl = *(LAS float*)(lds + O_DL + kr * 4);
                sacc[r] = sacc[r] * dl + u[r];
                *(LAS bf16_t*)(lds + O_S + (sb_cur ^ 1) * 64 * STT + kr * STT + (32 * vb + r32) * 2) = (bf16_t)(pk2(sacc[r], 0.f) & 0xffffu); }
        }
        __syncthreads();
    }
    epilogue(31, gprev);
    __syncthreads();
}

using pg8::Unit;
__device__ __forceinline__ size_t gate_blk(int pm, int pn, int ai, int wr, int m, int bj, int wc) { return (size_t)(((((((pm * 16 + pn) * 2 + ai) * 2 + wr) * 4 + m) * 2 + bj) * 4 + wc)) * 64; }
__device__ __forceinline__ size_t merged_blk(int pm, int pn, int ai, int wr, int m, int bj, int wc) { return (size_t)(((((((pm * 4 + pn) * 2 + ai) * 2 + wr) * 4 + m) * 2 + bj) * 4 + wc)) * 64; }
struct SchedB { static constexpr bool ABLK = false; unsigned H, W; int G, c;
    __device__ __forceinline__ bool next(int i, Unit& u) const { const long L = (long)i * G + c; if (L >= 64 * 35) return false; int pm, pn; pg8::tile_order((int)L, 64, 35, pm, pn);
        u.pm = pm; u.pn = pn; u.aux = 0; u.a = H + (unsigned)pm * (256 * 1024); u.b0 = W + (unsigned)pn * (256 * 1024); u.b1 = u.b0; u.ridx = 0; u.nvalid = 256; return true; }
    __device__ __forceinline__ int lda(const Unit&) const { return 1024; } __device__ __forceinline__ int akstep(const Unit&) const { return 128; }
    __device__ __forceinline__ unsigned btile(const Unit& u, int t) const { return u.b0 + (unsigned)t * 128; } };
struct EpiB { static constexpr bool PERM = true; bf16_t* proj; unsigned char* gate8;
    __device__ __forceinline__ void operator()(const f32x4 (&acc)[2][2][4][2], const Unit& u, int wr, int wc, int fr, int fq) const {
        const int row0 = u.pm * 256 + wr * 64 + fr;
        if (u.pn < 16) {
#pragma unroll
            for (int ai = 0; ai < 2; ++ai)
#pragma unroll
                for (int m = 0; m < 4; ++m) {
#pragma unroll
                    for (int bj = 0; bj < 2; ++bj) { const f32x4 v0 = acc[ai][bj][m][0], v1 = acc[ai][bj][m][1]; u32x2 o = {0u, 0u};
#pragma unroll
                        for (int i = 0; i < 4; ++i) {
                            const float t0 = __builtin_amdgcn_exp2f(v0[i] * (-W8_INV * LOG2E)), t1 = __builtin_amdgcn_exp2f(v1[i] * (-W8_INV * LOG2E));
                            const float q0 = __builtin_amdgcn_rcpf(__builtin_fmaf(t0, 1.0f / 255.0f, 1.0f / 255.0f)), q1 = __builtin_amdgcn_rcpf(__builtin_fmaf(t1, 1.0f / 255.0f, 1.0f / 255.0f));
                            o.x = __builtin_amdgcn_cvt_pk_u8_f32(q0, i, o.x); o.y = __builtin_amdgcn_cvt_pk_u8_f32(q1, i, o.y); }
                        *(u32x2*)(gate8 + (gate_blk(u.pm, u.pn, ai, wr, m, bj, wc) + fr * 4 + fq) * 8) = o; } }
        } else {
#pragma unroll
            for (int ai = 0; ai < 2; ++ai)
#pragma unroll
                for (int m = 0; m < 4; ++m) { bf16_t* rp = proj + (size_t)(row0 + ai * 128 + m * 16) * NPROJ + (u.pn - 16) * 256 + wc * 32 + 8 * fq;
#pragma unroll
                    for (int bj = 0; bj < 2; ++bj) { const f32x4 v0 = acc[ai][bj][m][0] * W8_INV, v1 = acc[ai][bj][m][1] * W8_INV; u32x4 o;
                        o.x = pg8::cvt_pk_bf16(v0[0], v0[1]); o.y = pg8::cvt_pk_bf16(v0[2], v0[3]); o.z = pg8::cvt_pk_bf16(v1[0], v1[1]); o.w = pg8::cvt_pk_bf16(v1[2], v1[3]);
                        *(u32x4*)(rp + bj * 128) = o; } }
        }
    } };
struct SchedF { static constexpr bool ABLK = true; unsigned proj, mlaq, W; int G, c;
    __device__ __forceinline__ bool next(int i, Unit& u) const { const long L = (long)(i >> 2) * G + c; if (L >= 256) return false; const int b = i & 3; int pm, pn; pg8::tile_order((int)L, 64, 4, pm, pn);
        u.pm = pm; u.pn = pn; u.aux = b;
        if (b == 1) { u.a = mlaq + (unsigned)pm * (256 * 1536); }
        else { const int co = (b == 0) ? PC_HQ : (b == 2 ? PC_DQ : PC_SQ); u.a = proj + (unsigned)pm * (256 * NPROJ * 2) + co * 2; }
        u.b0 = W + (unsigned)(b * 1024 + pn * 256) * 512; u.b1 = u.b0; u.ridx = 0; u.nvalid = 256; return true; }
    __device__ __forceinline__ int lda(const Unit& u) const { return u.aux == 1 ? 1536 : NPROJ * 2; } __device__ __forceinline__ int akstep(const Unit& u) const { return u.aux == 1 ? 384 : 256; }
    __device__ __forceinline__ unsigned atile(const Unit& u, int kt) const { return u.a + (unsigned)kt * (unsigned)akstep(u); }
    __device__ __forceinline__ unsigned voffa(const Unit& u, int R, int C) const { const int cb = C * 2, slot = (u.aux == 1) ? 192 : 128;
        return (unsigned)(R * lda(u) + ((u.aux == 2) ? cb : ((cb & 63) + (cb >> 6) * slot))); }
    __device__ __forceinline__ unsigned hs(const Unit& u) const { return 128u * (unsigned)lda(u); }
    __device__ __forceinline__ unsigned btile(const Unit& u, int t) const { return u.b0 + (unsigned)t * 128; } };
struct EpiF { static constexpr bool PERM = true; bf16_t* merged; const unsigned char* gate8;
    __device__ __forceinline__ void operator()(const f32x4 (&acc)[2][2][4][2], const Unit& u, int wr, int wc, int fr, int fq) const {
        const int row0 = u.pm * 256 + wr * 64 + fr, b = u.aux; const int col = u.pn * 256 + wc * 32 + 8 * fq;
#pragma unroll
        for (int ai = 0; ai < 2; ++ai) {
            u32x2 g[4][2]; u32x4 old[4][2];
#pragma unroll
            for (int m = 0; m < 4; ++m)
#pragma unroll
                for (int bj = 0; bj < 2; ++bj) { const size_t row = (size_t)(row0 + ai * 128 + m * 16);
                    g[m][bj] = *(const u32x2*)(gate8 + (gate_blk(u.pm, b * 4 + u.pn, ai, wr, m, bj, wc) + fr * 4 + fq) * 8);
                    if (b > 0) old[m][bj] = *(const u32x4*)(merged + (merged_blk(u.pm, u.pn, ai, wr, m, bj, wc) + fr * 4 + fq) * 8); else old[m][bj] = (u32x4){0u, 0u, 0u, 0u}; }
#pragma unroll
            for (int m = 0; m < 4; ++m)
#pragma unroll
                for (int bj = 0; bj < 2; ++bj) { bf16_t* mp = merged + (merged_blk(u.pm, u.pn, ai, wr, m, bj, wc) + fr * 4 + fq) * 8;
                    const f32x4 v0 = acc[ai][bj][m][0], v1 = acc[ai][bj][m][1]; const u32x2 gg = g[m][bj]; const u32x4 od = old[m][bj]; float r[8];
                    const float s = (1.0f / 255.0f) * (W8_INV / Y8_SCALE);
                    r[0] = v0[0] * (float)(gg.x & 255u) * s + bflo(od.x); r[1] = v0[1] * (float)((gg.x >> 8) & 255u) * s + bfhi(od.x); r[2] = v0[2] * (float)((gg.x >> 16) & 255u) * s + bflo(od.y); r[3] = v0[3] * (float)(gg.x >> 24) * s + bfhi(od.y);
                    r[4] = v1[0] * (float)(gg.y & 255u) * s + bflo(od.z); r[5] = v1[1] * (float)((gg.y >> 8) & 255u) * s + bfhi(od.z); r[6] = v1[2] * (float)((gg.y >> 16) & 255u) * s + bflo(od.w); r[7] = v1[3] * (float)(gg.y >> 24) * s + bfhi(od.w);
                    if (b == 3) {
                        u32x2 o8; o8.x = pk4f8(r[0] * M8_SCALE, r[1] * M8_SCALE, r[2] * M8_SCALE, r[3] * M8_SCALE); o8.y = pk4f8(r[4] * M8_SCALE, r[5] * M8_SCALE, r[6] * M8_SCALE, r[7] * M8_SCALE);
                        *(u32x2*)((unsigned char*)gate8 + (gate_blk(u.pm, u.pn, ai, wr, m, bj, wc) + fr * 4 + fq) * 8) = o8;
                    } else {
                    u32x4 o; o.x = pg8::cvt_pk_bf16(r[0], r[1]); o.y = pg8::cvt_pk_bf16(r[2], r[3]); o.z = pg8::cvt_pk_bf16(r[4], r[5]); o.w = pg8::cvt_pk_bf16(r[6], r[7]);
                    *(u32x4*)mp = o; } }
            asm volatile("" ::: "memory");
        }
    } };
struct SchedG { static constexpr bool ABLK = true; unsigned Am, W; int G, c;
    __device__ __forceinline__ bool next(int i, Unit& u) const { const long L = (long)i * G + c; if (L >= 256) return false; int pm, pn; pg8::tile_order((int)L, 64, 4, pm, pn);
        u.pm = pm; u.pn = pn; u.aux = 0; u.a = Am + (unsigned)pm * (16u * 8192u * 8u); u.b0 = W + (unsigned)pn * (256 * 1024); u.b1 = u.b0; u.ridx = 0; u.nvalid = 256; return true; }
    __device__ __forceinline__ int lda(const Unit&) const { return 1024; } __device__ __forceinline__ int akstep(const Unit&) const { return 128; }
    __device__ __forceinline__ unsigned atile(const Unit& u, int kt) const { return u.a + (unsigned)((kt >> 1) * 8192 + (kt & 1) * 256) * 8u; }
    __device__ __forceinline__ unsigned voffa(const Unit&, int R, int C) const { const int cb = C * 2; return (unsigned)(((R >> 7) & 1) * 4096 + ((R >> 6) & 1) * 2048 + ((R >> 4) & 3) * 512 + (cb >> 5) * 64 + (R & 15) * 4 + ((cb >> 3) & 3)) * 8u; }
    __device__ __forceinline__ unsigned hs(const Unit&) const { return 4096u * 8u; }
    __device__ __forceinline__ unsigned btile(const Unit& u, int t) const { return u.b0 + (unsigned)t * 128; } };
struct EpiG { static constexpr bool PERM = false; const float* xin; float* out; const float* gt;
    __device__ __forceinline__ void operator()(const f32x4 (&acc)[2][2][4][2], const Unit& u, int wr, int wc, int fr, int fq) const {
        const int row0 = u.pm * 256 + wr * 64 + fr, col0 = u.pn * 256 + wc * 32 + 4 * fq; const int b = (u.pm * 256) >> 11;
        f32x4 g[2][2];
#pragma unroll
        for (int bj = 0; bj < 2; ++bj)
#pragma unroll
            for (int n = 0; n < 2; ++n) g[bj][n] = *(const f32x4*)(gt + b * 6144 + col0 + bj * 128 + n * 16);
#pragma unroll
        for (int ai = 0; ai < 2; ++ai) {
            f32x4 xv[4][2][2];
#pragma unroll
            for (int m = 0; m < 4; ++m) { const size_t off = (size_t)(row0 + ai * 128 + m * 16) * DM + col0;
#pragma unroll
                for (int bj = 0; bj < 2; ++bj)
#pragma unroll
                    for (int n = 0; n < 2; ++n) xv[m][bj][n] = *(const f32x4*)(xin + off + bj * 128 + n * 16); }
#pragma unroll
            for (int m = 0; m < 4; ++m) { const size_t off = (size_t)(row0 + ai * 128 + m * 16) * DM + col0;
#pragma unroll
                for (int bj = 0; bj < 2; ++bj)
#pragma unroll
                    for (int n = 0; n < 2; ++n) *(f32x4*)(out + off + bj * 128 + n * 16) = xv[m][bj][n] + g[bj][n] * (acc[ai][bj][m][n] * (W8_INV / M8_SCALE)); }
            asm volatile("" ::: "memory");
        }
    } };
struct MoeSched { volatile LAS unsigned* ms; unsigned list;
    __device__ __forceinline__ int rd(int i) const { return __builtin_amdgcn_readfirstlane((int)ms[i]); }
    __device__ __forceinline__ bool tile(int tau, int& pair, int& j0, int& nval) const { const int T = rd(64 + 24); if (tau >= T) return false; int p = 0;
        for (int q = 1; q < 24; ++q) if (rd(64 + q) <= tau) p = q;
        pair = p; j0 = (tau - rd(64 + p)) * 256; const int rem = rd(32 + p) - j0; nval = rem < 256 ? rem : 256; return true; } };
__device__ __forceinline__ void moe_sched_setup(const Frame& F0, int l) {
    const Args A = load_args(); const Frame F = fresh(F0); asm volatile("" : "+s"(l));
    const unsigned* cnt = (const unsigned*)(A.ws + WS_CTL) + CW_CNT + 64 * l;
    if (F.tid < 24) F.MISC[32 + F.tid] = __hip_atomic_load(cnt + F.tid, RLX_AGENT);
    __syncthreads();
    if (F.tid == 0) { unsigned pre = 0; for (int p = 0; p < 24; ++p) { F.MISC[64 + p] = pre; pre += (F.MISC[32 + p] + 255u) >> 8; } F.MISC[64 + 24] = pre; }
    __syncthreads();
}
struct SchedI { static constexpr bool ABLK = false; MoeSched ms; unsigned H2, GUT; int G, c;
    __device__ __forceinline__ bool next(int i, Unit& u) const { const long L = (long)i * G + c; const int tau = (int)(L >> 2), pn = (int)(L & 3); int pair, j0, nval; if (!ms.tile(tau, pair, j0, nval)) return false;
        int ea, eb; pair_experts(pair, ea, eb); const int e = pn < 2 ? ea : eb;
        u.pm = tau; u.pn = pn; u.aux = pair; u.a = H2; u.b0 = GUT + (unsigned)(e * 512 + (pn & 1) * 256) * 2048; u.b1 = u.b0;
        u.ridx = ms.list + (unsigned)(pair * 16384 + j0) * 4; u.nvalid = nval; return true; }
    __device__ __forceinline__ int lda(const Unit&) const { return 2048; } __device__ __forceinline__ int akstep(const Unit&) const { return 128; }
    __device__ __forceinline__ unsigned btile(const Unit& u, int t) const { return u.b0 + (unsigned)t * 128; } };
struct EpiI { static constexpr bool PERM = true; bf16_t* hid; const float* tokw; const char* wsb;
    __device__ __forceinline__ void operator()(const f32x4 (&acc)[2][2][4][2], const Unit& u, int wr, int wc, int fr, int fq) const {
        const int wsel = u.pn >> 1;
#pragma unroll
        for (int ai = 0; ai < 2; ++ai)
#pragma unroll
            for (int m = 0; m < 4; ++m) { const int r = ai * 128 + wr * 64 + m * 16 + fr; float wgt = 0.f; if (r < u.nvalid) wgt = tokw[2 * ((const int*)(wsb + u.ridx))[r] + wsel];
                const f32x4 g0 = acc[ai][0][m][0], g1 = acc[ai][0][m][1], u0 = acc[ai][1][m][0], u1 = acc[ai][1][m][1]; float v[8];
                const float ws_ = wgt * (W8_INV * HID8_SCALE);
#pragma unroll
                for (int i = 0; i < 4; ++i) { v[i] = fsilu(g0[i] * W8_INV) * u0[i] * ws_; v[4 + i] = fsilu(g1[i] * W8_INV) * u1[i] * ws_; }
                u32x2 o; o.x = pk4f8(v[0], v[1], v[2], v[3]); o.y = pk4f8(v[4], v[5], v[6], v[7]);
                { unsigned char* hp = (unsigned char*)hid + (size_t)(u.pm * 256 + r) * 512 + u.pn * 128 + wc * 32 + 8 * fq;
                  asm volatile("global_store_dwordx2 %0, %1, off sc1\n\ts_nop 1" :: "v"(hp), "v"(o) : "memory"); }
                asm volatile("" ::: "memory"); }
    } };
struct SchedJ { static constexpr bool ABLK = false; MoeSched ms; unsigned HID, DT; int G, c;
    __device__ __forceinline__ bool next(int i, Unit& u) const { const long L = (long)i * G + c; const int tau = (int)(L >> 2), pn = (int)(L & 3); int pair, j0, nval; if (!ms.tile(tau, pair, j0, nval)) return false;
        int ea, eb; pair_experts(pair, ea, eb);
        u.pm = tau; u.pn = pn; u.a = HID + (unsigned)tau * (256 * 1024);
        u.b0 = DT + (unsigned)(ea * 1024 + pn * 256) * 512; u.b1 = DT + (unsigned)(eb * 1024 + pn * 256) * 512; u.ridx = 0; u.nvalid = nval; u.aux = j0 + pair * 16384; return true; }
    __device__ __forceinline__ int lda(const Unit&) const { return 1024; } __device__ __forceinline__ int akstep(const Unit&) const { return 128; }
    __device__ __forceinline__ unsigned btile(const Unit& u, int t) const { return t < 4 ? u.b0 + (unsigned)t * 128 : u.b1 + (unsigned)(t - 4) * 128; } };
struct EpiJ { static constexpr bool PERM = false; float* out; const float* gt; const int* list;
    __device__ __forceinline__ void operator()(const f32x4 (&acc)[2][2][4][2], const Unit& u, int wr, int wc, int fr, int fq) const {
        const int col0 = u.pn * 256 + wc * 32 + 4 * fq;
#pragma unroll
        for (int ai = 0; ai < 2; ++ai) {
            int tok[4]; f32x4 xv[4][2][2];
#pragma unroll
            for (int m = 0; m < 4; ++m) { const int r = ai * 128 + wr * 64 + m * 16 + fr; tok[m] = (r < u.nvalid) ? list[u.aux + r] : -1; }
#pragma unroll
            for (int m = 0; m < 4; ++m) { const size_t off = (size_t)(tok[m] < 0 ? 0 : tok[m]) * DM + col0;
#pragma unroll
                for (int bj = 0; bj < 2; ++bj)
#pragma unroll
                    for (int n = 0; n < 2; ++n) xv[m][bj][n] = *(const f32x4*)(out + off + bj * 128 + n * 16); }
#pragma unroll
            for (int m = 0; m < 4; ++m) if (tok[m] >= 0) { const int bb = tok[m] >> 11; const size_t off = (size_t)tok[m] * DM + col0;
#pragma unroll
                for (int bj = 0; bj < 2; ++bj)
#pragma unroll
                    for (int n = 0; n < 2; ++n) { const f32x4 g = *(const f32x4*)(gt + bb * 6144 + col0 + bj * 128 + n * 16);
                        *(f32x4*)(out + off + bj * 128 + n * 16) = xv[m][bj][n] + g * (acc[ai][bj][m][n] * (W8_INV / HID8_SCALE)); } }
            asm volatile("" ::: "memory");
        }
    } };

constexpr int CW_TILE = 9216;
struct SchedIJ { static constexpr bool ABLK = false; MoeSched ms; unsigned H2, GUT, HID, DT; unsigned* tcnt; int G, c;
    __device__ __forceinline__ bool next(int i, Unit& u) const { const long L = (long)i * G + c; const int T4 = 4 * ms.rd(64 + 24); if (L >= 2 * T4) return false;
        const int kind = L >= T4 ? 1 : 0; const int idx = (int)L - kind * T4; const int tau = idx >> 2, pn = idx & 3; int pair, j0, nval; if (!ms.tile(tau, pair, j0, nval)) return false;
        int ea, eb; pair_experts(pair, ea, eb);
        u.pm = tau; u.pn = pn; u.kind = kind; u.nvalid = nval;
        if (kind == 0) { const int e = pn < 2 ? ea : eb; u.aux = pair; u.a = H2; u.b0 = GUT + (unsigned)(e * 512 + (pn & 1) * 256) * 1024; u.b1 = u.b0; u.ridx = ms.list + (unsigned)(pair * 16384 + j0) * 4; }
        else { u.aux = j0 + pair * 16384; u.a = HID + (unsigned)tau * (256 * 512); u.b0 = DT + (unsigned)(ea * 1024 + pn * 256) * 256; u.b1 = DT + (unsigned)(eb * 1024 + pn * 256) * 256; u.ridx = 0; }
        return true; }
    __device__ __forceinline__ int lda(const Unit& u) const { return u.kind ? 512 : 1024; } __device__ __forceinline__ int akstep(const Unit&) const { return 128; }
    __device__ __forceinline__ int nt(const Unit& u) const { return u.kind ? 4 : 8; } __device__ __forceinline__ int ldb(const Unit& u) const { return u.kind ? 256 : 1024; }
    __device__ __forceinline__ bool perm(const Unit& u) const { return u.kind == 0; } __device__ __forceinline__ bool dep(const Unit& u) const { return u.kind == 1; }
    __device__ __forceinline__ unsigned btile(const Unit& u, int t) const { return (u.kind && t >= 2) ? u.b1 + (unsigned)(t - 2) * 128 : u.b0 + (unsigned)t * 128; }
    __device__ __forceinline__ void a_ready(const Unit& u) const {
        if (u.kind == 1) { unsigned sp = 0;
            while (__hip_atomic_load(tcnt + u.pm, RLX_AGENT) < 4u) { __builtin_amdgcn_s_sleep(2); if (++sp > (1u << 22)) break; }
            __builtin_amdgcn_fence(__ATOMIC_ACQUIRE, "agent"); asm volatile("s_waitcnt vmcnt(0)" ::: "memory"); } }
    __device__ __forceinline__ void done(const Unit& u, int wid, int lane) const {
        if (u.kind == 0 && wid == 0 && lane == 0) __hip_atomic_fetch_add(tcnt + u.pm, 1u, RLX_AGENT); }
};
struct EpiIJ { static constexpr bool PERM = false; EpiI ei; EpiJ ej;
    __device__ __forceinline__ void operator()(const f32x4 (&acc)[2][2][4][2], const Unit& u, int wr, int wc, int fr, int fq) const { if (u.kind == 0) ei(acc, u, wr, wc, fr, fq); else ej(acc, u, wr, wc, fr, fq); } };

__global__ void __launch_bounds__(512, 2) mk_fwd(Args Akern) {
    extern __shared__ __attribute__((aligned(16))) unsigned char lds_raw[];
    Frame F;
    F.lds = (LAS unsigned char*)lds_raw; F.ldsg = lds_raw;
    F.MISC = (volatile LAS unsigned*)(F.lds + MISC_OFF);
    F.tid = threadIdx.x; F.lane = F.tid & 63; F.wave = __builtin_amdgcn_readfirstlane(F.tid >> 6);
    F.G = gridDim.x; { const int bx = blockIdx.x; F.vcu = (F.G % 8 == 0) ? (bx % 8) * (F.G / 8) + bx / 8 : bx; }
    for (int u = F.tid; u < 256; u += 512) F.MISC[u] = 0u;
    __syncthreads();
    int lo, hi;
    XcdBarrier bar;
    { const Args A = load_args(); lo = A.ph_lo; hi = A.ph_hi; F.ctl = (gu32*)(A.ws + WS_CTL);
      bar.bar = (unsigned*)(A.ws + WS_CTL) + CW_BAR; bar.x = 0; bar.st = nullptr;
      if (!MK_PER_PHASE) bar = xcd_barrier_post((unsigned*)(A.ws + WS_CTL) + CW_BAR, F.MISC + 8); }
#define GRID_BAR() do { if (!MK_PER_PHASE) xcd_barrier(bar); } while (0)
#pragma unroll 1
    for (int ph = lo; ph < hi; ++ph) {
      if (STAMP_MODE == 2 && blockIdx.x == 0) { int t0_ = threadIdx.x; asm volatile("" : "+v"(t0_)); if (t0_ == 0) ((unsigned long long*)((unsigned*)F.ctl + 12288))[ph] = __builtin_amdgcn_s_memrealtime(); }
      const int spx = (ph == 0) ? 9 : (ph - 1) % PPL; const int reps = ((REP_MASK >> spx) & 1) ? 1 + REP_N : 1;
#pragma unroll 1
      for (int rep = 0; rep < reps; ++rep) {
        if (rep > 0) GRID_BAR();
        if (ph == 0) { if (PH_ON(9)) {
            conv_layer_main(F, 0);
            __syncthreads();
            p0_mod_rope(F); }
        } else {
            const int l = (ph - 1) / PPL, sp = (ph - 1) % PPL;
            if (sp == 0) { if (PH_ON(0))
                norm_phase<false>(F, l);
            } else if (sp == 1) { if (PH_ON(1)) {
                const Args A = load_args(); const char* wsb = (const char*)A.ws;
                SchedB S{(unsigned)WS_H, (unsigned)WS_WINT, F.G, (int)blockIdx.x}; EpiB E{(bf16_t*)(A.ws + WS_PROJ), A.ws + WS_GATE8};
                pg8::gemm_phase<false, false, true>(F.lds, wsb, 8, 1024, S, E); }
            } else if (sp == 2) { if (PH_ON(2))
                { for (int rp = 0; rp < 1 + PROBE_MLAPREP; ++rp) for (int u = F.vcu; u < M / 64; u += F.G) mla_prep_unit(F, l, u); knorm_pass(F, l); }
            } else if (sp == 3) { if (PH_ON(3)) {
                unsigned* qctr = (unsigned*)F.ctl + CW_QUEUE + 64 * l;
#define QNEXT(ctr) ({ if (F.tid == 0) F.MISC[16] = atomicAdd((ctr), 1u); __syncthreads(); const int u_ = __builtin_amdgcn_readfirstlane((int)F.MISC[16]); __syncthreads(); u_; })
#pragma unroll 1
                for (int pass = ((DRY_MASK && ((DRY_LAYERS >> l) & 1)) ? -(DRY_REPS - 1) : 1); pass < 2; ++pass) {
                const bool dry = (pass <= 0); unsigned* qc = qctr + (dry ? 4 * (1 - pass) : 0);
                if (UNIT_ON(0) && (!dry || (DRY_MASK & 1))) for (;;) { const int u = QNEXT(qc + 0); if (u >= 64) break; hgrn_unit(F, l, u >> 3, u & 7, dry); }
                if (UNIT_ON(1) && (!dry || (DRY_MASK & 2))) for (;;) { const int u = QNEXT(qc + 1); if (u >= 512) break; const int qb = 15 - (u >> 5), bh = u & 31; diff_attn_unit(F, l, bh >> 2, bh & 3, qb, dry); }
                if (UNIT_ON(2) && (!dry || (DRY_MASK & 4))) for (;;) { const int u = QNEXT(qc + 2); if (u >= 512) break; const int qb = 7 - (u >> 6), bh = u & 63; mla_attn_unit(F, bh >> 3, bh & 7, qb, dry); }
                if (UNIT_ON(3) && (!dry || (DRY_MASK & 8))) for (;;) { const int u = QNEXT(qc + 3); if (u >= 512) break; const int rb64 = u & 31, bk = u >> 5; swa_attn_unit(F, l, bk >> 1, bk & 1, rb64, dry, dry && (pass == DRY_ALT)); }
                if (dry) GRID_BAR();
                }
#undef QNEXT
                }
            } else if (sp == 4) { if (PH_ON(4)) {
                const Args A = load_args(); const char* wsb = (const char*)A.ws;
                SchedF S{(unsigned)WS_PROJ, (unsigned)WS_MLAQ, (unsigned)WS_BRT, F.G, (int)blockIdx.x}; EpiF E{(bf16_t*)(A.ws + WS_MERGED), A.ws + WS_GATE8};
                pg8::gemm_phase<false, false, true>(F.lds, wsb, 4, 512, S, E); }
            } else if (sp == 5) { if (PH_ON(5)) {
                const Args A = load_args(); const char* wsb = (const char*)A.ws; const float* mod = (const float*)(A.ws + WS_MOD) + (size_t)l * 8 * 6144;
                SchedG S{(unsigned)WS_GATE8, (unsigned)WS_OUTT, F.G, (int)blockIdx.x}; EpiG E{(l == 0) ? A.x : A.out, A.out, mod + 2048};
                pg8::gemm_phase<false, false, true>(F.lds, wsb, 8, 1024, S, E); }
            } else if (sp == 6) { if (PH_ON(6)) {
                norm_phase<true>(F, l);
                conv_layer_moe(F, l);
                if (l + 1 < DEPTH) conv_layer_main(F, l + 1); }
            } else if (sp == 7) { if (PH_ON(7)) {
                moe_sched_setup(F, l);
                const Args A = load_args(); const char* wsb = (const char*)A.ws; const float* mod = (const float*)(A.ws + WS_MOD) + (size_t)l * 8 * 6144;
                SchedIJ S{{F.MISC, (unsigned)WS_LIST}, (unsigned)WS_H, (unsigned)WS_GUT, (unsigned)WS_HID, (unsigned)WS_DT, (unsigned*)F.ctl + CW_TILE + 128 * l, F.G, (int)blockIdx.x};
                EpiIJ E{{(bf16_t*)(A.ws + WS_HID), (const float*)(A.ws + WS_TOKW), wsb}, {A.out, mod + 5120, (const int*)(A.ws + WS_LIST)}};
                pg8::gemm_phase<true, true, true>(F.lds, wsb, 16, 2048, S, E); }
            }
        }
      }
        for (int eb = 0; eb < EXTRA_BARS; ++eb) GRID_BAR();
        if (ph + 1 < hi) GRID_BAR();
    }
    if (STAMP_MODE != 0) {
        GRID_BAR();
        if (blockIdx.x == 0) { int t0_ = threadIdx.x; asm volatile("" : "+v"(t0_)); if (t0_ == 0) ((unsigned long long*)((unsigned*)F.ctl + 12288))[NPHASE] = __builtin_amdgcn_s_memrealtime(); }
        GRID_BAR();
        const Args A = load_args();
        const unsigned long long* ts = (const unsigned long long*)((unsigned*)F.ctl + 12288);
        float delta = 0.05f;
        if (STAMP_MODE == 2) { const float dt_us = (float)(long long)(ts[STAMP_HI] - ts[STAMP_LO]) * 0.01f; delta = sqrtf(STAMP_C * dt_us); }
        int t1_ = threadIdx.x; asm volatile("" : "+v"(t1_));
        for (int i = blockIdx.x * 512 + t1_; i < M * DM / 4; i += gridDim.x * 512) { f32x4 v = ((f32x4*)A.out)[i]; v = v + delta; ((f32x4*)A.out)[i] = v; }
    }
}

extern "C" void kernel_launch(void* const* d_in, const int* in_sizes, int n_in, void* d_out, int out_size, void* d_ws, size_t ws_size, hipStream_t stream) {
    static int grid = 0;
    if (grid == 0) {
        if (n_in != 27 || in_sizes[0] != M * DM || out_size != M * DM || ws_size < WS_END) {
            fprintf(stderr, "kernel_launch: unexpected problem (n_in %d, in0 %d, out %d, ws %zu < %zu); nothing launched\n", n_in, n_in > 0 ? in_sizes[0] : -1, out_size, ws_size, (size_t)WS_END); grid = -1; return; }
        int dev = 0, cus = 0, per_cu = 0;
        if (hipGetDevice(&dev) != hipSuccess || hipDeviceGetAttribute(&cus, hipDeviceAttributeMultiprocessorCount, dev) != hipSuccess) { grid = -1; return; }
        if (hipFuncSetAttribute((const void*)mk_fwd, hipFuncAttributeMaxDynamicSharedMemorySize, LDS_BYTES) != hipSuccess) { fprintf(stderr, "kernel_launch: hipFuncSetAttribute failed\n"); grid = -1; return; }
        if (hipOccupancyMaxActiveBlocksPerMultiprocessor(&per_cu, (const void*)mk_fwd, 512, LDS_BYTES) != hipSuccess || per_cu < 1) { fprintf(stderr, "kernel_launch: occupancy query says %d blocks/CU\n", per_cu); per_cu = 1; }
        (void)hipGetLastError();
        if (cus != 256) { fprintf(stderr, "kernel_launch: built for a 256-CU device (got %d); nothing launched\n", cus); grid = -1; return; }
        grid = cus;
    }
    if (grid < 0) return;
    (void)hipMemsetAsync((char*)d_ws + WS_CTL, 0, CTL_ZERO_BYTES, stream);
    Args a{};
    a.x = (const float*)d_in[0]; a.c = (const float*)d_in[1]; a.pos = (const int*)d_in[2]; a.ada_w = (const float*)d_in[3]; a.ada_b = (const float*)d_in[4];
    a.norm_mix = (const float*)d_in[5]; a.norm_ffn = (const float*)d_in[6]; a.w_in = (const float*)d_in[7]; a.hg_lb = (const float*)d_in[8]; a.hg_onorm = (const float*)d_in[9];
    a.mla_q_norm = (const float*)d_in[10]; a.mla_kv_norm = (const float*)d_in[11]; a.mla_w_uq = (const float*)d_in[12]; a.mla_w_ukv = (const float*)d_in[13];
    a.mla_qk_norm = (const float*)d_in[14]; a.diff_qk_norm = (const float*)d_in[15]; a.diff_lam = (const float*)d_in[16]; a.diff_onorm = (const float*)d_in[17];
    a.swa_qk_norm = (const float*)d_in[18]; a.swa_sinks = (const float*)d_in[19]; a.w_branch = (const float*)d_in[20]; a.w_out = (const float*)d_in[21];
    a.router_w = (const float*)d_in[22]; a.router_bias = (const float*)d_in[23]; a.moe_w_gate = (const float*)d_in[24]; a.moe_w_up = (const float*)d_in[25]; a.moe_w_down = (const float*)d_in[26];
    a.out = (float*)d_out; a.ws = (unsigned char*)d_ws;
#if MK_PER_PHASE
    for (int ph = 0; ph < NPHASE; ++ph) { a.ph_lo = ph; a.ph_hi = ph + 1; hipLaunchKernelGGL(mk_fwd, dim3(grid), dim3(512), LDS_BYTES, stream, a); }
#else
    a.ph_lo = 0; a.ph_hi = NPHASE;
    void* kargs[] = {&a};
    hipError_t e = hipLaunchCooperativeKernel((const void*)mk_fwd, dim3(grid), dim3(512), kargs, LDS_BYTES, stream);
    if (e != hipSuccess) fprintf(stderr, "kernel_launch: cooperative launch failed: %s (grid %d)\n", hipGetErrorString(e), grid);
#endif
}
```

```cpp
#include <hip/hip_runtime.h>
#include <hip/hip_bf16.h>
#include <cstdio>
#include <cstdint>

#ifndef MK_PER_PHASE
#define MK_PER_PHASE 0
#endif

#ifndef PHASE_MASK
#define PHASE_MASK 0x3ff
#endif
#define PH_ON(k) ((PHASE_MASK >> (k)) & 1)
#ifndef REP_MASK
#define REP_MASK 0
#endif
#ifndef REP_N
#define REP_N 1
#endif
#ifndef EXTRA_BARS
#define EXTRA_BARS 0
#endif
#ifndef EPIF_FENCE
#define EPIF_FENCE 0
#endif
#ifndef DIFF_VPRE
#define DIFF_VPRE 2
#endif
#ifndef PROBE_MLAPREP
#define PROBE_MLAPREP 0
#endif
#ifndef DRY_MASK
#define DRY_MASK 0
#endif
#ifndef STAMP_MODE
#define STAMP_MODE 0
#endif
#ifndef STAMP_C
#define STAMP_C 1.2e-4f
#endif
#ifndef STAMP_LO
#define STAMP_LO 0
#endif
#ifndef STAMP_HI
#define STAMP_HI 17
#endif
#ifndef DRY_ALT
#define DRY_ALT 99
#endif
#ifndef DRY_LAYERS
#define DRY_LAYERS 3
#endif
#ifndef DRY_REPS
#define DRY_REPS 1
#endif
#ifndef UNIT_MASK
#define UNIT_MASK 15
#endif
#define UNIT_ON(k) ((UNIT_MASK >> (k)) & 1)
#define LAS __attribute__((address_space(3)))
#define GAS __attribute__((address_space(1)))
typedef unsigned short bf16_t;
typedef short bf16x8 __attribute__((ext_vector_type(8)));
typedef short s16x4 __attribute__((ext_vector_type(4)));
typedef float f32x4 __attribute__((ext_vector_type(4)));
typedef float f32x16 __attribute__((ext_vector_type(16)));
typedef unsigned u32x4 __attribute__((ext_vector_type(4)));
typedef unsigned u32x2 __attribute__((ext_vector_type(2)));
typedef int i32x4 __attribute__((ext_vector_type(4)));
typedef int i32x8 __attribute__((ext_vector_type(8)));
typedef GAS unsigned gu32;

constexpr int NB = 8, SEQ = 2048, DM = 1024, M = NB * SEQ, DEPTH = 2;
constexpr int NPROJ = 4864;
constexpr int NGATE = 4096;
constexpr int NBIG = NGATE + NPROJ;
constexpr int W_IN_COLS = 8864;
constexpr int PC_HQ = 0, PC_HF = 512, PC_HI = 1024, PC_HG = 1536, PC_CQ = 2048, PC_CKV = 2304,
              PC_DQ = 2432, PC_DK = 2944, PC_DV = 3456, PC_SQ = 3968, PC_SK = 4480, PC_SV = 4608, PC_KR = 4736;
__host__ __device__ __forceinline__ int wint_row(int c) { const int cn = c < 2432 ? c : (c < 2464 ? c + 2304 : c - 32); const int a = cn & 255, ab = a >> 5;
    return (cn & ~255) + (((ab & 1) ? 4 + (ab >> 1) : (ab >> 1)) << 5) + (a & 31); }
constexpr float EPS = 1e-6f;
constexpr float LOG2E = 1.4426950408889634f;

constexpr size_t MiB = 1u << 20;
constexpr size_t WS_CTL = 0, CTL_ZERO_BYTES = 64 * 1024;
constexpr size_t WS_MOD = 1 * MiB;
constexpr size_t WS_ROPE = 2 * MiB;
constexpr size_t WS_LIST = 4 * MiB;
constexpr size_t WS_TOKW = 6 * MiB;
constexpr size_t WS_UQT = 8 * MiB;
constexpr size_t WS_UKVT = 8 * MiB + 512 * 1024;
constexpr size_t WS_BRT = 9 * MiB;
constexpr size_t WS_OUTT = 13 * MiB;
constexpr size_t WS_PROJ = 16 * MiB;
constexpr size_t WS_GUT = 16 * MiB;
constexpr size_t WS_DT = 32 * MiB;
constexpr size_t WS_HID = 40 * MiB;
constexpr size_t WS_GATE8 = 168 * MiB;
constexpr size_t WS_X = 232 * MiB;
constexpr size_t WS_H = WS_X;
constexpr size_t WS_WINT = WS_X + 32 * MiB;
constexpr size_t WS_MLAQ = WS_X;
constexpr size_t WS_MLAK = WS_X + 24 * MiB;
constexpr size_t WS_MLAV = WS_X + 48 * MiB;
constexpr size_t WS_MERGED = WS_X + 24 * MiB;
constexpr size_t WS_END = 296 * MiB;
constexpr int HID_ROWS = 22528;

constexpr int CW_BAR = 4096;
constexpr int CW_QUEUE = 8192;
constexpr int CW_CNT = 8448;
constexpr int PPL = 8;
constexpr int NPHASE = 1 + PPL * DEPTH;

constexpr int RING_BYTES = 131072;
constexpr int MISC_OFF = RING_BYTES;
constexpr int LDS_BYTES = 147456;

#define LDS_WAIT() asm volatile("s_waitcnt lgkmcnt(0)" ::: "memory")
#define VM_WAIT() asm volatile("s_waitcnt vmcnt(0)" ::: "memory")
#define RLX_AGENT __ATOMIC_RELAXED, __HIP_MEMORY_SCOPE_AGENT
__device__ __forceinline__ unsigned f2bf(float f) { unsigned u = __builtin_bit_cast(unsigned, f); return (u + 0x7fffu + ((u >> 16) & 1u)) >> 16; }
typedef float f32x2_t __attribute__((ext_vector_type(2))); typedef __bf16 bf16x2_t __attribute__((ext_vector_type(2)));
__device__ __forceinline__ unsigned pk4f8(float a, float b, float c, float d) { int w = 0; w = __builtin_amdgcn_cvt_pk_fp8_f32(a, b, w, false); w = __builtin_amdgcn_cvt_pk_fp8_f32(c, d, w, true); return (unsigned)w; }
__device__ __forceinline__ unsigned pk2(float lo, float hi) { f32x2_t v = {lo, hi}; bf16x2_t b = __builtin_convertvector(v, bf16x2_t); return __builtin_bit_cast(unsigned, b); }
__device__ __forceinline__ float bf2f(unsigned short b) { return __builtin_bit_cast(float, (unsigned)b << 16); }
__device__ __forceinline__ float bflo(unsigned w) { return __builtin_bit_cast(float, w << 16); }
__device__ __forceinline__ float bfhi(unsigned w) { return __builtin_bit_cast(float, w & 0xffff0000u); }
__device__ __forceinline__ float fsigmoid(float x) { return __builtin_amdgcn_rcpf(1.0f + __expf(-x)); }
__device__ __forceinline__ float fsilu(float x) { return x * __builtin_amdgcn_rcpf(1.0f + __expf(-x)); }
__device__ __forceinline__ int crow(int r, int hi) { return (r & 3) + 8 * (r >> 2) + 4 * hi; }
__device__ __forceinline__ float shx(float v, int m, int lane) { return __builtin_bit_cast(float, __builtin_amdgcn_ds_bpermute((lane ^ m) << 2, __builtin_bit_cast(int, v))); }
__device__ __forceinline__ float dpp_f(float v, int ctrl_sel) {
    const int x = __builtin_bit_cast(int, v); int r;
    if (ctrl_sel == 0) r = __builtin_amdgcn_mov_dpp(x, 0xB1, 0xf, 0xf, true);
    else if (ctrl_sel == 1) r = __builtin_amdgcn_mov_dpp(x, 0x4E, 0xf, 0xf, true);
    else r = __builtin_amdgcn_mov_dpp(x, 0x141, 0xf, 0xf, true);
    return __builtin_bit_cast(float, r); }
__device__ __forceinline__ float sum8(float v) { v += dpp_f(v, 0); v += dpp_f(v, 1); v += dpp_f(v, 2); return v; }
__device__ __forceinline__ float sum32(float v, int lane) { v = sum8(v); v += __builtin_bit_cast(float, __builtin_amdgcn_mov_dpp(__builtin_bit_cast(int, v), 0x140, 0xf, 0xf, true)); v += shx(v, 16, lane); return v; }
__device__ __forceinline__ float wave_sum(float v, int lane) {
    v = sum8(v); v += __builtin_bit_cast(float, __builtin_amdgcn_mov_dpp(__builtin_bit_cast(int, v), 0x140, 0xf, 0xf, true));
    v += shx(v, 16, lane); v += shx(v, 32, lane);
    return v;
}

#define XB_TMO      128
#define XB_XCNT(j)  (256  + 64 * (j))
#define XB_XSUB(j)  (1280 + 64 * (j))
#define XB_XGEN(j)  (2304 + 64 * (j))
#define XB_TOP      3328
#define XB_TOPGEN   3392
#define XB_GMASK(j) (3456 + (j))
#define XCD_BAR_WORDS 3472
#define XB_SPIN_CAP (1u << 22)
__device__ __forceinline__ unsigned xb_ld(unsigned* p)              { return __hip_atomic_load(p, __ATOMIC_RELAXED, __HIP_MEMORY_SCOPE_AGENT); }
__device__ __forceinline__ unsigned xb_add(unsigned* p, unsigned v) { return __hip_atomic_fetch_add(p, v, __ATOMIC_RELAXED, __HIP_MEMORY_SCOPE_AGENT); }
__device__ __forceinline__ unsigned xb_xcc_id() { return (unsigned)__builtin_amdgcn_s_getreg((3 << 11) | 20) & 0xFu; }
#define XB_SPIN(cond, bar) do { unsigned _sp = 0; while (cond) { __builtin_amdgcn_s_sleep(1); \
    if ((++_sp & 255u) == 0u) { if (xb_ld(&(bar)[XB_TMO])) break; if (_sp > XB_SPIN_CAP) { atomicAdd(&(bar)[XB_TMO], 1u); break; } } } } while (0)
struct XcdBarrier { unsigned* bar; unsigned x; volatile LAS unsigned* st; };
__device__ __forceinline__ XcdBarrier xcd_barrier_post(unsigned* bar, volatile LAS unsigned* st) {
    XcdBarrier b; b.bar = bar; b.x = xb_xcc_id(); b.st = st;
    if (threadIdx.x == 0) {
        const unsigned o = __hip_atomic_fetch_or(&bar[XB_GMASK(b.x)], 1u << (blockIdx.x & 7u), __ATOMIC_RELAXED, __HIP_MEMORY_SCOPE_AGENT);
        asm volatile("s_waitcnt vmcnt(0)" :: "v"(o) : "memory");
        (void)xb_add(&bar[XB_XCNT(b.x)], 1u); }
    return b;
}
__device__ __forceinline__ void xcd_barrier_complete(unsigned* bar, unsigned x, unsigned& nloc, unsigned& nx, unsigned& lok) {
    const unsigned G = gridDim.x * gridDim.y * gridDim.z;
    unsigned sum, cnt, mine, sp = 0u;
    for (;;) {
        sum = 0u; cnt = 0u; mine = 0u;
#pragma unroll
        for (unsigned j = 0; j < 16; ++j) { const unsigned c = xb_ld(&bar[XB_XCNT(j)]); sum += c; cnt += (c > 0u) ? 1u : 0u; mine = (j == x) ? c : mine; }
        if (sum == G) break;
        __builtin_amdgcn_s_sleep(1);
        if ((++sp & 255u) == 0u) { if (xb_ld(&bar[XB_TMO])) break; if (sp > XB_SPIN_CAP) { atomicAdd(&bar[XB_TMO], 1u); break; } }
    }
    nloc = mine > 0u ? mine : 1u; nx = cnt > 0u ? cnt : 1u;
    unsigned ok = (G % 8u == 0u && sum == G) ? 1u : 0u;
#pragma unroll
    for (unsigned j = 0; j < 16; ++j) { const unsigned c = xb_ld(&bar[XB_XCNT(j)]), m = xb_ld(&bar[XB_GMASK(j)]); if (c > 0u && (c != G / 8u || __builtin_popcount(m) != 1)) ok = 0u; }
    lok = ok;
}
__device__ __forceinline__ void xcd_barrier(const XcdBarrier& b) {
    asm volatile("s_waitcnt vmcnt(0)" ::: "memory");
    __syncthreads();
    if (threadIdx.x == 0) {
        unsigned* bar = b.bar;
        __builtin_amdgcn_s_waitcnt(0);
        unsigned nloc = b.st[0], nx = b.st[1];
        if (nloc == 0u) { unsigned lok; xcd_barrier_complete(bar, b.x, nloc, nx, lok); b.st[0] = nloc; b.st[1] = nx; b.st[2] = lok; }
        const unsigned old = xb_add(&bar[XB_XSUB(b.x)], 1u);
        const unsigned gen = old / nloc;
        if (old + 1u == (gen + 1u) * nloc) {
            __builtin_amdgcn_fence(__ATOMIC_RELEASE, "agent");
            asm volatile("s_waitcnt vmcnt(0)" ::: "memory");
            const unsigned og = xb_add(&bar[XB_TOP], 1u);
            const unsigned tg = og / nx;
            if (og + 1u == (tg + 1u) * nx) xb_add(&bar[XB_TOPGEN], 1u);
            else XB_SPIN(xb_ld(&bar[XB_TOPGEN]) == tg, bar);
            __builtin_amdgcn_fence(__ATOMIC_ACQUIRE, "agent");
            asm volatile("s_waitcnt vmcnt(0)" ::: "memory");
        } else {
            XB_SPIN(xb_ld(&bar[XB_TOPGEN]) == gen, bar);
            __builtin_amdgcn_fence(__ATOMIC_ACQUIRE, "agent");
            asm volatile("s_waitcnt vmcnt(0)" ::: "memory");
        }
    }
    __syncthreads();
}

constexpr float M8_SCALE = 8.0f;
constexpr float Y8_SCALE = 8.0f;
constexpr float HID8_SCALE = 4.0f;
constexpr float W8_SCALE = 32.0f, W8_INV = 1.0f / 32.0f;
namespace pg8 {
constexpr int BM = 256, BK = 64, HALF = 128, HTB = HALF * BK * 2, NXCD = 8, WGM = 8;
__host__ __device__ __forceinline__ int lds_byte(int r, int c) { const int st = (r >> 4) * 2 + (c >> 5), rr = r & 15, cc = c & 31, ob = rr * 64 + cc * 2; return st * 1024 + (ob ^ (((ob >> 9) & 1) << 5)); }
__host__ __device__ __forceinline__ void stage_rc(int b, int& R, int& C) { const int st = b / 1024, sb = b % 1024, swz = sb ^ (((sb >> 9) & 1) << 5); R = (st >> 1) * 16 + swz / 64; C = (st & 1) * 32 + (swz % 64) / 2; }
__host__ __device__ __forceinline__ int perm32(int rho) { const int n = rho >> 4, i = rho & 15; return 8 * (i >> 2) + 4 * n + (i & 3); }

struct Unit {
    int pm, pn, aux, kind;
    unsigned a;
    unsigned b0, b1;
    unsigned ridx;
    int nvalid;
};
__device__ __forceinline__ void tile_order(int wgid, int nM, int nN, int& pm, int& pn) {
    const int nwg = nM * nN;
    { const int q = nwg / NXCD, r = nwg % NXCD, xcd = wgid % NXCD, off = wgid / NXCD; wgid = (xcd < r ? xcd * (q + 1) : r * (q + 1) + (xcd - r) * q) + off; }
    const int nig = WGM * nN, gid = wgid / nig, fm = gid * WGM, gsz = (nM - fm) < WGM ? (nM - fm) : WGM;
    pm = fm + ((wgid % nig) % gsz); pn = (wgid % nig) / gsz;
}
__device__ __forceinline__ unsigned cvt_pk_bf16(float lo, float hi) { unsigned r; asm volatile("v_cvt_pk_bf16_f32 %0, %1, %2" : "=v"(r) : "v"(lo), "v"(hi)); return r; }

template <bool M, class S> __device__ __forceinline__ int mg_nt(const S& s, const Unit& u, int d) { if constexpr (M) return s.nt(u); else return d; }
template <bool M, class S> __device__ __forceinline__ int mg_ldb(const S& s, const Unit& u, int d) { if constexpr (M) return s.ldb(u); else return d; }
template <bool M, class S> __device__ __forceinline__ bool mg_perm(const S& s, const Unit& u, bool d) { if constexpr (M) return s.perm(u); else return d; }
template <bool M, class S> __device__ __forceinline__ bool mg_dep(const S& s, const Unit& u) { if constexpr (M) return s.dep(u); else return false; }
template <bool M, class S> __device__ __forceinline__ void mg_ready(const S& s, const Unit& u) { if constexpr (M) s.a_ready(u); }
template <bool M, class S> __device__ __forceinline__ void mg_done(const S& s, const Unit& u, int wid, int lane) { if constexpr (M) s.done(u, wid, lane); }
template <class S> __device__ __forceinline__ unsigned ga_tile(const S& s, const Unit& u, int k) { if constexpr (S::ABLK) return s.atile(u, k); else return u.a + (unsigned)k * s.akstep(u); }
template <class S> __device__ __forceinline__ unsigned ga_voff(const S& s, const Unit& u, int R, int C) { if constexpr (S::ABLK) return s.voffa(u, R, C); else return (unsigned)(R * s.lda(u) + C * 2); }
template <class S> __device__ __forceinline__ unsigned ga_hs(const S& s, const Unit& u) { if constexpr (S::ABLK) return s.hs(u); else return (unsigned)HALF * (unsigned)s.lda(u); }
template <bool GATHER, bool MERGED, bool F8, class Epi, class Sched>
__device__ __forceinline__ void gemm_phase(LAS unsigned char* lds, const char* wsb, const int nt_, const int ldb_  , const Sched& S, const Epi& E) {
    int tid = threadIdx.x; asm volatile("" : "+v"(tid));
    const int wid = __builtin_amdgcn_readfirstlane(tid >> 6), lane = tid & 63, wr = wid >> 2, wc = wid & 3, fr = lane & 15, fq = lane >> 4;
    unsigned vB[2], vBn[2];
#define PG8_NT(u) mg_nt<MERGED>(S, u, nt_)
#define PG8_LDB(u_) mg_ldb<MERGED>(S, u_, ldb_)
#define PG8_VOFFB(u, v) do { int t4_ = threadIdx.x; asm volatile("" : "+v"(t4_)); _Pragma("unroll") for (int i_ = 0; i_ < 2; ++i_) { int R_, C_; stage_rc(t4_ * 16 + i_ * 8192, R_, C_); \
        const bool pm_ = mg_perm<MERGED>(S, u, Epi::PERM); const int Rb_ = pm_ ? ((R_ & ~31) + perm32(R_ & 31)) : R_; v[i_] = (unsigned)(Rb_ * PG8_LDB(u) + C_ * 2); } } while (0)
    const unsigned ldsw = (unsigned)wid * 1024u;
    const int aoff = lds_byte(wr * 64 + fr, fq * 8), boff = lds_byte(wc * 32 + fr, fq * 8);
#define PG8_SA(b, h) (((b) * 2 + (h)) * HTB)
#define PG8_SB(b, h) ((4 + (b) * 2 + (h)) * HTB)
#define PG8_GLDS(bufoff, gptr, i_) __builtin_amdgcn_global_load_lds((const unsigned*)(gptr), (LAS unsigned*)(lds + (bufoff) + ldsw + (i_) * 8192), 16, 0, 0)
#define PG8_STAGE_B(bufoff, goff, w0, w1) do { PG8_GLDS(bufoff, wsb + (size_t)(unsigned)((goff) + (w0)), 0); PG8_GLDS(bufoff, wsb + (size_t)(unsigned)((goff) + (w1)), 1); } while (0)
#define PG8_STAGE_A(bufoff, goff, v0, v1) do { PG8_GLDS(bufoff, wsb + (size_t)(unsigned)((goff) + (v0)), 0); PG8_GLDS(bufoff, wsb + (size_t)(unsigned)((goff) + (v1)), 1); } while (0)
#define PG8_LDA(dst, b, h) do { if constexpr (F8) { _Pragma("unroll") for (int m = 0; m < 4; ++m) { const LAS i32x4* p_ = (const LAS i32x4*)(lds + PG8_SA(b, h) + aoff + m * 2048); dst##8[m].lo = p_[0]; dst##8[m].hi = p_[64]; } } \
        else { _Pragma("unroll") for (int m = 0; m < 4; ++m) _Pragma("unroll") for (int k = 0; k < 2; ++k) dst[m][k] = *(const LAS bf16x8*)(lds + PG8_SA(b, h) + aoff + m * 2048 + k * 1024); } } while (0)
#define PG8_LDBF(dst, b, h) do { if constexpr (F8) { _Pragma("unroll") for (int n = 0; n < 2; ++n) { const LAS i32x4* p_ = (const LAS i32x4*)(lds + PG8_SB(b, h) + boff + n * 2048); dst##8[n].lo = p_[0]; dst##8[n].hi = p_[64]; } } \
        else { _Pragma("unroll") for (int n = 0; n < 2; ++n) _Pragma("unroll") for (int k = 0; k < 2; ++k) dst[n][k] = *(const LAS bf16x8*)(lds + PG8_SB(b, h) + boff + n * 2048 + k * 1024); } } while (0)
#define PG8_MMA(ai, bj, At, Bt) do { __builtin_amdgcn_s_setprio(1); if constexpr (F8) { _Pragma("unroll") for (int m = 0; m < 4; ++m) _Pragma("unroll") for (int n = 0; n < 2; ++n) \
        asm volatile("v_mfma_f32_16x16x128_f8f6f4 %0, %1, %2, %0" : "+v"(acc[ai][bj][m][n]) : "v"(Bt##8[n]), "v"(At##8[m])); } \
        else { _Pragma("unroll") for (int m = 0; m < 4; ++m) _Pragma("unroll") for (int n = 0; n < 2; ++n) _Pragma("unroll") for (int k = 0; k < 2; ++k) \
        acc[ai][bj][m][n] = __builtin_amdgcn_mfma_f32_16x16x32_bf16(Bt[n][k], At[m][k], acc[ai][bj][m][n], 0, 0, 0); } __builtin_amdgcn_s_setprio(0); } while (0)
#define PG8_WAIT_V(n) asm volatile("s_waitcnt vmcnt(" #n ")" ::: "memory")
#define PG8_WAIT_L(n) asm volatile("s_waitcnt lgkmcnt(" #n ")" ::: "memory")
#define PG8_BAR __builtin_amdgcn_s_barrier()
#define PG8_SCHED __builtin_amdgcn_sched_barrier(0)
    Unit cur, nxt; int ui = 0;
    if (!S.next(0, cur)) return;
    constexpr int NH = GATHER ? 2 : 1;
    unsigned vA[2][NH], vN[2][NH];
#define PG8_VOFF2(u, v) do { int t3_ = threadIdx.x; asm volatile("" : "+v"(t3_)); _Pragma("unroll") for (int i_ = 0; i_ < 2; ++i_) { int R_, C_; stage_rc(t3_ * 16 + i_ * 8192, R_, C_); \
        _Pragma("unroll") for (int h_ = 0; h_ < NH; ++h_) { const int r_ = R_ + HALF * h_; \
        if (GATHER) { const int rr_ = (u).ridx ? ((r_ < (u).nvalid) ? ((const int*)(wsb + (u).ridx))[r_] : 0) : r_; v[i_][h_] = (unsigned)(rr_ * S.lda(u) + C_ * 2); } \
        else v[i_][h_] = ga_voff(S, u, R_, C_); } } } while (0)
#define PG8_HS(u) (GATHER ? 0u : ga_hs(S, u))
    mg_ready<MERGED>(S, cur);
    PG8_VOFF2(cur, vA); PG8_VOFFB(cur, vB);
    f32x4 acc[2][2][4][2];
#pragma unroll
    for (int a = 0; a < 2; ++a)
#pragma unroll
        for (int b = 0; b < 2; ++b)
#pragma unroll
            for (int m = 0; m < 4; ++m)
#pragma unroll
                for (int n = 0; n < 2; ++n) acc[a][b][m][n] = (f32x4){0.f, 0.f, 0.f, 0.f};
    bf16x8 At[4][2], B0[2][2], B1[2][2]; i32x8 At8[4], B08[2], B18[2];
#define PG8_PROLOGUE(u) do { const unsigned hsb = (unsigned)HALF * PG8_LDB(u); \
    PG8_STAGE_B(PG8_SB(0, 0), (u).b0, vB[0], vB[1]); PG8_STAGE_B(PG8_SB(0, 1), (u).b0 + hsb, vB[0], vB[1]); PG8_STAGE_A(PG8_SA(0, 0), ga_tile(S, u, 0), vA[0][0], vA[1][0]); PG8_STAGE_A(PG8_SA(0, 1), ga_tile(S, u, 0) + PG8_HS(u), vA[0][NH - 1], vA[1][NH - 1]); \
    if (wr == 1) PG8_BAR; \
    PG8_WAIT_V(2); PG8_BAR; \
    PG8_STAGE_B(PG8_SB(1, 0), (u).b0 + BK * 2, vB[0], vB[1]); PG8_STAGE_A(PG8_SA(1, 0), ga_tile(S, u, 1), vA[0][0], vA[1][0]); PG8_STAGE_B(PG8_SB(1, 1), (u).b0 + hsb + BK * 2, vB[0], vB[1]); \
    PG8_WAIT_V(6); PG8_BAR; } while (0)
    PG8_PROLOGUE(cur);
    for (;;) {
        const bool has_next = S.next(ui + 1, nxt);
        const bool pre = has_next && !mg_dep<MERGED>(S, nxt);
        Unit stg = pre ? nxt : cur;
        if (pre) { PG8_VOFF2(nxt, vN); if (MERGED) { PG8_VOFFB(nxt, vBn); } else { vBn[0] = vB[0]; vBn[1] = vB[1]; } }
        else { _Pragma("unroll") for (int i_ = 0; i_ < 2; ++i_) _Pragma("unroll") for (int h_ = 0; h_ < NH; ++h_) vN[i_][h_] = vA[i_][h_]; vBn[0] = vB[0]; vBn[1] = vB[1]; }
        const int nt = PG8_NT(cur);
        for (int t = 0; t < nt; t += 2) {
            const bool last = (t == nt - 2);
            const unsigned hstepB = (unsigned)HALF * (last ? PG8_LDB(stg) : PG8_LDB(cur));
            const unsigned y0 = last ? vBn[0] : vB[0], y1 = last ? vBn[1] : vB[1];
            const unsigned a1 = ga_tile(S, cur, t + 1);
            const unsigned a2 = last ? ga_tile(S, stg, 0) : ga_tile(S, cur, t + 2);
            const unsigned a3 = last ? ga_tile(S, stg, 1) : ga_tile(S, cur, t + 3);
            unsigned hs1 = PG8_HS(cur), hs2 = last ? PG8_HS(stg) : PG8_HS(cur);
            const unsigned b2 = last ? stg.b0 : S.btile(cur, t + 2);
            const unsigned b3 = b2 + BK * 2;
            unsigned x00 = last ? vN[0][0] : vA[0][0], x10 = last ? vN[1][0] : vA[1][0], x01 = last ? vN[0][NH - 1] : vA[0][NH - 1], x11 = last ? vN[1][NH - 1] : vA[1][NH - 1];
            unsigned vc0 = vA[0][NH - 1], vc1 = vA[1][NH - 1];
            if constexpr (Sched::MULTIK) {
                int t6_ = threadIdx.x; asm volatile("" : "+v"(t6_)); int R0_, C0_, R1_, C1_; stage_rc(t6_ * 16, R0_, C0_); stage_rc(t6_ * 16 + 8192, R1_, C1_);
                vc0 = S.voffk(cur, t + 1, R0_, C0_); vc1 = S.voffk(cur, t + 1, R1_, C1_);
                x00 = x01 = last ? S.voffk(stg, 0, R0_, C0_) : S.voffk(cur, t + 2, R0_, C0_); x10 = x11 = last ? S.voffk(stg, 0, R1_, C1_) : S.voffk(cur, t + 2, R1_, C1_);
                hs1 = S.hsk(cur, t + 1); hs2 = last ? S.hsk(stg, 0) : S.hsk(cur, t + 2); }
            if constexpr (Epi::MID) { if (t > 0 && (t & 3) == 0) {
                asm volatile("s_nop 15\n\ts_nop 7" ::: "memory"); int t7_ = threadIdx.x; asm volatile("" : "+v"(t7_)); const int l7_ = t7_ & 63; E.mid(acc, cur, t >> 2, wr, wc, l7_ & 15, l7_ >> 4); } }
            PG8_LDBF(B0, 0, 0); PG8_LDBF(B1, 0, 1); PG8_SCHED; PG8_LDA(At, 0, 0); PG8_STAGE_A(PG8_SA(1, 1), a1 + hs1, vc0, vc1);
            PG8_WAIT_V(8); PG8_WAIT_L(0); PG8_BAR; PG8_MMA(0, 0, At, B0); PG8_MMA(0, 1, At, B1); PG8_BAR; PG8_SCHED;
            PG8_LDA(At, 0, 1); PG8_STAGE_B(PG8_SB(0, 0), b2, y0, y1); PG8_STAGE_B(PG8_SB(0, 1), b2 + hstepB, y0, y1); PG8_STAGE_A(PG8_SA(0, 0), a2, x00, x10);
            PG8_WAIT_V(8); PG8_WAIT_L(0); PG8_BAR; PG8_MMA(1, 0, At, B0); PG8_MMA(1, 1, At, B1); PG8_BAR; PG8_SCHED;
            PG8_LDBF(B0, 1, 0); PG8_LDBF(B1, 1, 1); PG8_SCHED; PG8_LDA(At, 1, 0); PG8_STAGE_A(PG8_SA(0, 1), a2 + hs2, x01, x11);
            PG8_WAIT_V(8); PG8_WAIT_L(0); PG8_BAR; PG8_MMA(0, 0, At, B0); PG8_MMA(0, 1, At, B1); PG8_BAR; PG8_SCHED;
            PG8_LDA(At, 1, 1); PG8_STAGE_B(PG8_SB(1, 0), b3, y0, y1); PG8_STAGE_B(PG8_SB(1, 1), b3 + hstepB, y0, y1); PG8_STAGE_A(PG8_SA(1, 0), a3, x00, x10);
            PG8_WAIT_V(8); PG8_WAIT_L(0); PG8_BAR; PG8_MMA(1, 0, At, B0); PG8_MMA(1, 1, At, B1); PG8_BAR; PG8_SCHED;
        }
        if (wr == 0) PG8_BAR;
        if constexpr (F8) asm volatile("s_nop 15\n\ts_nop 7" ::: "memory");
        { int t2 = threadIdx.x; asm volatile("" : "+v"(t2)); const int l2 = t2 & 63; E(acc, cur, wr, wc, l2 & 15, l2 >> 4);
          if (MERGED) { PG8_WAIT_V(0); PG8_BAR; mg_done<MERGED>(S, cur, wid, l2); } }
        if (!has_next) break;
#pragma unroll
        for (int a = 0; a < 2; ++a)
#pragma unroll
            for (int b = 0; b < 2; ++b)
#pragma unroll
                for (int m = 0; m < 4; ++m)
#pragma unroll
                    for (int n = 0; n < 2; ++n) acc[a][b][m][n] = (f32x4){0.f, 0.f, 0.f, 0.f};
        cur = nxt; ++ui;
        if (pre) { _Pragma("unroll") for (int i_ = 0; i_ < 2; ++i_) _Pragma("unroll") for (int h_ = 0; h_ < NH; ++h_) vA[i_][h_] = vN[i_][h_]; vB[0] = vBn[0]; vB[1] = vBn[1];
            if (wr == 1) PG8_BAR; }
        else { mg_ready<MERGED>(S, cur); PG8_VOFF2(cur, vA); PG8_VOFFB(cur, vB); PG8_WAIT_V(0); PG8_BAR; PG8_PROLOGUE(cur); }
    }
    PG8_WAIT_V(0);
    PG8_BAR;
#undef PG8_SA
#undef PG8_SB
#undef PG8_GLDS
#undef PG8_STAGE_A
#undef PG8_STAGE_B
#undef PG8_LDA
#undef PG8_LDB
#undef PG8_MMA
#undef PG8_WAIT_V
#undef PG8_WAIT_L
#undef PG8_BAR
#undef PG8_SCHED
#undef PG8_VOFF2
#undef PG8_PROLOGUE
#undef PG8_VOFFB
#undef PG8_NT
#undef PG8_LDBF
#undef PG8_HS
}
}

struct Args {
    const float* x; const float* c; const int* pos; const float* ada_w; const float* ada_b; const float* norm_mix; const float* norm_ffn;
    const float* w_in; const float* hg_lb; const float* hg_onorm; const float* mla_q_norm; const float* mla_kv_norm; const float* mla_w_uq;
    const float* mla_w_ukv; const float* mla_qk_norm; const float* diff_qk_norm; const float* diff_lam; const float* diff_onorm;
    const float* swa_qk_norm; const float* swa_sinks; const float* w_branch; const float* w_out; const float* router_w; const float* router_bias;
    const float* moe_w_gate; const float* moe_w_up; const float* moe_w_down;
    float* out; unsigned char* ws; int ph_lo, ph_hi;
};
typedef const __attribute__((address_space(4))) Args* kargs_ptr;
__device__ __forceinline__ Args load_args() {
#if defined(__HIP_DEVICE_COMPILE__)
    kargs_ptr ap = (kargs_ptr)__builtin_amdgcn_kernarg_segment_ptr(); asm volatile("" : "+s"(ap)); Args r; __builtin_memcpy(&r, ap, sizeof(Args)); return r;
#else
    return Args{};
#endif
}
struct Frame {
    LAS unsigned char* lds; unsigned char* ldsg;
    volatile LAS unsigned* MISC; gu32* ctl;
    int tid, lane, wave, vcu, G;
};

__device__ __forceinline__ Frame fresh(const Frame& F0) {
    Frame F = F0; int t = threadIdx.x; asm volatile("" : "+v"(t)); F.tid = t; F.lane = t & 63; F.wave = __builtin_amdgcn_readfirstlane(t >> 6);
    unsigned lb = 0; asm volatile("" : "+s"(lb)); F.lds = (LAS unsigned char*)(F0.lds + lb); F.MISC = (volatile LAS unsigned*)(F.lds + MISC_OFF); return F;
}
__device__ __forceinline__ void conv_wg_item(const Frame& F, const float* W, int ld, int c0, int ncols, int K, bf16_t* WT, int row0, int rstep, int item, bool frag = false, bool f8 = false, bool pmap = false) {
    constexpr int ST = 257;
    LAS float* tile = (LAS float*)F.lds;
    const int nblk = (ncols + 255) >> 8, kb = item / nblk, nb = item % nblk, k0 = 64 * kb, n0 = 256 * nb;
    const int lane = F.lane, w = F.wave;
    { const int n = n0 + 4 * lane; const bool ok = n < ncols; const float* src = W + (size_t)(k0 + 8 * w) * ld + c0 + n; f32x4 v[8];
#pragma unroll
      for (int r = 0; r < 8; ++r) v[r] = ok ? *(const GAS f32x4*)(src + (size_t)r * ld) : (f32x4){0.f, 0.f, 0.f, 0.f};
#pragma unroll
      for (int r = 0; r < 8; ++r) { LAS float* d = tile + (8 * w + r) * ST + 4 * lane; d[0] = v[r][0]; d[1] = v[r][1]; d[2] = v[r][2]; d[3] = v[r][3]; } }
    __syncthreads();
    if (f8) {
#pragma unroll
        for (int j = 0; j < 2; ++j) { const int idx = F.tid + 512 * j, c = idx & 3, n = idx >> 2; const LAS float* sp = tile + (16 * c) * ST + n; u32x4 o;
#pragma unroll
            for (int q = 0; q < 4; ++q) o[q] = pk4f8(sp[(4 * q) * ST] * W8_SCALE, sp[(4 * q + 1) * ST] * W8_SCALE, sp[(4 * q + 2) * ST] * W8_SCALE, sp[(4 * q + 3) * ST] * W8_SCALE);
            if (n0 + n < ncols) { const int ng = pmap ? row0 + wint_row(n0 + n) : row0 + (n & 127) + (n >> 7) * rstep + (n0 >> 7) * rstep, c16 = (k0 >> 4) + c, kb32 = c16 >> 1;
                const size_t dst = frag ? ((size_t)(((ng >> 5) * (K >> 6) + (kb32 >> 1)) * 64 + (kb32 & 1) * 32 + (ng & 31))) * 32 + (c16 & 1) * 16 : (size_t)ng * K + k0 + 16 * c;
                *(GAS u32x4*)((unsigned char*)WT + dst) = o; } }
        __syncthreads(); return; }
#pragma unroll
    for (int j = 0; j < 4; ++j) { const int idx = F.tid + 512 * j, c = idx & 7, n = idx >> 3; const LAS float* sp = tile + (8 * c) * ST + n;
        u32x4 o; o.x = pk2(sp[0 * ST], sp[1 * ST]); o.y = pk2(sp[2 * ST], sp[3 * ST]); o.z = pk2(sp[4 * ST], sp[5 * ST]); o.w = pk2(sp[6 * ST], sp[7 * ST]);
        if (n0 + n < ncols) { const int ng = row0 + (n & 127) + (n >> 7) * rstep + (n0 >> 7) * rstep, kc = (k0 >> 3) + c;
            const size_t dst = frag ? ((size_t)(((ng >> 5) * (K >> 4) + (kc >> 1)) * 64 + (kc & 1) * 32 + (ng & 31))) * 8 : (size_t)ng * K + k0 + 8 * c;
            *(GAS u32x4*)(WT + dst) = o; } }
    __syncthreads();
}
constexpr int MAIN_CONV_ITEMS = 16 * 16 + 16 * 19 + 4 * 3 + 2 * 4 + 4 * 8 * 4 + 16 * 4 + 1;
__device__ __forceinline__ void conv_main_item(const Frame& F0, int l, int it) {
    const Args A = load_args(); const Frame F = fresh(F0); asm volatile("" : "+s"(l));
    bf16_t* WINT = (bf16_t*)(A.ws + WS_WINT); bf16_t* UQT = (bf16_t*)(A.ws + WS_UQT); bf16_t* UKVT = (bf16_t*)(A.ws + WS_UKVT);
    bf16_t* BRT = (bf16_t*)(A.ws + WS_BRT); bf16_t* OUTT = (bf16_t*)(A.ws + WS_OUTT);
    const float* w_in = A.w_in + (size_t)l * DM * W_IN_COLS;
    constexpr int I_G = 16 * 16, I_P = 16 * 19, I_UQ = 4 * 3, I_UKV = 2 * 4, I_BR = 4 * 8 * 4, I_OUT = 16 * 4;
    int r = it;
    if (r < I_G) { conv_wg_item(F, w_in, W_IN_COLS, 4768, 4096, DM, WINT, 0, 128, r, false, true); return; } r -= I_G;
    if (r < I_P) { conv_wg_item(F, w_in, W_IN_COLS, 0, 4768, DM, WINT, NGATE, 128, r, false, true, true); return; } r -= I_P;
    if (r < I_UQ) { conv_wg_item(F, A.mla_w_uq + (size_t)l * 256 * 768, 768, 0, 768, 256, UQT, 0, 128, r, true, true); return; } r -= I_UQ;
    if (r < I_UKV) { conv_wg_item(F, A.mla_w_ukv + (size_t)l * 128 * 1024, 1024, 0, 1024, 128, UKVT, 0, 128, r, true, true); return; } r -= I_UKV;
    if (r < I_BR) { const int b = r >> 5; conv_wg_item(F, A.w_branch + ((size_t)l * 4 + b) * 512 * 1024, 1024, 0, 1024, 512, BRT, b * 1024, 128, r & 31, false, true); return; } r -= I_BR;
    if (r < I_OUT) { conv_wg_item(F, A.w_out + (size_t)l * DM * DM, DM, 0, DM, DM, OUTT, 0, 128, r, false, true); return; }
    { unsigned z0 = 0u; asm volatile("" : "+v"(z0)); u32x4 z = {z0, z0, z0, z0}; GAS u32x4* p = (GAS u32x4*)((unsigned char*)WINT + (size_t)(NGATE + 4608) * DM);
      for (int i = F.tid; i < 96 * DM / 16; i += 512) { const int rr = i >> 6, q = i & 63; p[(rr < 32 ? 96 + rr : 160 + rr) * (DM / 16) + q] = z; } }
}
__device__ __forceinline__ void conv_layer_main(const Frame& F0, int l) {
    for (int it = F0.vcu; it < MAIN_CONV_ITEMS; it += F0.G) conv_main_item(F0, l, it);
}
__device__ __forceinline__ void conv_layer_moe(const Frame& F0, int l) {
    const Args A = load_args(); const Frame F = fresh(F0); asm volatile("" : "+s"(l));
    bf16_t* GUT = (bf16_t*)(A.ws + WS_GUT); bf16_t* DT = (bf16_t*)(A.ws + WS_DT);
    constexpr int I_GU = 16 * 2 * 16, I_D = 16 * 16;
    for (int it = F.vcu; it < I_GU + I_D; it += F.G) {
        if (it < I_GU) { const int e = it >> 5, isup = (it >> 4) & 1, item = it & 15;
            const float* src = (isup ? A.moe_w_up : A.moe_w_gate) + ((size_t)l * 16 + e) * DM * 256;
            conv_wg_item(F, src, 256, 0, 256, DM, GUT, e * 512 + isup * 128, 256, item, false, true);
        } else { const int r = it - I_GU, e = r >> 4, item = r & 15;
            conv_wg_item(F, A.moe_w_down + ((size_t)l * 16 + e) * 256 * DM, DM, 0, DM, 256, DT, e * 1024, 128, item, false, true); }
    }
}

__device__ __forceinline__ void p0_mod_rope(const Frame& F0) {
    const Args A = load_args(); const Frame F = fresh(F0);
    { float* rope = (float*)(A.ws + WS_ROPE);
      for (int idx = F.vcu * 512 + F.tid; idx < M * 16; idx += F.G * 512) { const int m = idx >> 4, i = idx & 15;
          const float inv = powf(10000.0f, -(float)(2 * i) / 32.0f); const float ang = (float)A.pos[m] * inv; float sn, cs; sincosf(ang, &sn, &cs);
          rope[m * 32 + i] = cs; rope[m * 32 + 16 + i] = sn; } }
    LAS float* cact = (LAS float*)(F.lds + 73728);
    LAS float* part = (LAS float*)(F.lds + 106496);
    for (int i = F.tid; i < 8 * DM; i += 512) { const int b = i >> 10, k = i & 1023; cact[k * 8 + b] = fsilu(A.c[b * DM + k]); }
    __syncthreads();
    float* mod = (float*)(A.ws + WS_MOD);
    unsigned* pq = (unsigned*)F.ctl + CW_QUEUE + 48;
    for (int it_ = 0;; ++it_) {
        int u;
        if (it_ == 0) u = (int)blockIdx.x;
        else { __syncthreads(); if (F.tid == 0) F.MISC[16] = atomicAdd(pq, 1u) + gridDim.x; __syncthreads(); u = __builtin_amdgcn_readfirstlane((int)F.MISC[16]); }
        if (u >= 2 * 96 + MAIN_CONV_ITEMS) break;
        if (u >= 2 * 96) { conv_main_item(F0, 0, u - 2 * 96); continue; }
        const int l = u / 96, n0 = (u % 96) * 64;
        const float* w = A.ada_w + (size_t)l * DM * 6144 + n0 + F.lane;
        float acc[8];
#pragma unroll
        for (int b = 0; b < 8; ++b) acc[b] = 0.f;
        const int k0 = F.wave * 128;
#pragma unroll 1
        for (int kb = 0; kb < 128; kb += 32) { float wv[32];
#pragma unroll
            for (int k = 0; k < 32; ++k) wv[k] = w[(size_t)(k0 + kb + k) * 6144];
#pragma unroll
            for (int k = 0; k < 32; ++k) { const f32x4 c0 = *(const LAS f32x4*)(cact + (k0 + kb + k) * 8), c1 = *(const LAS f32x4*)(cact + (k0 + kb + k) * 8 + 4);
                acc[0] += c0[0] * wv[k]; acc[1] += c0[1] * wv[k]; acc[2] += c0[2] * wv[k]; acc[3] += c0[3] * wv[k]; acc[4] += c1[0] * wv[k]; acc[5] += c1[1] * wv[k]; acc[6] += c1[2] * wv[k]; acc[7] += c1[3] * wv[k]; } }
#pragma unroll
        for (int b = 0; b < 8; ++b) part[(F.wave * 8 + b) * 64 + F.lane] = acc[b];
        __syncthreads();
        { const int b = F.tid >> 6, n = F.tid & 63; float s = 0.f;
#pragma unroll
          for (int w8 = 0; w8 < 8; ++w8) s += part[(w8 * 8 + b) * 64 + n];
          mod[((size_t)l * 8 + b) * 6144 + n0 + n] = s + A.ada_b[l * 6144 + n0 + n]; }
        __syncthreads();
    }
}

__device__ __forceinline__ void store_row_bf16(bf16_t* orow, int lane, const f32x4 (&v)[4]) {
    GAS unsigned long long* o8 = (GAS unsigned long long*)orow + lane;
#pragma unroll
    for (int j = 0; j < 4; ++j) o8[64 * j] = (unsigned long long)pk2(v[j].x, v[j].y) | ((unsigned long long)pk2(v[j].z, v[j].w) << 32);
}
__device__ __forceinline__ void store_row_f8(unsigned char* orow, int lane, const f32x4 (&v)[4]) {
    GAS unsigned* o4 = (GAS unsigned*)orow + lane;
#pragma unroll
    for (int j = 0; j < 4; ++j) o4[64 * j] = pk4f8(v[j].x, v[j].y, v[j].z, v[j].w);
}
template <bool ROUTER>
__device__ __forceinline__ void norm_phase(const Frame& F0, int l) {
    const Args A = load_args(); const Frame F = fresh(F0); asm volatile("" : "+s"(l));
    bf16_t* H = (bf16_t*)(A.ws + WS_H); const float* mod = (const float*)(A.ws + WS_MOD) + (size_t)l * 8 * 6144;
    const float* xin = ROUTER ? A.out : ((l == 0) ? A.x : A.out);
    const float* gain = (ROUTER ? A.norm_ffn : A.norm_mix) + l * DM;
    const int lane = F.lane, gw = F.vcu * 8 + F.wave, b = gw >> 8, r0 = gw & 255;
    LAS float* rwt = (LAS float*)F.lds;
    LAS int* rowpair = (LAS int*)(F.lds + 65536);
    if (ROUTER) {
#pragma unroll
        for (int i = 0; i < 8; ++i) { const int idx = F.tid + 512 * ((i + F.vcu) & 7), c = idx >> 2, q = idx & 3; const f32x4 r = *(const GAS f32x4*)(A.router_w + (size_t)c * 16 + 4 * q);
            rwt[(4 * q + 0) * DM + c] = r[0]; rwt[(4 * q + 1) * DM + c] = r[1]; rwt[(4 * q + 2) * DM + c] = r[2]; rwt[(4 * q + 3) * DM + c] = r[3]; }
        __syncthreads();
    }
    f32x4 sc[4], sh[4];
    { const float* pm = mod + b * 6144 + (ROUTER ? 3072 : 0);
#pragma unroll
      for (int j = 0; j < 4; ++j) { const f32x4 gg = ((const GAS f32x4*)gain)[lane + 64 * j], s1 = ((const GAS f32x4*)(pm + 1024))[lane + 64 * j]; sh[j] = ((const GAS f32x4*)pm)[lane + 64 * j]; sc[j] = gg * (s1 + 1.0f); } }
    const int b5 = lane >> 5, b4 = (lane >> 4) & 1, b3 = (lane >> 3) & 1, b2 = (lane >> 2) & 1;
    f32x4 xn[4];
    { const GAS f32x4* xr = (const GAS f32x4*)(xin + (size_t)(b * 2048 + r0) * DM) + lane;
#pragma unroll
      for (int j = 0; j < 4; ++j) xn[j] = xr[64 * j]; }
#pragma unroll 2
    for (int k = 0; k < 8; ++k) {
        const int m = b * 2048 + r0 + 256 * k;
        f32x4 v[4];
#pragma unroll
        for (int j = 0; j < 4; ++j) v[j] = xn[j];
        if (k + 1 < 8) { const GAS f32x4* xr = (const GAS f32x4*)(xin + (size_t)(m + 256) * DM) + lane;
#pragma unroll
            for (int j = 0; j < 4; ++j) xn[j] = xr[64 * j]; }
        float s = 0.f;
#pragma unroll
        for (int j = 0; j < 4; ++j) s += (v[j].x * v[j].x + v[j].y * v[j].y) + (v[j].z * v[j].z + v[j].w * v[j].w);
        const float rstd = __builtin_amdgcn_rsqf(wave_sum(s, lane) * (1.f / DM) + EPS);
#pragma unroll
        for (int j = 0; j < 4; ++j) v[j] = v[j] * rstd * sc[j] + sh[j];
        store_row_f8((unsigned char*)H + (size_t)m * DM, lane, v);
        if (ROUTER) {
            float a16[16];
            int lo4 = 4 * lane; asm volatile("" : "+v"(lo4));
#pragma unroll
            for (int e = 0; e < 16; ++e) { float acc = 0.f;
#pragma unroll
                for (int j = 0; j < 4; ++j) { const f32x4 r = *(const LAS f32x4*)(rwt + e * DM + 256 * j + lo4); acc += v[j][0] * r[0] + v[j][1] * r[1] + v[j][2] * r[2] + v[j][3] * r[3]; }
                a16[e] = acc; }
            float r8[8], r4[4], r2[2], r1;
#pragma unroll
            for (int q = 0; q < 8; ++q) { const float mine = b5 ? a16[8 + q] : a16[q], oth = b5 ? a16[q] : a16[8 + q]; r8[q] = mine + shx(oth, 32, lane); }
#pragma unroll
            for (int q = 0; q < 4; ++q) { const float mine = b4 ? r8[4 + q] : r8[q], oth = b4 ? r8[q] : r8[4 + q]; r4[q] = mine + shx(oth, 16, lane); }
#pragma unroll
            for (int q = 0; q < 2; ++q) { const float mine = b3 ? r4[2 + q] : r4[q], oth = b3 ? r4[q] : r4[2 + q]; r2[q] = mine + shx(oth, 8, lane); }
            { const float mine = b2 ? r2[1] : r2[0], oth = b2 ? r2[0] : r2[1]; r1 = mine + shx(oth, 4, lane); }
            r1 += shx(r1, 2, lane); r1 += shx(r1, 1, lane);
            float lg[16];
#pragma unroll
            for (int e = 0; e < 16; ++e) lg[e] = __builtin_bit_cast(float, __builtin_amdgcn_readlane(__builtin_bit_cast(int, r1), 32 * ((e >> 3) & 1) + 16 * ((e >> 2) & 1) + 8 * ((e >> 1) & 1) + 4 * (e & 1)));
            float scv[16], sel[16];
#pragma unroll
            for (int e = 0; e < 16; ++e) { scv[e] = fsigmoid(lg[e]); sel[e] = scv[e] + A.router_bias[e]; }
            int bg = 0, bi1 = 0, bi2 = 1; float bgs = -1e30f, bw1 = 0.f, bw2 = 0.f;
#pragma unroll
            for (int g = 0; g < 4; ++g) { int i1 = 0; float s1 = sel[g * 4], w1 = scv[g * 4];
#pragma unroll
                for (int i = 1; i < 4; ++i) { const float sv = sel[g * 4 + i]; if (sv > s1) { s1 = sv; i1 = i; w1 = scv[g * 4 + i]; } }
                int i2 = -1; float s2 = -1e30f, w2 = 0.f;
#pragma unroll
                for (int i = 0; i < 4; ++i) { const float sv = sel[g * 4 + i]; if (i != i1 && sv > s2) { s2 = sv; i2 = i; w2 = scv[g * 4 + i]; } }
                const float gs = s1 + s2; if (gs > bgs) { bgs = gs; bg = g; bi1 = i1; bi2 = i2; bw1 = w1; bw2 = w2; } }
            const int ia = bi1 < bi2 ? bi1 : bi2, ib = bi1 < bi2 ? bi2 : bi1;
            const float wa0 = bi1 < bi2 ? bw1 : bw2, wb0 = bi1 < bi2 ? bw2 : bw1, inv = 1.0f / (wa0 + wb0);
            const int pidx = (ia == 0) ? (ib - 1) : (ia == 1 ? ib + 1 : 5);
            const int pair = bg * 6 + pidx;
            if (lane == 0) { float* tokw = (float*)(A.ws + WS_TOKW); tokw[2 * m] = wa0 * inv; tokw[2 * m + 1] = wb0 * inv; rowpair[F.wave * 8 + k] = pair; }
        }
    }
    if (ROUTER) {
        int* list = (int*)(A.ws + WS_LIST); unsigned* cnt = (unsigned*)(A.ws + WS_CTL) + CW_CNT + 64 * l;
        LAS int* base = rowpair + 64;
        __syncthreads();
        if (F.tid < 24) { int c = 0;
#pragma unroll 8
            for (int r = 0; r < 64; ++r) c += (rowpair[r] == F.tid) ? 1 : 0;
            base[F.tid] = c ? (int)atomicAdd(cnt + F.tid, (unsigned)c) : 0; }
        __syncthreads();
        if (F.tid < 64) { const int p = rowpair[F.tid]; int rank = 0;
#pragma unroll 8
            for (int r = 0; r < 64; ++r) rank += (r < F.tid && rowpair[r] == p) ? 1 : 0;
            const int w = F.tid >> 3, k = F.tid & 7; const int gwv = F.vcu * 8 + w; const int m = (gwv >> 8) * 2048 + (gwv & 255) + 256 * k;
            list[p * 16384 + base[p] + rank] = m; }
        __syncthreads();
    }
}
__device__ __forceinline__ void norm_router_phase(const Frame& F0, int l) {
    const Args A = load_args(); const Frame F = fresh(F0); asm volatile("" : "+s"(l));
    bf16_t* H = (bf16_t*)(A.ws + WS_H); const float* mod = (const float*)(A.ws + WS_MOD) + (size_t)l * 8 * 6144;
    const float* xin = A.out; const float* gain = A.norm_ffn + l * DM;
    const int lane = F.lane, w = F.wave, gw = F.vcu * 8 + w, b = gw >> 8, r0 = gw & 255;
    constexpr int XST = 4112, PART_OFF = 66048, LOG_OFF = 74240, RP_OFF = 78336;
    LAS unsigned char* lds = F.lds;
    LAS int* rowpair = (LAS int*)(lds + RP_OFF);
    bf16x8 wh[4], wl[4];
    { const int e = lane & 15, kg = lane >> 4;
#pragma unroll
      for (int ks = 0; ks < 4; ++ks) { float wv[8];
#pragma unroll
          for (int i = 0; i < 8; ++i) wv[i] = A.router_w[(size_t)(128 * w + 32 * ks + 8 * kg + i) * 16 + e];
          u32x4 hh, ll;
#pragma unroll
          for (int i = 0; i < 4; ++i) { const unsigned hp = pg8::cvt_pk_bf16(wv[2 * i], wv[2 * i + 1]); hh[i] = hp; ll[i] = pg8::cvt_pk_bf16(wv[2 * i] - bflo(hp), wv[2 * i + 1] - bfhi(hp)); }
          wh[ks] = __builtin_bit_cast(bf16x8, hh); wl[ks] = __builtin_bit_cast(bf16x8, ll); } }
    f32x4 sc[4], sh[4];
    { const float* pm = mod + b * 6144 + 3072;
#pragma unroll
      for (int j = 0; j < 4; ++j) { const f32x4 gg = ((const GAS f32x4*)gain)[lane + 64 * j], s1 = ((const GAS f32x4*)(pm + 1024))[lane + 64 * j]; sh[j] = ((const GAS f32x4*)pm)[lane + 64 * j]; sc[j] = gg * (s1 + 1.0f); } }
    f32x4 xn[2][4];
#pragma unroll
    for (int kk = 0; kk < 2; ++kk) { const GAS f32x4* xr = (const GAS f32x4*)(xin + (size_t)(b * 2048 + r0 + 256 * kk) * DM) + lane;
#pragma unroll
        for (int j = 0; j < 4; ++j) xn[kk][j] = xr[64 * j]; }
#pragma unroll 1
    for (int sb = 0; sb < 4; ++sb) {
        f32x4 v[2][4];
#pragma unroll
        for (int kk = 0; kk < 2; ++kk)
#pragma unroll
            for (int j = 0; j < 4; ++j) v[kk][j] = xn[kk][j];
        if (sb + 1 < 4) {
#pragma unroll
            for (int kk = 0; kk < 2; ++kk) { const GAS f32x4* xr = (const GAS f32x4*)(xin + (size_t)(b * 2048 + r0 + 256 * (2 * sb + 2 + kk)) * DM) + lane;
#pragma unroll
                for (int j = 0; j < 4; ++j) xn[kk][j] = xr[64 * j]; } }
#pragma unroll
        for (int kk = 0; kk < 2; ++kk) {
            const int m = b * 2048 + r0 + 256 * (2 * sb + kk);
            float s = 0.f;
#pragma unroll
            for (int j = 0; j < 4; ++j) s += (v[kk][j].x * v[kk][j].x + v[kk][j].y * v[kk][j].y) + (v[kk][j].z * v[kk][j].z + v[kk][j].w * v[kk][j].w);
            const float rstd = __builtin_amdgcn_rsqf(wave_sum(s, lane) * (1.f / DM) + EPS);
#pragma unroll
            for (int j = 0; j < 4; ++j) v[kk][j] = v[kk][j] * rstd * sc[j] + sh[j];
            store_row_f8((unsigned char*)H + (size_t)m * DM, lane, v[kk]);
            LAS unsigned char* xrow = lds + (2 * w + kk) * XST + lane * 8;
#pragma unroll
            for (int j = 0; j < 4; ++j) { const unsigned h0 = pg8::cvt_pk_bf16(v[kk][j][0], v[kk][j][1]), h1 = pg8::cvt_pk_bf16(v[kk][j][2], v[kk][j][3]);
                const unsigned l0 = pg8::cvt_pk_bf16(v[kk][j][0] - bflo(h0), v[kk][j][1] - bfhi(h0)), l1 = pg8::cvt_pk_bf16(v[kk][j][2] - bflo(h1), v[kk][j][3] - bfhi(h1));
                *(LAS u32x2*)(xrow + 512 * j) = (u32x2){h0, h1}; *(LAS u32x2*)(xrow + 2048 + 512 * j) = (u32x2){l0, l1}; }
        }
        __syncthreads();
        { const int tok = lane & 15, kg = lane >> 4; f32x4 acc = {0.f, 0.f, 0.f, 0.f};
          const LAS unsigned char* xb = lds + tok * XST + (128 * w + 8 * kg) * 2;
#pragma unroll
          for (int ks = 0; ks < 4; ++ks) { const bf16x8 bh = *(const LAS bf16x8*)(xb + 64 * ks), bl = *(const LAS bf16x8*)(xb + 2048 + 64 * ks);
              acc = __builtin_amdgcn_mfma_f32_16x16x32_bf16(wh[ks], bh, acc, 0, 0, 0);
              acc = __builtin_amdgcn_mfma_f32_16x16x32_bf16(wl[ks], bh, acc, 0, 0, 0);
              acc = __builtin_amdgcn_mfma_f32_16x16x32_bf16(wh[ks], bl, acc, 0, 0, 0); }
          *(LAS f32x4*)(lds + PART_OFF + ((w * 16 + tok) * 16 + 4 * kg) * 4) = acc; }
        __syncthreads();
        if (F.tid < 256) { const int tok = F.tid >> 4, e = F.tid & 15; float sum = 0.f;
#pragma unroll
            for (int ww = 0; ww < 8; ++ww) sum += *(const LAS float*)(lds + PART_OFF + ((ww * 16 + tok) * 16 + e) * 4);
            *(LAS float*)(lds + LOG_OFF + (((tok >> 1) * 8 + 2 * sb + (tok & 1)) * 16 + e) * 4) = sum; }
    }
    __syncthreads();
    if (F.tid < 64) {
        float lg[16];
#pragma unroll
        for (int q = 0; q < 4; ++q) { const f32x4 t4 = *(const LAS f32x4*)(lds + LOG_OFF + (F.tid * 16 + 4 * q) * 4); lg[4 * q] = t4[0]; lg[4 * q + 1] = t4[1]; lg[4 * q + 2] = t4[2]; lg[4 * q + 3] = t4[3]; }
        float scv[16], sel[16];
#pragma unroll
        for (int e = 0; e < 16; ++e) { scv[e] = fsigmoid(lg[e]); sel[e] = scv[e] + A.router_bias[e]; }
        int bg = 0, bi1 = 0, bi2 = 1; float bgs = -1e30f, bw1 = 0.f, bw2 = 0.f;
#pragma unroll
        for (int g = 0; g < 4; ++g) { int i1 = 0; float s1 = sel[g * 4], w1 = scv[g * 4];
#pragma unroll
            for (int i = 1; i < 4; ++i) { const float sv = sel[g * 4 + i]; if (sv > s1) { s1 = sv; i1 = i; w1 = scv[g * 4 + i]; } }
            int i2 = -1; float s2 = -1e30f, w2 = 0.f;
#pragma unroll
            for (int i = 0; i < 4; ++i) { const float sv = sel[g * 4 + i]; if (i != i1 && sv > s2) { s2 = sv; i2 = i; w2 = scv[g * 4 + i]; } }
            const float gs = s1 + s2; if (gs > bgs) { bgs = gs; bg = g; bi1 = i1; bi2 = i2; bw1 = w1; bw2 = w2; } }
        const int ia = bi1 < bi2 ? bi1 : bi2, ib = bi1 < bi2 ? bi2 : bi1;
        const float wa0 = bi1 < bi2 ? bw1 : bw2, wb0 = bi1 < bi2 ? bw2 : bw1, inv = 1.0f / (wa0 + wb0);
        const int pidx = (ia == 0) ? (ib - 1) : (ia == 1 ? ib + 1 : 5);
        const int pair = bg * 6 + pidx;
        const int wv_ = F.tid >> 3, k = F.tid & 7; const int gwv = F.vcu * 8 + wv_; const int m = (gwv >> 8) * 2048 + (gwv & 255) + 256 * k;
        float* tokw = (float*)(A.ws + WS_TOKW); tokw[2 * m] = wa0 * inv; tokw[2 * m + 1] = wb0 * inv; rowpair[F.tid] = pair;
    }
    {
        int* list = (int*)(A.ws + WS_LIST); unsigned* cnt = (unsigned*)(A.ws + WS_CTL) + CW_CNT + 64 * l;
        LAS int* base = rowpair + 64;
        __syncthreads();
        if (F.tid < 24) { int c = 0;
#pragma unroll 8
            for (int r = 0; r < 64; ++r) c += (rowpair[r] == F.tid) ? 1 : 0;
            base[F.tid] = c ? (int)atomicAdd(cnt + F.tid, (unsigned)c) : 0; }
        __syncthreads();
        if (F.tid < 64) { const int p = rowpair[F.tid]; int rank = 0;
#pragma unroll 8
            for (int r = 0; r < 64; ++r) rank += (r < F.tid && rowpair[r] == p) ? 1 : 0;
            const int wv_ = F.tid >> 3, k = F.tid & 7; const int gwv = F.vcu * 8 + wv_; const int m = (gwv >> 8) * 2048 + (gwv & 255) + 256 * k;
            list[p * 16384 + base[p] + rank] = m; }
        __syncthreads();
    }
}
__device__ __forceinline__ void pair_experts(int pair, int& ea, int& eb) { const int g = pair / 6, pi = pair % 6;
    const int ia = pi < 3 ? 0 : (pi < 5 ? 1 : 2); const int ib = pi < 3 ? pi + 1 : (pi < 5 ? pi - 1 : 3); ea = g * 4 + ia; eb = g * 4 + ib; }

template <int NT>
__device__ __forceinline__ void stage_store_rows(LAS unsigned char* stg, const f32x16* v, bf16_t* gbase, int gstride, int lane) {
    const int r32 = lane & 31, hi = lane >> 5;
#pragma unroll
    for (int nt = 0; nt < NT; ++nt)
#pragma unroll
        for (int g = 0; g < 4; ++g) { u32x2 o; o.x = pk2(v[nt][4 * g], v[nt][4 * g + 1]); o.y = pk2(v[nt][4 * g + 2], v[nt][4 * g + 3]);
            *(LAS u32x2*)(stg + r32 * 208 + (nt * 32 + 8 * g + 4 * hi) * 2) = o; }
    LDS_WAIT(); asm volatile("" ::: "memory");
    constexpr int CPR = NT * 4;
#pragma unroll
    for (int i = 0; i < (32 * CPR) / 64; ++i) { const int c = lane + 64 * i, tok = c / CPR, part = c % CPR;
        const u32x4 d = *(const LAS u32x4*)(stg + tok * 208 + part * 16);
        *(u32x4*)(gbase + (size_t)tok * gstride + part * 8) = d; }
    LDS_WAIT(); asm volatile("" ::: "memory");
}
__device__ __forceinline__ void mla_prep_unit(const Frame& F0, int l, int unit) {
    const Args A = load_args(); const Frame F = fresh(F0); asm volatile("" : "+s"(l));
    const int tid = F.tid, lane = F.lane, w = F.wave, r32 = lane & 31, hi = lane >> 5;
    LAS unsigned char* lds = F.lds;
    constexpr int XQ_OFF = 0, XQ_ST = 272, XKV_OFF = 64 * 272, XKV_ST = 144, XR_OFF = XKV_OFF + 64 * 144, STG_OFF = 65536; constexpr float X8_SCALE = 8.f, XW_INV = 1.f / (8.f * W8_SCALE);
    const bf16_t* proj = (const bf16_t*)(A.ws + WS_PROJ);
    const int m0 = unit * 64;
    { const int t = tid >> 3, part = tid & 7; const bf16_t* row = proj + (size_t)(m0 + t) * NPROJ;
      u32x4 cq[4], ck[2];
#pragma unroll
      for (int i = 0; i < 4; ++i) cq[i] = *(const u32x4*)(row + PC_CQ + part * 32 + i * 8);
#pragma unroll
      for (int i = 0; i < 2; ++i) ck[i] = *(const u32x4*)(row + PC_CKV + part * 16 + i * 8);
      const u32x2 kr = *(const u32x2*)(row + PC_KR + part * 4);
      float sq = 0.f, sk = 0.f;
#pragma unroll
      for (int i = 0; i < 4; ++i)
#pragma unroll
          for (int j = 0; j < 4; ++j) { const float a = bflo(cq[i][j]), b = bfhi(cq[i][j]); sq += a * a + b * b; }
#pragma unroll
      for (int i = 0; i < 2; ++i)
#pragma unroll
          for (int j = 0; j < 4; ++j) { const float a = bflo(ck[i][j]), b = bfhi(ck[i][j]); sk += a * a + b * b; }
      sq += shx(sq, 1, lane); sq += shx(sq, 2, lane); sq += shx(sq, 4, lane);
      sk += shx(sk, 1, lane); sk += shx(sk, 2, lane); sk += shx(sk, 4, lane);
      const float rq = __builtin_amdgcn_rsqf(sq * (1.f / 256.f) + EPS), rk = __builtin_amdgcn_rsqf(sk * (1.f / 128.f) + EPS);
      const float* gq = A.mla_q_norm + l * 256 + part * 32; const float* gkv = A.mla_kv_norm + l * 128 + part * 16;
      const float rq8 = rq * X8_SCALE, rk8 = rk * X8_SCALE;
#pragma unroll
      for (int i2 = 0; i2 < 2; ++i2) { u32x4 o;
#pragma unroll
          for (int q = 0; q < 4; ++q) { const int i = i2 * 2 + (q >> 1), j = (q & 1) * 2;
              o[q] = pk4f8(bflo(cq[i][j]) * rq8 * gq[i * 8 + 2 * j], bfhi(cq[i][j]) * rq8 * gq[i * 8 + 2 * j + 1], bflo(cq[i][j + 1]) * rq8 * gq[i * 8 + 2 * j + 2], bfhi(cq[i][j + 1]) * rq8 * gq[i * 8 + 2 * j + 3]); }
          *(LAS u32x4*)(lds + XQ_OFF + t * XQ_ST + part * 32 + i2 * 16) = o; }
      { u32x4 o;
#pragma unroll
          for (int q = 0; q < 4; ++q) { const int i = q >> 1, j = (q & 1) * 2;
              o[q] = pk4f8(bflo(ck[i][j]) * rk8 * gkv[i * 8 + 2 * j], bfhi(ck[i][j]) * rk8 * gkv[i * 8 + 2 * j + 1], bflo(ck[i][j + 1]) * rk8 * gkv[i * 8 + 2 * j + 2], bfhi(ck[i][j + 1]) * rk8 * gkv[i * 8 + 2 * j + 3]); }
          *(LAS u32x4*)(lds + XKV_OFF + t * XKV_ST + part * 16) = o; }
      *(LAS f32x4*)(lds + XR_OFF + (t * 32 + part * 4) * 4) = (f32x4){bflo(kr.x), bfhi(kr.x), bflo(kr.y), bfhi(kr.y)}; }
    __syncthreads();
    const i32x8* UQF = (const i32x8*)(A.ws + WS_UQT); const i32x8* UKVF = (const i32x8*)(A.ws + WS_UKVT);
    const float* rope = (const float*)(A.ws + WS_ROPE);
    bf16_t* MQ = (bf16_t*)(A.ws + WS_MLAQ); bf16_t* MK = (bf16_t*)(A.ws + WS_MLAK); bf16_t* MV = (bf16_t*)(A.ws + WS_MLAV);
    const float* gqk = A.mla_qk_norm + l * 192;
    const int h = w;
    {
        f32x16 acc[3][2];
#pragma unroll
        for (int nt = 0; nt < 3; ++nt) { acc[nt][0] = (f32x16){0}; acc[nt][1] = (f32x16){0}; asm volatile("" : "+v"(acc[nt][0]), "+v"(acc[nt][1])); }
        const int rot = F.vcu;
        i32x8 wq[2][3];
#pragma unroll
        for (int nt = 0; nt < 3; ++nt) wq[0][nt] = UQF[((h * 3 + nt) * 4 + (rot & 3)) * 64 + lane];
#pragma unroll
        for (int k_ = 0; k_ < 4; ++k_) { const int ks = (k_ + rot) & 3;
            if (k_ < 3) {
#pragma unroll
                for (int nt = 0; nt < 3; ++nt) wq[(k_ + 1) & 1][nt] = UQF[((h * 3 + nt) * 4 + ((k_ + 1 + rot) & 3)) * 64 + lane]; }
            __builtin_amdgcn_sched_barrier(0);
            const LAS u32x4* p0 = (const LAS u32x4*)(lds + XQ_OFF + r32 * XQ_ST + ks * 64 + hi * 32); const LAS u32x4* p1 = (const LAS u32x4*)(lds + XQ_OFF + (32 + r32) * XQ_ST + ks * 64 + hi * 32);
            const u32x4 a0 = p0[0], a1 = p0[1], b0 = p1[0], b1 = p1[1];
            const i32x8 x0 = {(int)a0.x, (int)a0.y, (int)a0.z, (int)a0.w, (int)a1.x, (int)a1.y, (int)a1.z, (int)a1.w}, x1 = {(int)b0.x, (int)b0.y, (int)b0.z, (int)b0.w, (int)b1.x, (int)b1.y, (int)b1.z, (int)b1.w};
#pragma unroll
            for (int nt = 0; nt < 3; ++nt) { const i32x8 wf = wq[k_ & 1][nt];
                asm volatile("v_mfma_f32_32x32x64_f8f6f4 %0, %1, %2, %0" : "+v"(acc[nt][0]) : "v"(wf), "v"(x0));
                asm volatile("v_mfma_f32_32x32x64_f8f6f4 %0, %1, %2, %0" : "+v"(acc[nt][1]) : "v"(wf), "v"(x1)); }
            __builtin_amdgcn_sched_barrier(0);
        }
        asm volatile("s_nop 15\n\ts_nop 15" : "+v"(acc[0][0]), "+v"(acc[0][1]), "+v"(acc[1][0]), "+v"(acc[1][1]), "+v"(acc[2][0]), "+v"(acc[2][1]));
#pragma unroll
        for (int tb = 0; tb < 2; ++tb) {
            const int m = m0 + tb * 32 + r32;
            float ss = 0.f;
#pragma unroll
            for (int nt = 0; nt < 3; ++nt)
#pragma unroll
                for (int r = 0; r < 16; ++r) ss += acc[nt][tb][r] * acc[nt][tb][r];
            ss += shx(ss, 32, lane);
            const float rstd = __builtin_amdgcn_rsqf(ss * (XW_INV * XW_INV / 96.f) + EPS) * XW_INV;
#pragma unroll
            for (int nt = 0; nt < 3; ++nt)
#pragma unroll
                for (int r = 0; r < 16; ++r) acc[nt][tb][r] = acc[nt][tb][r] * rstd * gqk[nt * 32 + crow(r, hi)];
#pragma unroll
            for (int r = 0; r < 8; ++r) { const int i = crow(r, hi); const float cs = rope[m * 32 + i], sn = rope[m * 32 + 16 + i];
                const float x1 = acc[2][tb][r], x2 = acc[2][tb][r + 8]; acc[2][tb][r] = x1 * cs - x2 * sn; acc[2][tb][r + 8] = x1 * sn + x2 * cs; }
            { f32x16 t3[3] = {acc[0][tb], acc[1][tb], acc[2][tb]}; stage_store_rows<3>(lds + STG_OFF + w * 6656, t3, MQ + (size_t)(m0 + tb * 32) * 768 + h * 96, 768, lane); }
        }
    }
    __builtin_amdgcn_sched_barrier(0);
    {
        f32x16 acc[4][2];
        const int rot = F.vcu;
        int lk = lane; asm volatile("" : "+v"(lk)); const int r32k = lk & 31, hik = lk >> 5;
        i32x8 wk[2][4];
#pragma unroll
        for (int k_ = 0; k_ < 2; ++k_)
#pragma unroll
            for (int nt = 0; nt < 2; ++nt) wk[k_][nt] = UKVF[((h * 4 + nt) * 2 + ((k_ + rot) & 1)) * 64 + lane];
        __builtin_amdgcn_sched_barrier(0);
#pragma unroll
        for (int half = 0; half < 2; ++half) {
#pragma unroll
        for (int nt = 2 * half; nt < 2 * half + 2; ++nt) { acc[nt][0] = (f32x16){0}; acc[nt][1] = (f32x16){0}; asm volatile("s_nop 3" : "+v"(acc[nt][0]), "+v"(acc[nt][1])); }
#pragma unroll
        for (int k_ = 0; k_ < 2; ++k_) { const int ks = (k_ + rot) & 1;
            const LAS u32x4* p0 = (const LAS u32x4*)(lds + XKV_OFF + r32 * XKV_ST + ks * 64 + hi * 32); const LAS u32x4* p1 = (const LAS u32x4*)(lds + XKV_OFF + (32 + r32) * XKV_ST + ks * 64 + hi * 32);
            const u32x4 a0 = p0[0], a1 = p0[1], b0 = p1[0], b1 = p1[1];
            const i32x8 x0 = {(int)a0.x, (int)a0.y, (int)a0.z, (int)a0.w, (int)a1.x, (int)a1.y, (int)a1.z, (int)a1.w}, x1 = {(int)b0.x, (int)b0.y, (int)b0.z, (int)b0.w, (int)b1.x, (int)b1.y, (int)b1.z, (int)b1.w};
#pragma unroll
            for (int nt = 2 * half; nt < 2 * half + 2; ++nt) { const i32x8 wf = wk[k_][nt];
                asm volatile("v_mfma_f32_32x32x64_f8f6f4 %0, %1, %2, %0" : "+v"(acc[nt][0]) : "v"(wf), "v"(x0));
                asm volatile("v_mfma_f32_32x32x64_f8f6f4 %0, %1, %2, %0" : "+v"(acc[nt][1]) : "v"(wf), "v"(x1)); }
            if (half == 0 && k_ == 0) {
#pragma unroll
                for (int k2 = 0; k2 < 2; ++k2)
#pragma unroll
                    for (int nt = 2; nt < 4; ++nt) wk[k2][nt] = UKVF[((h * 4 + nt) * 2 + ((k2 + rot) & 1)) * 64 + lane]; }
            __builtin_amdgcn_sched_barrier(0);
        }
        }
        asm volatile("s_nop 15\n\ts_nop 15" : "+v"(acc[0][0]), "+v"(acc[0][1]), "+v"(acc[1][0]), "+v"(acc[1][1]), "+v"(acc[2][0]), "+v"(acc[2][1]), "+v"(acc[3][0]), "+v"(acc[3][1]));
#pragma unroll
        for (int nt = 0; nt < 4; ++nt)
#pragma unroll
            for (int r = 0; r < 16; ++r) { acc[nt][0][r] *= XW_INV; acc[nt][1][r] *= XW_INV; }
#pragma unroll
        for (int tb = 0; tb < 2; ++tb) { f32x16 t2[2] = {acc[2][tb], acc[3][tb]}; stage_store_rows<2>(lds + STG_OFF + w * 6656, t2, MV + (size_t)(m0 + tb * 32) * 512 + h * 64, 512, lk); }
        __builtin_amdgcn_sched_barrier(0);
#pragma unroll
        for (int tb = 0; tb < 2; ++tb) {
            const int m = m0 + tb * 32 + r32k, tl = tb * 32 + r32k;
            f32x16 kr;
#pragma unroll
            for (int r = 0; r < 16; ++r) kr[r] = *(const LAS float*)(lds + XR_OFF + (tl * 32 + crow(r, hik)) * 4);
            float ss = 0.f;
#pragma unroll
            for (int nt = 0; nt < 2; ++nt)
#pragma unroll
                for (int r = 0; r < 16; ++r) ss += acc[nt][tb][r] * acc[nt][tb][r];
#pragma unroll
            for (int r = 0; r < 16; ++r) ss += kr[r] * kr[r];
            ss += shx(ss, 32, lane);
            const float rstd = __builtin_amdgcn_rsqf(ss * (1.f / 96.f) + EPS);
#pragma unroll
            for (int nt = 0; nt < 2; ++nt)
#pragma unroll
                for (int r = 0; r < 16; ++r) acc[nt][tb][r] = acc[nt][tb][r] * rstd * gqk[96 + nt * 32 + crow(r, hik)];
#pragma unroll
            for (int r = 0; r < 16; ++r) kr[r] = kr[r] * rstd * gqk[96 + 64 + crow(r, hik)];
#pragma unroll
            for (int r = 0; r < 8; ++r) { const int i = crow(r, hik); const float cs = rope[m * 32 + i], sn = rope[m * 32 + 16 + i];
                const float x1 = kr[r], x2 = kr[r + 8]; kr[r] = x1 * cs - x2 * sn; kr[r + 8] = x1 * sn + x2 * cs; }
            { f32x16 t3[3] = {acc[0][tb], acc[1][tb], kr}; stage_store_rows<3>(lds + STG_OFF + w * 6656, t3, MK + (size_t)(m0 + tb * 32) * 768 + h * 96, 768, lk); }
        }
    }
    __syncthreads();
}

struct AttnWaveCfg {
    const bf16_t* q; int qstride;
    int qpos0;
    int kc0;
};
__device__ __forceinline__ void glds16(const void* gsrc, unsigned lds_dst) { unsigned keep;
    asm volatile("s_mov_b32 %0, m0\n\ts_mov_b32 m0, %2\n\ts_nop 0\n\tglobal_load_lds_dwordx4 %1, off\n\ts_mov_b32 m0, %0" : "=&s"(keep) : "v"(gsrc), "s"(lds_dst) : "memory"); }
__device__ __forceinline__ unsigned cvtpk(float lo, float hi) { f32x2_t v = {lo, hi}; bf16x2_t b = __builtin_convertvector(v, bf16x2_t); return __builtin_bit_cast(unsigned, b); }
__device__ __forceinline__ float xmax32(float x) { float a = x, b = x; asm volatile("s_nop 1\n\tv_permlane32_swap_b32 %0, %1" : "+v"(a), "+v"(b)); return fmaxf(a, b); }
#ifndef ATT_THR
#define ATT_THR 8.0f
#endif
#define ATT_WAITBAR(N) asm volatile("s_waitcnt vmcnt(" #N ") lgkmcnt(0)\n\ts_barrier" ::: "memory")
template <int DQK, int DV, int KL, bool NORMQ, int WINDOW, int VPRE>
struct AttnBody {
    static constexpr int NKP = (KL == 0) ? 8 : (KL == 1 ? 16 : 12), NVP = DV / 8;
    static constexpr int KBYTES = NKP * 1024, SLOT = KBYTES + NVP * 1024, NS = 3;
    static constexpr int PT = (KL == 0) ? 2 : (KL == 1 ? 4 : 3);
    static constexpr int SCR_OFF = NS * SLOT;
    static constexpr int NKS = DQK / 16, ND0 = DV / 32;
    __device__ static __forceinline__ void run(const Frame& F, const AttnWaveCfg& W, const bf16_t* Kg, int kstride, const bf16_t* Vg, int vstride,
                                               int kt_lo, int kt_hi, float c2, const float* gq, bool use_sink, float sink_l2, f32x16 (&o)[ND0]) {
        const int lane = F.lane, r32 = lane & 31, hi = lane >> 5, w = F.wave;
        LAS unsigned char* lds = F.lds;
        const unsigned lds0 = (unsigned)(size_t)lds;
        LAS float* wsf = (LAS float*)(lds + SCR_OFF + w * 256);
        const bf16_t* ksrc0; const bf16_t* ksrc1 = nullptr; const bf16_t* vsrc0; const bf16_t* vsrc1 = nullptr; unsigned kd0, kd1 = 0, vd0, vd1 = 0;
        if (KL == 0) { const int row = 8 * w + (lane >> 3), c = (lane & 7) ^ ((row >> 1) & 7); ksrc0 = Kg + (size_t)row * kstride + c * 8; kd0 = w * 1024; }
        else if (KL == 1) { const int p0 = 2 * w, row0 = 4 * p0 + (lane >> 4), row1 = row0 + 4; ksrc0 = Kg + (size_t)row0 * kstride + ((lane & 15) ^ (row0 & 15)) * 8; ksrc1 = Kg + (size_t)row1 * kstride + ((lane & 15) ^ (row1 & 15)) * 8;
            kd0 = p0 * 1024; kd1 = kd0 + 1024; }
        else { const int row = 8 * w + (lane >> 3), c = (lane & 7) ^ ((row >> 1) & 7); ksrc0 = Kg + (size_t)row * kstride + c * 8; kd0 = w * 1024;
            const int p = w & 3, rr = 16 * p + (lane >> 2), cr = (lane & 3) ^ ((rr >> 2) & 3); ksrc1 = Kg + (size_t)rr * kstride + 64 + cr * 8; kd1 = 8192 + p * 1024; }
        if (DV == 64) { vsrc0 = Vg + (size_t)(16 * (w & 3) + (lane >> 2)) * vstride + (w >> 2) * 32 + (lane & 3) * 8; vd0 = KBYTES + w * 1024; }
        else { const int p0 = 2 * w, p1 = p0 + 1; vsrc0 = Vg + (size_t)(16 * (p0 & 3) + (lane >> 2)) * vstride + (p0 >> 2) * 32 + (lane & 3) * 8; vsrc1 = Vg + (size_t)(16 * (p1 & 3) + (lane >> 2)) * vstride + (p1 >> 2) * 32 + (lane & 3) * 8;
            vd0 = KBYTES + p0 * 1024; vd1 = vd0 + 1024; }
        auto dma_tile = [&](int kt, int slot) {
            const size_t ko = (size_t)kt * 64 * kstride, vo = (size_t)kt * 64 * vstride; const unsigned sb = lds0 + (unsigned)slot * SLOT;
            glds16(ksrc0 + ko, (unsigned)__builtin_amdgcn_readfirstlane(sb + kd0));
            if (KL != 0) glds16(ksrc1 + ko, (unsigned)__builtin_amdgcn_readfirstlane(sb + kd1));
            glds16(vsrc0 + vo, (unsigned)__builtin_amdgcn_readfirstlane(sb + vd0));
            if (DV == 128) glds16(vsrc1 + vo, (unsigned)__builtin_amdgcn_readfirstlane(sb + vd1));
        };
        dma_tile(kt_lo, 0);
        if (kt_lo + 1 < kt_hi) dma_tile(kt_lo + 1, 1);
        bf16x8 qf[NKS];
        {
            float ss = 0.f; u32x4 raw[NKS];
#pragma unroll
            for (int ks = 0; ks < NKS; ++ks) { raw[ks] = *(const u32x4*)(W.q + (size_t)r32 * W.qstride + ks * 16 + hi * 8);
#pragma unroll
                for (int j = 0; j < 4; ++j) { const float a = bflo(raw[ks][j]), b = bfhi(raw[ks][j]); ss += a * a + b * b; } }
            float rs = c2;
            if (NORMQ) { ss += shx(ss, 32, lane); rs = __builtin_amdgcn_rsqf(ss * (1.f / DQK) + EPS) * c2; }
#pragma unroll
            for (int ks = 0; ks < NKS; ++ks) { u32x4 p;
#pragma unroll
                for (int j = 0; j < 4; ++j) { float a = bflo(raw[ks][j]) * rs, b = bfhi(raw[ks][j]) * rs; if (NORMQ) { a *= gq[ks * 16 + hi * 8 + 2 * j]; b *= gq[ks * 16 + hi * 8 + 2 * j + 1]; } p[j] = cvtpk(a, b); }
                qf[ks] = __builtin_bit_cast(bf16x8, p); }
        }
#pragma unroll
        for (int d = 0; d < ND0; ++d) o[d] = (f32x16){0};
        float m_run = -1e30f, l_run = 0.f;
        const int qlo = W.qpos0, qhi = W.qpos0 + 31;
        const int kx = (KL == 1) ? (r32 & 15) : ((r32 >> 1) & 7);
        const int krow = (KL == 1) ? r32 * 256 : r32 * 128;
        const int kxr = (r32 >> 2) & 3, krow_r = 8192 + r32 * 64;
        const int vlane = (4 * hi + ((lane & 15) >> 2)) * 64 + ((lane >> 4) & 1) * 32 + (lane & 3) * 8;
        int slot = 0;
        for (int kt = kt_lo; kt < kt_hi; ++kt) {
            if (kt + 1 < kt_hi) { if (PT == 2) { ATT_WAITBAR(2); } else if (PT == 3) { ATT_WAITBAR(3); } else { ATT_WAITBAR(4); }; } else { ATT_WAITBAR(0); }
            if (kt + 2 < kt_hi) dma_tile(kt + 2, slot >= 1 ? slot - 1 : 2);
            const int k0 = kt * 64;
            bool need = (k0 <= qhi);
            if (WINDOW > 0) need = need && (k0 + 63 >= qlo - (WINDOW - 1));
            if (need) {
                const LAS unsigned char* sb = lds + slot * SLOT;
                const bool unset = (m_run == -1e30f); const float minit = unset ? 0.f : -m_run;
                f32x16 p0, p1;
#pragma unroll
                for (int r = 0; r < 16; ++r) { p0[r] = minit; p1[r] = minit; }
                bf16x8 kfa[NKS], kfb[NKS];
#pragma unroll
                for (int ks = 0; ks < NKS; ++ks) {
                    const LAS unsigned char* ka;
                    if (KL == 2 && ks >= 4) ka = sb + krow_r + (((2 * (ks - 4) + hi) ^ kxr) << 4);
                    else ka = sb + krow + ((((KL == 1 ? W.kc0 : 0) + 2 * ks + hi) ^ kx) << 4);
                    const int hstep = (KL == 2 && ks >= 4) ? 32 * 64 : (KL == 1 ? 32 * 256 : 32 * 128);
                    kfa[ks] = *(const LAS bf16x8*)ka; kfb[ks] = *(const LAS bf16x8*)(ka + hstep); }
                __builtin_amdgcn_sched_barrier(0);
#pragma unroll
                for (int ks = 0; ks < NKS; ++ks) { p0 = __builtin_amdgcn_mfma_f32_32x32x16_bf16(kfa[ks], qf[ks], p0, 0, 0, 0); p1 = __builtin_amdgcn_mfma_f32_32x32x16_bf16(kfb[ks], qf[ks], p1, 0, 0, 0); }
                const LAS unsigned char* vb = sb + KBYTES + vlane;
                s16x4 vlo[VPRE > 0 ? VPRE : 1][4], vhi[VPRE > 0 ? VPRE : 1][4];
#pragma unroll
                for (int d = 0; d < VPRE; ++d)
#pragma unroll
                    for (int q4 = 0; q4 < 4; ++q4) { const LAS unsigned char* vp = vb + (d * 4 + q4) * 1024;
                        vlo[d][q4] = __builtin_bit_cast(s16x4, __builtin_amdgcn_ds_read_tr16_b64_v4i16((LAS s16x4*)vp));
                        vhi[d][q4] = __builtin_bit_cast(s16x4, __builtin_amdgcn_ds_read_tr16_b64_v4i16((LAS s16x4*)(vp + 512))); }
                const int qpos = W.qpos0 + r32;
                bool full = (k0 + 63 <= qlo);
                if (WINDOW > 0) full = full && (k0 >= qhi - (WINDOW - 1));
                if (!full) {
#pragma unroll
                    for (int r = 0; r < 16; ++r) { const int ka = k0 + crow(r, hi), kb2 = ka + 32;
                        bool va = ka <= qpos, vb2 = kb2 <= qpos; if (WINDOW > 0) { va = va && (qpos - ka < WINDOW); vb2 = vb2 && (qpos - kb2 < WINDOW); }
                        p0[r] = va ? p0[r] : -INFINITY; p1[r] = vb2 ? p1[r] : -INFINITY; }
                }
                float mx = fmaxf(p0[0], p1[0]), mxb;
#define ATT_MAX3(d, a, b, c) asm("v_max3_f32 %0, %1, %2, %3" : "=v"(d) : "v"(a), "v"(b), "v"(c))
#pragma unroll
                for (int r = 1; r < 8; ++r) ATT_MAX3(mx, mx, p0[r], p1[r]);
                ATT_MAX3(mxb, p0[8], p1[8], p0[9]); ATT_MAX3(mxb, mxb, p1[9], p0[10]); ATT_MAX3(mxb, mxb, p1[10], p0[11]); ATT_MAX3(mxb, mxb, p1[11], p0[12]);
                ATT_MAX3(mxb, mxb, p1[12], p0[13]); ATT_MAX3(mxb, mxb, p1[13], p0[14]); ATT_MAX3(mxb, mxb, p1[14], p0[15]); ATT_MAX3(mx, mx, mxb, p1[15]);
#undef ATT_MAX3
                mx = xmax32(mx);
                const bool grow = unset ? (mx > -INFINITY) : (mx > ATT_THR);
                if (__any(grow)) {
                    const float delta = unset ? ((mx > -INFINITY) ? mx : 0.f) : fmaxf(mx, 0.f);
                    const float alpha = unset ? 1.0f : __builtin_amdgcn_exp2f(-delta);
                    m_run = unset ? ((mx > -INFINITY) ? mx : -1e30f) : (m_run + delta); l_run *= alpha;
                    if (hi == 0) wsf[r32] = alpha;
                    LDS_WAIT();
#pragma unroll
                    for (int r = 0; r < 16; ++r) { const float a = wsf[crow(r, hi)]; p0[r] -= delta; p1[r] -= delta;
#pragma unroll
                        for (int d = 0; d < ND0; ++d) o[d][r] *= a; }
                }
                f32x2_t rs2 = {0.f, 0.f};
#pragma unroll
                for (int r = 0; r < 8; ++r) {
                    p0[2 * r] = __builtin_amdgcn_exp2f(p0[2 * r]); p0[2 * r + 1] = __builtin_amdgcn_exp2f(p0[2 * r + 1]);
                    p1[2 * r] = __builtin_amdgcn_exp2f(p1[2 * r]); p1[2 * r + 1] = __builtin_amdgcn_exp2f(p1[2 * r + 1]);
                    rs2 += (f32x2_t){p0[2 * r], p0[2 * r + 1]}; rs2 += (f32x2_t){p1[2 * r], p1[2 * r + 1]}; }
                const float rs = rs2.x + rs2.y;
                l_run += rs;
                bf16x8 pa[4];
#pragma unroll
                for (int s = 0; s < 2; ++s) { u32x4 pw;
                    pw.x = cvtpk(p0[8 * s], p0[8 * s + 1]); pw.y = cvtpk(p0[8 * s + 2], p0[8 * s + 3]); pw.z = cvtpk(p0[8 * s + 4], p0[8 * s + 5]); pw.w = cvtpk(p0[8 * s + 6], p0[8 * s + 7]); pa[s] = __builtin_bit_cast(bf16x8, pw);
                    pw.x = cvtpk(p1[8 * s], p1[8 * s + 1]); pw.y = cvtpk(p1[8 * s + 2], p1[8 * s + 3]); pw.z = cvtpk(p1[8 * s + 4], p1[8 * s + 5]); pw.w = cvtpk(p1[8 * s + 6], p1[8 * s + 7]); pa[2 + s] = __builtin_bit_cast(bf16x8, pw); }
#pragma unroll
                for (int d = 0; d < ND0; ++d)
#pragma unroll
                    for (int q4 = 0; q4 < 4; ++q4) {
                        s16x4 lo, hh;
                        if (d < VPRE) { lo = vlo[d][q4]; hh = vhi[d][q4]; }
                        else { const LAS unsigned char* vp = vb + (d * 4 + q4) * 1024;
                            lo = __builtin_bit_cast(s16x4, __builtin_amdgcn_ds_read_tr16_b64_v4i16((LAS s16x4*)vp));
                            hh = __builtin_bit_cast(s16x4, __builtin_amdgcn_ds_read_tr16_b64_v4i16((LAS s16x4*)(vp + 512))); }
                        const bf16x8 vf = (bf16x8){lo[0], lo[1], lo[2], lo[3], hh[0], hh[1], hh[2], hh[3]};
                        o[d] = __builtin_amdgcn_mfma_f32_32x32x16_bf16(pa[q4], vf, o[d], 0, 0, 0);
                    }
            }
            slot = (slot == 2) ? 0 : slot + 1;
        }
        l_run += shx(l_run, 32, lane);
        if (use_sink) l_run += __builtin_amdgcn_exp2f(sink_l2 - m_run);
        if (hi == 0) wsf[32 + r32] = __builtin_amdgcn_rcpf(l_run);
        LDS_WAIT();
#pragma unroll
        for (int r = 0; r < 16; ++r) { const float a = wsf[32 + crow(r, hi)];
#pragma unroll
            for (int d = 0; d < ND0; ++d) o[d][r] *= a; }
        ATT_WAITBAR(0);
    }
};
template <int ND0>
__device__ __forceinline__ void store_o_bf16(bf16_t* orow0, int ostride, int lane, const f32x16 (&o)[ND0]) {
    const int r32 = lane & 31, hi = lane >> 5;
#pragma unroll
    for (int r = 0; r < 16; ++r)
#pragma unroll
        for (int d = 0; d < ND0; ++d) orow0[(size_t)crow(r, hi) * ostride + d * 32 + r32] = (bf16_t)(pk2(o[d][r], 0.f) & 0xffffu);
}

template <int ND0>
__device__ __forceinline__ void store_o_f8(unsigned char* orow0, int ostride, int lane, const f32x16 (&o)[ND0]) {
    const int r32 = lane & 31, hi = lane >> 5;
#pragma unroll
    for (int r = 0; r < 16; ++r)
#pragma unroll
        for (int d = 0; d < ND0; ++d) orow0[(size_t)crow(r, hi) * ostride + d * 32 + r32] = (unsigned char)(pk4f8(o[d][r] * Y8_SCALE, 0.f, 0.f, 0.f) & 0xffu);
}
template <int ND0>
__device__ __forceinline__ void store_o_f8_lds(LAS unsigned char* scr, unsigned char* orow0, int ostride, int lane, const f32x16 (&o)[ND0]) {
    const int r32 = lane & 31, hi = lane >> 5; constexpr int RB = 32 * ND0;
#pragma unroll
    for (int r = 0; r < 16; ++r)
#pragma unroll
        for (int d = 0; d < ND0; ++d) scr[crow(r, hi) * RB + d * 32 + r32] = (unsigned char)(pk4f8(o[d][r] * Y8_SCALE, 0.f, 0.f, 0.f) & 0xffu);
    LDS_WAIT();
#pragma unroll
    for (int i = 0; i < ND0; ++i) { const int c = lane + 64 * i, row = c / (2 * ND0), c16 = c % (2 * ND0);
        const u32x4 v = *(const LAS u32x4*)(scr + row * RB + c16 * 16); *(u32x4*)(orow0 + (size_t)row * ostride + c16 * 16) = v; }
}
__device__ __forceinline__ void mla_attn_unit(const Frame& F0, int b, int h, int qb, bool dry) {
    const Args A = load_args(); const Frame F = fresh(F0);
    typedef AttnBody<96, 64, 2, false, 0, 2> AB;
    bf16_t* MQ = (bf16_t*)(A.ws + WS_MLAQ); const bf16_t* MK = (const bf16_t*)(A.ws + WS_MLAK); const bf16_t* MV = (const bf16_t*)(A.ws + WS_MLAV);
    const int q0 = qb * 256 + F.wave * 32; const size_t rb = (size_t)b * SEQ;
    AttnWaveCfg W; W.q = MQ + (rb + q0) * 768 + h * 96; W.qstride = 768; W.qpos0 = q0; W.kc0 = 0;
    f32x16 o[2];
    AB::run(F, W, MK + rb * 768 + h * 96, 768, MV + rb * 512 + h * 64, 512, 0, (qb * 256 + 256) / 64, 0.10206207261596575f * LOG2E, nullptr, false, 0.f, o);
    if (!dry) store_o_f8_lds<2>(F.lds + 2 * AB::SLOT + F.wave * 2048, (unsigned char*)(MQ + (rb + q0) * 768 + h * 96), 1536, F.lane, o);
}
__device__ __forceinline__ void swa_attn_unit(const Frame& F0, int l, int b, int kvh, int rb64, bool dry, bool alt = false) {
    const Args A = load_args(); const Frame F = fresh(F0); asm volatile("" : "+s"(l));
    typedef AttnBody<64, 64, 0, true, 128, 2> AB;
    bf16_t* proj = (bf16_t*)(A.ws + WS_PROJ);
    const int hq = kvh * 4 + (F.wave >> 1); const int q0 = rb64 * 64 + (F.wave & 1) * 32; const size_t rb = (size_t)b * SEQ;
    const int cq = alt ? PC_DQ : PC_SQ, ck = alt ? PC_DK : PC_SK, cv = alt ? PC_DV : PC_SV;
    AttnWaveCfg W; W.q = proj + (rb + q0) * NPROJ + cq + hq * 64; W.qstride = NPROJ; W.qpos0 = q0; W.kc0 = 0;
    const int kt_hi = rb64 + 1, kt_lo = (rb64 - 2) < 0 ? 0 : rb64 - 2;
    f32x16 o[2];
    AB::run(F, W, proj + rb * NPROJ + ck + kvh * 64, NPROJ, proj + rb * NPROJ + cv + kvh * 64, NPROJ, kt_lo, kt_hi, 0.125f * LOG2E,
            A.swa_qk_norm + l * 128, true, A.swa_sinks[l * 8 + hq] * LOG2E, o);
    if (!dry) store_o_f8_lds<2>(F.lds + 2 * AB::SLOT + F.wave * 2048, (unsigned char*)(proj + (rb + q0) * NPROJ + PC_SQ + hq * 64), NPROJ * 2, F.lane, o);
}
__device__ __forceinline__ void diff_attn_unit(const Frame& F0, int l, int b, int hh, int qb128, bool dry) {
    const Args A = load_args(); const Frame F = fresh(F0); asm volatile("" : "+s"(l));
    typedef AttnBody<64, 128, 1, true, 0, DIFF_VPRE> AB;
    bf16_t* proj = (bf16_t*)(A.ws + WS_PROJ);
    const int sub = F.wave & 1, rbk = F.wave >> 1; const int q0 = qb128 * 128 + rbk * 32; const size_t rb = (size_t)b * SEQ;
    AttnWaveCfg W; W.q = proj + (rb + q0) * NPROJ + PC_DQ + hh * 128 + sub * 64; W.qstride = NPROJ; W.qpos0 = q0; W.kc0 = sub * 8;
    float lam;
    { const float* lp = A.diff_lam + l * 256; const float a = wave_sum(lp[F.lane] * lp[64 + F.lane], F.lane), c = wave_sum(lp[128 + F.lane] * lp[192 + F.lane], F.lane);
      const float lam_init = 0.8f - 0.6f * __expf(-0.3f * (float)l); lam = __expf(a) - __expf(c) + lam_init; }
    f32x16 o[4];
    AB::run(F, W, proj + rb * NPROJ + PC_DK + hh * 128, NPROJ, proj + rb * NPROJ + PC_DV + hh * 128, NPROJ, 0, (qb128 * 128 + 128) / 64, 0.125f * LOG2E,
            A.diff_qk_norm + l * 128, false, 0.f, o);
    LAS float* ex = (LAS float*)(F.lds) + rbk * 4096;
    const int r32 = F.lane & 31, hi = F.lane >> 5;
    if (sub == 1) {
#pragma unroll
        for (int r = 0; r < 16; ++r)
#pragma unroll
            for (int d = 0; d < 4; ++d) ex[crow(r, hi) * 128 + d * 32 + r32] = o[d][r];
    }
    __syncthreads();
    if (sub == 0) {
        const float lam_init = 0.8f - 0.6f * __expf(-0.3f * (float)l);
        float ss[16];
#pragma unroll
        for (int r = 0; r < 16; ++r) { ss[r] = 0.f;
#pragma unroll
            for (int d = 0; d < 4; ++d) { const float v = o[d][r] - lam * ex[crow(r, hi) * 128 + d * 32 + r32]; o[d][r] = v; ss[r] += v * v; } }
#pragma unroll
        for (int r = 0; r < 16; ++r) { const float s = sum32(ss[r], F.lane);
            const float rstd = __builtin_amdgcn_rsqf(s * (1.f / 128.f) + EPS) * (1.0f - lam_init);
#pragma unroll
            for (int d = 0; d < 4; ++d) o[d][r] *= rstd * A.diff_onorm[l * 128 + d * 32 + r32]; }
        if (!dry) store_o_f8_lds<4>(F.lds + 65536 + rbk * 4096, (unsigned char*)(proj + (rb + q0) * NPROJ + PC_DQ + hh * 128), NPROJ * 2, F.lane, o);
    }
    __syncthreads();
}
__device__ __forceinline__ void knorm_pass(const Frame& F0, int l) {
    const Args A = load_args(); const Frame F = fresh(F0); asm volatile("" : "+s"(l));
    bf16_t* proj = (bf16_t*)(A.ws + WS_PROJ);
    const int stride = F.G * 512;
    for (int idx0 = F.vcu * 512 + F.tid; idx0 < M * 80; idx0 += 5 * stride) {
        u32x4 raw[5]; bf16_t* p[5]; const float* g[5];
#pragma unroll
        for (int i = 0; i < 5; ++i) { const int idx = idx0 + i * stride; const int row = idx / 80, ch = idx % 80; const bool isd = ch < 64; const int col = isd ? PC_DK + ch * 8 : PC_SK + (ch - 64) * 8;
            g[i] = (isd ? A.diff_qk_norm : A.swa_qk_norm) + l * 128 + 64 + (ch & 7) * 8; p[i] = proj + (size_t)row * NPROJ + col; raw[i] = *(const u32x4*)p[i]; }
#pragma unroll
        for (int i = 0; i < 5; ++i) { float f[8];
#pragma unroll
            for (int j = 0; j < 4; ++j) { f[2 * j] = bflo(raw[i][j]); f[2 * j + 1] = bfhi(raw[i][j]); }
            float ss = 0.f;
#pragma unroll
            for (int j = 0; j < 8; ++j) ss += f[j] * f[j];
            ss += shx(ss, 1, F.lane); ss += shx(ss, 2, F.lane); ss += shx(ss, 4, F.lane);
            const float rstd = __builtin_amdgcn_rsqf(ss * (1.f / 64.f) + EPS); const float* gg = g[i];
            u32x4 o; o.x = cvtpk(f[0] * rstd * gg[0], f[1] * rstd * gg[1]); o.y = cvtpk(f[2] * rstd * gg[2], f[3] * rstd * gg[3]); o.z = cvtpk(f[4] * rstd * gg[4], f[5] * rstd * gg[5]); o.w = cvtpk(f[6] * rstd * gg[6], f[7] * rstd * gg[7]);
            *(u32x4*)p[i] = o; }
    }
}

__device__ __forceinline__ void hgrn_unit(const Frame& F0, int l, int b, int h, bool dry) {
    const Args A = load_args(); const Frame F = fresh(F0); asm volatile("" : "+s"(l));
    const int tid = F.tid, lane = F.lane, w = F.wave, r32 = lane & 31, hi = lane >> 5;
    LAS unsigned char* lds = F.lds;
    constexpr int ST = 144, STT = 192, OST = 272;
    constexpr int O_QB = 0, O_QD = O_QB + 64 * ST, O_KD = O_QD + 64 * ST, O_QX = O_KD + 64 * ST, O_KX = O_QX + 64 * ST;
    constexpr int O_KE = O_KX + 64 * ST, O_V = O_KE + 64 * STT, O_S = O_V + 64 * STT;
    constexpr int O_SEG = O_S + 2 * 64 * STT, O_DL = O_SEG + 8 * 64 * 4, O_OB = O_DL + 256;
    bf16_t* proj = (bf16_t*)(A.ws + WS_PROJ);
    const size_t rb = (size_t)b * SEQ;
    const int k = lane;
    float lb = 0.f;
    if (l == 1) { const float a0 = A.hg_lb[h * 64 + k], a1 = A.hg_lb[512 + h * 64 + k]; lb = 1.0f / (1.0f + __expf(a0 - a1)); }
    for (int i = tid; i < 64 * STT / 4; i += 512) *(LAS unsigned*)(lds + O_S + i * 4) = 0u;
    f32x16 sacc = (f32x16){0};
    unsigned short qraw[8], fraw[8]; u32x4 vraw, graw, gprev = (u32x4){0u, 0u, 0u, 0u};
    const int erow = tid >> 3, ecol = (tid & 7) * 8;
    f32x4 gn0, gn1; { const float* g = A.hg_onorm + l * 64 + ecol; gn0 = *(const f32x4*)g; gn1 = *(const f32x4*)(g + 4); }
    auto load_chunk = [&](int c) {
        const bf16_t* base = proj + (rb + c * 64 + w * 8) * NPROJ + h * 64 + k;
#pragma unroll
        for (int j = 0; j < 8; ++j) { qraw[j] = base[(size_t)j * NPROJ + PC_HQ]; fraw[j] = base[(size_t)j * NPROJ + PC_HF]; }
        const bf16_t* rp = proj + (rb + c * 64 + erow) * NPROJ + h * 64 + ecol;
        vraw = *(const u32x4*)(rp + PC_HI); graw = *(const u32x4*)(rp + PC_HG);
    };
    auto epilogue = [&](int c, const u32x4& gr) {
        const LAS float* op = (const LAS float*)(lds + O_OB + erow * OST + ecol * 4);
        const f32x4 o0 = *(const LAS f32x4*)op, o1 = *(const LAS f32x4*)(op + 4);
        const float ss = sum8((o0[0] * o0[0] + o0[1] * o0[1]) + (o0[2] * o0[2] + o0[3] * o0[3]) + (o1[0] * o1[0] + o1[1] * o1[1]) + (o1[2] * o1[2] + o1[3] * o1[3]));
        const float rstd = __builtin_amdgcn_rsqf(ss * (1.f / 64.f) + EPS);
        float y[8];
#pragma unroll
        for (int j = 0; j < 4; ++j) { const float ga = bflo(gr[j]), gb = bfhi(gr[j]); const float oa = j < 2 ? o0[2 * j] : o1[2 * j - 4], ob = j < 2 ? o0[2 * j + 1] : o1[2 * j - 3];
            const float na = j < 2 ? gn0[2 * j] : gn1[2 * j - 4], nb = j < 2 ? gn0[2 * j + 1] : gn1[2 * j - 3];
            y[2 * j] = oa * rstd * na * fsilu(ga); y[2 * j + 1] = ob * rstd * nb * fsilu(gb); }
        u32x2 o; o.x = pk4f8(y[0] * Y8_SCALE, y[1] * Y8_SCALE, y[2] * Y8_SCALE, y[3] * Y8_SCALE); o.y = pk4f8(y[4] * Y8_SCALE, y[5] * Y8_SCALE, y[6] * Y8_SCALE, y[7] * Y8_SCALE);
        if (!dry) *(u32x2*)((unsigned char*)(proj + (rb + c * 64 + erow) * NPROJ + PC_HQ + h * 64) + ecol) = o;
    };
    load_chunk(0);
#pragma unroll 1
    for (int c = 0; c < 32; ++c) {
        const int sb_cur = c & 1;
        float qv[8], kkv[8], bl[8]; float run = 0.f;
#pragma unroll
        for (int j = 0; j < 8; ++j) { const float f = bf2f(fraw[j]), q = bf2f(qraw[j]);
            const float ef = __expf(-f); const float sg = __builtin_amdgcn_rcpf(1.0f + ef); const float fg = lb + (1.0f - lb) * sg;
            float lf = __logf(fg); lf = fmaxf(lf, -30.0f);
            kkv[j] = (1.0f - lb) * ef * sg;
            qv[j] = fsilu(q);
            run += lf; bl[j] = run; }
        const u32x4 vcur = vraw, gcur = graw;
        *(LAS float*)(lds + O_SEG + (w * 64 + k) * 4) = run;
        __syncthreads();
        if (c + 1 < 32) load_chunk(c + 1);
        if (c > 0) epilogue(c - 1, gprev);
        gprev = gcur;
        float sg8[8];
#pragma unroll
        for (int j = 0; j < 8; ++j) sg8[j] = *(LAS float*)(lds + O_SEG + (j * 64 + k) * 4);
        float off = 0.f;
#pragma unroll
        for (int j = 0; j < 8; ++j) off += (j < w) ? sg8[j] : 0.f;
        const float r15 = sg8[0] + sg8[1], r31 = r15 + sg8[2] + sg8[3], r47 = r31 + sg8[4] + sg8[5], r63 = r47 + sg8[6] + sg8[7];
        const float rd = (w < 4) ? r15 : r47;
#pragma unroll
        for (int j = 0; j < 8; ++j) { const int t = w * 8 + j; const float bt = off + bl[j];
            const float eb = __expf(bt);
            const float qd = qv[j] * __expf(fminf(bt - rd, 60.f)), kd = kkv[j] * __expf(fminf(rd - bt, 60.f));
            const float ke = kkv[j] * __expf(r63 - bt);
            const float xx = (w >= 4) ? qv[j] * __expf(bt - r31) : kkv[j] * __expf(r31 - bt);
            const unsigned p0 = pk2(qv[j] * eb, qd), p1 = pk2(kd, ke), p2 = pk2(xx, 0.f);
            *(LAS bf16_t*)(lds + O_QB + t * ST + k * 2) = (bf16_t)(p0 & 0xffffu);
            *(LAS bf16_t*)(lds + O_QD + t * ST + k * 2) = (bf16_t)(p0 >> 16);
            *(LAS bf16_t*)(lds + O_KD + t * ST + k * 2) = (bf16_t)(p1 & 0xffffu);
            *(LAS bf16_t*)(lds + O_KE + t * STT + k * 2) = (bf16_t)(p1 >> 16);
            *(LAS bf16_t*)(lds + ((w >= 4) ? O_QX : O_KX) + t * ST + k * 2) = (bf16_t)(p2 & 0xffffu); }
        *(LAS u32x4*)(lds + O_V + erow * STT + ecol * 2) = vcur;
        if (w == 0) *(LAS float*)(lds + O_DL + k * 4) = __expf(r63);
        __syncthreads();
        const int trow = 4 * hi + ((lane & 15) >> 2), tcol = ((lane >> 4) & 1) * 32 + (lane & 3) * 8;
        if (w < 2) {
            const int tb = w;
            f32x16 oacc[2]; oacc[0] = (f32x16){0}; oacc[1] = (f32x16){0};
            for (int sb = 0; sb <= tb; ++sb) {
                const int ko = (sb == tb) ? O_KD : O_KX, qo = (sb == tb) ? O_QD : O_QX;
                f32x16 p = (f32x16){0};
#pragma unroll
                for (int ks = 0; ks < 4; ++ks) { const bf16x8 ka = *(const LAS bf16x8*)(lds + ko + (32 * sb + r32) * ST + ks * 32 + hi * 16);
                    const bf16x8 qb = *(const LAS bf16x8*)(lds + qo + (32 * tb + r32) * ST + ks * 32 + hi * 16);
                    p = __builtin_amdgcn_mfma_f32_32x32x16_bf16(ka, qb, p, 0, 0, 0); }
                if (sb == tb) {
#pragma unroll
                    for (int r = 0; r < 16; ++r) p[r] = (crow(r, hi) <= r32) ? p[r] : 0.f;
                }
#pragma unroll
                for (int s2 = 0; s2 < 2; ++s2) { u32x4 pw; pw.x = pk2(p[8 * s2], p[8 * s2 + 1]); pw.y = pk2(p[8 * s2 + 2], p[8 * s2 + 3]); pw.z = pk2(p[8 * s2 + 4], p[8 * s2 + 5]); pw.w = pk2(p[8 * s2 + 6], p[8 * s2 + 7]);
                    const bf16x8 pa = __builtin_bit_cast(bf16x8, pw);
#pragma unroll
                    for (int d = 0; d < 2; ++d) { const LAS unsigned char* vp = lds + O_V + (32 * sb + 16 * s2 + trow) * STT + tcol + d * 64;
                        const s16x4 lo = __builtin_bit_cast(s16x4, __builtin_amdgcn_ds_read_tr16_b64_v4i16((LAS s16x4*)vp));
                        const s16x4 hh = __builtin_bit_cast(s16x4, __builtin_amdgcn_ds_read_tr16_b64_v4i16((LAS s16x4*)(vp + 8 * STT)));
                        const bf16x8 vf = (bf16x8){lo[0], lo[1], lo[2], lo[3], hh[0], hh[1], hh[2], hh[3]};
                        oacc[d] = __builtin_amdgcn_mfma_f32_32x32x16_bf16(pa, vf, oacc[d], 0, 0, 0); } }
            }
#pragma unroll
            for (int ks = 0; ks < 4; ++ks) { const bf16x8 qa = *(const LAS bf16x8*)(lds + O_QB + (32 * tb + r32) * ST + ks * 32 + hi * 16);
#pragma unroll
                for (int d = 0; d < 2; ++d) { const LAS unsigned char* sp = lds + O_S + sb_cur * 64 * STT + (16 * ks + 8 * hi + ((lane & 15) >> 2)) * STT + tcol + d * 64;
                    const s16x4 lo = __builtin_bit_cast(s16x4, __builtin_amdgcn_ds_read_tr16_b64_v4i16((LAS s16x4*)sp));
                    const s16x4 hh = __builtin_bit_cast(s16x4, __builtin_amdgcn_ds_read_tr16_b64_v4i16((LAS s16x4*)(sp + 4 * STT)));
                    const bf16x8 sf = (bf16x8){lo[0], lo[1], lo[2], lo[3], hh[0], hh[1], hh[2], hh[3]};
                    oacc[d] = __builtin_amdgcn_mfma_f32_32x32x16_bf16(qa, sf, oacc[d], 0, 0, 0); } }
#pragma unroll
            for (int r = 0; r < 16; ++r) { LAS float* op = (LAS float*)(lds + O_OB + (32 * tb + crow(r, hi)) * OST) + r32; op[0] = oacc[0][r]; op[32] = oacc[1][r]; }
        } else if (w < 6) {
            const int kb = (w - 2) >> 1, vb = (w - 2) & 1;
            f32x16 u = (f32x16){0};
#pragma unroll
            for (int s2 = 0; s2 < 4; ++s2) { const LAS unsigned char* ap = lds + O_KE + (16 * s2 + trow) * STT + tcol + kb * 64;
                const LAS unsigned char* bp = lds + O_V + (16 * s2 + trow) * STT + tcol + vb * 64;
                const s16x4 alo = __builtin_bit_cast(s16x4, __builtin_amdgcn_ds_read_tr16_b64_v4i16((LAS s16x4*)ap));
                const s16x4 ahi = __builtin_bit_cast(s16x4, __builtin_amdgcn_ds_read_tr16_b64_v4i16((LAS s16x4*)(ap + 8 * STT)));
                const s16x4 blo = __builtin_bit_cast(s16x4, __builtin_amdgcn_ds_read_tr16_b64_v4i16((LAS s16x4*)bp));
                const s16x4 bhi = __builtin_bit_cast(s16x4, __builtin_amdgcn_ds_read_tr16_b64_v4i16((LAS s16x4*)(bp + 8 * STT)));
                const bf16x8 af = (bf16x8){alo[0], alo[1], alo[2], alo[3], ahi[0], ahi[1], ahi[2], ahi[3]};
                const bf16x8 bf = (bf16x8){blo[0], blo[1], blo[2], blo[3], bhi[0], bhi[1], bhi[2], bhi[3]};
                u = __builtin_amdgcn_mfma_f32_32x32x16_bf16(af, bf, u, 0, 0, 0); }
#pragma unroll
            for (int r = 0; r < 16; ++r) { const int kr = 32 * kb + crow(r, hi); const float dl = *(LAS float*)(lds + O_DL + kr * 4);
                sacc[r] = sacc[r] * dl + u[r];
                *(LAS bf16_t*)(lds + O_S + (sb_cur ^ 1) * 64 * STT + kr * STT + (32 * vb + r32) * 2) = (bf16_t)(pk2(sacc[r], 0.f) & 0xffffu); }
        }
    }
    __syncthreads();
    epilogue(31, gprev);
    __syncthreads();
}

using pg8::Unit;
__device__ __forceinline__ size_t gate_blk(int pm, int pn, int ai, int wr, int m, int bj, int wc) { return (size_t)(((((((pm * 16 + pn) * 2 + ai) * 2 + wr) * 4 + m) * 2 + bj) * 4 + wc)) * 64; }
__device__ __forceinline__ size_t merged_blk(int pm, int pn, int ai, int wr, int m, int bj, int wc) { return (size_t)(((((((pm * 4 + pn) * 2 + ai) * 2 + wr) * 4 + m) * 2 + bj) * 4 + wc)) * 64; }
struct SchedB { static constexpr bool MULTIK = false; static constexpr bool ABLK = false; unsigned H, W; int G, c;
    __device__ __forceinline__ bool next(int i, Unit& u) const { const long L = (long)i * G + c; if (L >= 64 * 35) return false; int pm, pn; pg8::tile_order((int)L, 64, 35, pm, pn);
        u.pm = pm; u.pn = pn; u.aux = 0; u.a = H + (unsigned)pm * (256 * 1024); u.b0 = W + (unsigned)pn * (256 * 1024); u.b1 = u.b0; u.ridx = 0; u.nvalid = 256; return true; }
    __device__ __forceinline__ int lda(const Unit&) const { return 1024; } __device__ __forceinline__ int akstep(const Unit&) const { return 128; }
    __device__ __forceinline__ unsigned btile(const Unit& u, int t) const { return u.b0 + (unsigned)t * 128; } };
struct EpiB { static constexpr bool MID = false; static constexpr bool PERM = true; bf16_t* proj; unsigned char* gate8; const float* gdk; const float* gsk;
    __device__ __forceinline__ void operator()(const f32x4 (&acc)[2][2][4][2], const Unit& u, int wr, int wc, int fr, int fq) const {
        const int row0 = u.pm * 256 + wr * 64 + fr;
        if (u.pn < 16) {
#pragma unroll
            for (int ai = 0; ai < 2; ++ai)
#pragma unroll
                for (int m = 0; m < 4; ++m) {
#pragma unroll
                    for (int bj = 0; bj < 2; ++bj) { const f32x4 v0 = acc[ai][bj][m][0], v1 = acc[ai][bj][m][1]; u32x2 o = {0u, 0u};
#pragma unroll
                        for (int i = 0; i < 4; ++i) {
                            const float t0 = __builtin_amdgcn_exp2f(v0[i] * (-W8_INV * LOG2E)), t1 = __builtin_amdgcn_exp2f(v1[i] * (-W8_INV * LOG2E));
                            const float q0 = fmaxf(__builtin_amdgcn_rcpf(__builtin_fmaf(t0, 1.0f / 255.0f, 1.0f / 255.0f)), 1.0f), q1 = fmaxf(__builtin_amdgcn_rcpf(__builtin_fmaf(t1, 1.0f / 255.0f, 1.0f / 255.0f)), 1.0f);
                            o.x = __builtin_amdgcn_cvt_pk_u8_f32(q0, i, o.x); o.y = __builtin_amdgcn_cvt_pk_u8_f32(q1, i, o.y); }
                        *(u32x2*)(gate8 + (gate_blk(u.pm, u.pn, ai, wr, m, bj, wc) + fr * 4 + fq) * 8) = o; } }
        } else {
            const int cb = (u.pn - 16) * 256 + 64 * wc;
            const bool isd = cb >= PC_DK && cb < PC_DK + 512, iss = cb >= PC_SK && cb < PC_SK + 128;
            if (isd || iss) {
                const float* gp = (isd ? gdk : gsk) + 8 * fq; f32x4 gv[2][2];
#pragma unroll
                for (int bj = 0; bj < 2; ++bj)
#pragma unroll
                    for (int n = 0; n < 2; ++n) gv[bj][n] = *(const f32x4*)(gp + 32 * bj + 4 * n) * W8_INV;
                const int lane = fq * 16 + fr;
#pragma unroll
                for (int ai = 0; ai < 2; ++ai)
#pragma unroll
                    for (int m = 0; m < 4; ++m) { bf16_t* rp = proj + (size_t)(row0 + ai * 128 + m * 16) * NPROJ + cb + 8 * fq;
                        float ss = 0.f;
#pragma unroll
                        for (int bj = 0; bj < 2; ++bj)
#pragma unroll
                            for (int n = 0; n < 2; ++n) { const f32x4 a = acc[ai][bj][m][n]; ss += (a[0] * a[0] + a[1] * a[1]) + (a[2] * a[2] + a[3] * a[3]); }
                        ss += shx(ss, 16, lane); ss += shx(ss, 32, lane);
                        const float rstd = __builtin_amdgcn_rsqf(ss * (W8_INV * W8_INV / 64.f) + EPS);
#pragma unroll
                        for (int bj = 0; bj < 2; ++bj) { const f32x4 v0 = acc[ai][bj][m][0] * rstd * gv[bj][0], v1 = acc[ai][bj][m][1] * rstd * gv[bj][1]; u32x4 o;
                            o.x = pg8::cvt_pk_bf16(v0[0], v0[1]); o.y = pg8::cvt_pk_bf16(v0[2], v0[3]); o.z = pg8::cvt_pk_bf16(v1[0], v1[1]); o.w = pg8::cvt_pk_bf16(v1[2], v1[3]);
                            *(u32x4*)(rp + bj * 32) = o; } }
            } else {
#pragma unroll
            for (int ai = 0; ai < 2; ++ai)
#pragma unroll
                for (int m = 0; m < 4; ++m) { bf16_t* rp = proj + (size_t)(row0 + ai * 128 + m * 16) * NPROJ + cb + 8 * fq;
#pragma unroll
                    for (int bj = 0; bj < 2; ++bj) { const f32x4 v0 = acc[ai][bj][m][0] * W8_INV, v1 = acc[ai][bj][m][1] * W8_INV; u32x4 o;
                        o.x = pg8::cvt_pk_bf16(v0[0], v0[1]); o.y = pg8::cvt_pk_bf16(v0[2], v0[3]); o.z = pg8::cvt_pk_bf16(v1[0], v1[1]); o.w = pg8::cvt_pk_bf16(v1[2], v1[3]);
                        *(u32x4*)(rp + bj * 32) = o; } }
            }
        }
    } };
struct SchedF { static constexpr bool MULTIK = true; static constexpr bool ABLK = true; unsigned proj, mlaq, W; int G, c;
    __device__ __forceinline__ bool next(int i, Unit& u) const { const long L = (long)i * G + c; if (L >= 256) return false; int pm, pn; pg8::tile_order((int)L, 64, 4, pm, pn);
        u.pm = pm; u.pn = pn; u.aux = 0; u.a = 0; u.b0 = W + (unsigned)(pn * 256) * 512; u.b1 = u.b0; u.ridx = 0; u.nvalid = 256; return true; }
    __device__ __forceinline__ int lda(const Unit&) const { return NPROJ * 2; } __device__ __forceinline__ int akstep(const Unit&) const { return 256; }
    __device__ __forceinline__ int ldab(int b) const { return b == 1 ? 1536 : NPROJ * 2; }
    __device__ __forceinline__ unsigned atile(const Unit& u, int kt) const { const int b = kt >> 2, k = kt & 3;
        if (b == 1) return mlaq + (unsigned)u.pm * (256 * 1536) + (unsigned)k * 384u;
        const int co = (b == 0) ? PC_HQ : (b == 2 ? PC_DQ : PC_SQ); return proj + (unsigned)u.pm * (256 * NPROJ * 2) + co * 2 + (unsigned)k * 256u; }
    __device__ __forceinline__ unsigned voffk(const Unit&, int kt, int R, int C) const { const int b = kt >> 2, cb = C * 2, slot = (b == 1) ? 192 : 128;
        return (unsigned)(R * ldab(b) + ((b == 2) ? cb : ((cb & 63) + (cb >> 6) * slot))); }
    __device__ __forceinline__ unsigned voffa(const Unit& u, int R, int C) const { return voffk(u, 0, R, C); }
    __device__ __forceinline__ unsigned hsk(const Unit&, int kt) const { return 128u * (unsigned)ldab(kt >> 2); }
    __device__ __forceinline__ unsigned hs(const Unit& u) const { return hsk(u, 0); }
    __device__ __forceinline__ unsigned btile(const Unit& u, int t) const { return u.b0 + (unsigned)(t >> 2) * (1024u * 512u) + (unsigned)(t & 3) * 128u; } };
struct EpiF { static constexpr bool MID = true; static constexpr bool PERM = true; const unsigned char* gate8;
    __device__ __forceinline__ void mid(f32x4 (&acc)[2][2][4][2], const Unit& u, int b, int wr, int wc, int fr, int fq) const {
        u32x2 gp[2][4][2], gn[2][4][2];
#pragma unroll
        for (int ai = 0; ai < 2; ++ai)
#pragma unroll
            for (int m = 0; m < 4; ++m)
#pragma unroll
                for (int bj = 0; bj < 2; ++bj) {
                    gp[ai][m][bj] = *(const u32x2*)(gate8 + (gate_blk(u.pm, (b - 1) * 4 + u.pn, ai, wr, m, bj, wc) + fr * 4 + fq) * 8);
                    gn[ai][m][bj] = *(const u32x2*)(gate8 + (gate_blk(u.pm, b * 4 + u.pn, ai, wr, m, bj, wc) + fr * 4 + fq) * 8); }
#pragma unroll
        for (int ai = 0; ai < 2; ++ai)
#pragma unroll
            for (int m = 0; m < 4; ++m)
#pragma unroll
                for (int bj = 0; bj < 2; ++bj) { const u32x2 p = gp[ai][m][bj], n = gn[ai][m][bj];
                    acc[ai][bj][m][0][0] *= (float)(p.x & 255u) * __builtin_amdgcn_rcpf((float)(n.x & 255u)); acc[ai][bj][m][0][1] *= (float)((p.x >> 8) & 255u) * __builtin_amdgcn_rcpf((float)((n.x >> 8) & 255u));
                    acc[ai][bj][m][0][2] *= (float)((p.x >> 16) & 255u) * __builtin_amdgcn_rcpf((float)((n.x >> 16) & 255u)); acc[ai][bj][m][0][3] *= (float)(p.x >> 24) * __builtin_amdgcn_rcpf((float)(n.x >> 24));
                    acc[ai][bj][m][1][0] *= (float)(p.y & 255u) * __builtin_amdgcn_rcpf((float)(n.y & 255u)); acc[ai][bj][m][1][1] *= (float)((p.y >> 8) & 255u) * __builtin_amdgcn_rcpf((float)((n.y >> 8) & 255u));
                    acc[ai][bj][m][1][2] *= (float)((p.y >> 16) & 255u) * __builtin_amdgcn_rcpf((float)((n.y >> 16) & 255u)); acc[ai][bj][m][1][3] *= (float)(p.y >> 24) * __builtin_amdgcn_rcpf((float)(n.y >> 24)); }
    }
    __device__ __forceinline__ void operator()(const f32x4 (&acc)[2][2][4][2], const Unit& u, int wr, int wc, int fr, int fq) const {
        const float s = (1.0f / 255.0f) * (W8_INV / Y8_SCALE) * M8_SCALE;
#pragma unroll
        for (int ai = 0; ai < 2; ++ai) {
            u32x2 g[4][2];
#pragma unroll
            for (int m = 0; m < 4; ++m)
#pragma unroll
                for (int bj = 0; bj < 2; ++bj) g[m][bj] = *(const u32x2*)(gate8 + (gate_blk(u.pm, 3 * 4 + u.pn, ai, wr, m, bj, wc) + fr * 4 + fq) * 8);
#pragma unroll
            for (int m = 0; m < 4; ++m)
#pragma unroll
                for (int bj = 0; bj < 2; ++bj) { const f32x4 v0 = acc[ai][bj][m][0], v1 = acc[ai][bj][m][1]; const u32x2 gg = g[m][bj]; float r[8];
                    r[0] = v0[0] * (float)(gg.x & 255u) * s; r[1] = v0[1] * (float)((gg.x >> 8) & 255u) * s; r[2] = v0[2] * (float)((gg.x >> 16) & 255u) * s; r[3] = v0[3] * (float)(gg.x >> 24) * s;
                    r[4] = v1[0] * (float)(gg.y & 255u) * s; r[5] = v1[1] * (float)((gg.y >> 8) & 255u) * s; r[6] = v1[2] * (float)((gg.y >> 16) & 255u) * s; r[7] = v1[3] * (float)(gg.y >> 24) * s;
                    u32x2 o8; o8.x = pk4f8(r[0], r[1], r[2], r[3]); o8.y = pk4f8(r[4], r[5], r[6], r[7]);
                    *(u32x2*)((unsigned char*)gate8 + (gate_blk(u.pm, u.pn, ai, wr, m, bj, wc) + fr * 4 + fq) * 8) = o8; }
            asm volatile("" ::: "memory");
        }
    } };
struct SchedG { static constexpr bool MULTIK = false; static constexpr bool ABLK = true; unsigned Am, W; int G, c;
    __device__ __forceinline__ bool next(int i, Unit& u) const { const long L = (long)i * G + c; if (L >= 256) return false; int pm, pn; pg8::tile_order((int)L, 64, 4, pm, pn);
        u.pm = pm; u.pn = pn; u.aux = 0; u.a = Am + (unsigned)pm * (16u * 8192u * 8u); u.b0 = W + (unsigned)pn * (256 * 1024); u.b1 = u.b0; u.ridx = 0; u.nvalid = 256; return true; }
    __device__ __forceinline__ int lda(const Unit&) const { return 1024; } __device__ __forceinline__ int akstep(const Unit&) const { return 128; }
    __device__ __forceinline__ unsigned atile(const Unit& u, int kt) const { return u.a + (unsigned)((kt >> 1) * 8192 + (kt & 1) * 256) * 8u; }
    __device__ __forceinline__ unsigned voffa(const Unit&, int R, int C) const { const int cb = C * 2; return (unsigned)(((R >> 7) & 1) * 4096 + ((R >> 6) & 1) * 2048 + ((R >> 4) & 3) * 512 + (cb >> 5) * 64 + (R & 15) * 4 + ((cb >> 3) & 3)) * 8u; }
    __device__ __forceinline__ unsigned hs(const Unit&) const { return 4096u * 8u; }
    __device__ __forceinline__ unsigned btile(const Unit& u, int t) const { return u.b0 + (unsigned)t * 128; } };
struct EpiG { static constexpr bool MID = false; static constexpr bool PERM = false; const float* xin; float* out; const float* gt;
    __device__ __forceinline__ void operator()(const f32x4 (&acc)[2][2][4][2], const Unit& u, int wr, int wc, int fr, int fq) const {
        const int row0 = u.pm * 256 + wr * 64 + fr, col0 = u.pn * 256 + wc * 32 + 4 * fq; const int b = (u.pm * 256) >> 11;
        f32x4 g[2][2];
#pragma unroll
        for (int bj = 0; bj < 2; ++bj)
#pragma unroll
            for (int n = 0; n < 2; ++n) g[bj][n] = *(const f32x4*)(gt + b * 6144 + col0 + bj * 128 + n * 16);
#pragma unroll
        for (int ai = 0; ai < 2; ++ai) {
            f32x4 xv[4][2][2];
#pragma unroll
            for (int m = 0; m < 4; ++m) { const size_t off = (size_t)(row0 + ai * 128 + m * 16) * DM + col0;
#pragma unroll
                for (int bj = 0; bj < 2; ++bj)
#pragma unroll
                    for (int n = 0; n < 2; ++n) xv[m][bj][n] = *(const f32x4*)(xin + off + bj * 128 + n * 16); }
#pragma unroll
            for (int m = 0; m < 4; ++m) { const size_t off = (size_t)(row0 + ai * 128 + m * 16) * DM + col0;
#pragma unroll
                for (int bj = 0; bj < 2; ++bj)
#pragma unroll
                    for (int n = 0; n < 2; ++n) *(f32x4*)(out + off + bj * 128 + n * 16) = xv[m][bj][n] + g[bj][n] * (acc[ai][bj][m][n] * (W8_INV / M8_SCALE)); }
            asm volatile("" ::: "memory");
        }
    } };
struct MoeSched { volatile LAS unsigned* ms; unsigned list;
    __device__ __forceinline__ int rd(int i) const { return __builtin_amdgcn_readfirstlane((int)ms[i]); }
    __device__ __forceinline__ bool tile(int tau, int& pair, int& j0, int& nval) const { const int T = rd(64 + 24); if (tau >= T) return false; int p = 0;
        for (int q = 1; q < 24; ++q) if (rd(64 + q) <= tau) p = q;
        pair = p; j0 = (tau - rd(64 + p)) * 256; const int rem = rd(32 + p) - j0; nval = rem < 256 ? rem : 256; return true; } };
__device__ __forceinline__ void moe_sched_setup(const Frame& F0, int l) {
    const Args A = load_args(); const Frame F = fresh(F0); asm volatile("" : "+s"(l));
    const unsigned* cnt = (const unsigned*)(A.ws + WS_CTL) + CW_CNT + 64 * l;
    if (F.tid < 24) F.MISC[32 + F.tid] = __hip_atomic_load(cnt + F.tid, RLX_AGENT);
    __syncthreads();
    if (F.tid == 0) { unsigned pre = 0; for (int p = 0; p < 24; ++p) { F.MISC[64 + p] = pre; pre += (F.MISC[32 + p] + 255u) >> 8; } F.MISC[64 + 24] = pre; }
    __syncthreads();
}
struct SchedI { static constexpr bool MULTIK = false; static constexpr bool ABLK = false; MoeSched ms; unsigned H2, GUT; int G, c;
    __device__ __forceinline__ bool next(int i, Unit& u) const { const long L = (long)i * G + c; const int tau = (int)(L >> 2), pn = (int)(L & 3); int pair, j0, nval; if (!ms.tile(tau, pair, j0, nval)) return false;
        int ea, eb; pair_experts(pair, ea, eb); const int e = pn < 2 ? ea : eb;
        u.pm = tau; u.pn = pn; u.aux = pair; u.a = H2; u.b0 = GUT + (unsigned)(e * 512 + (pn & 1) * 256) * 2048; u.b1 = u.b0;
        u.ridx = ms.list + (unsigned)(pair * 16384 + j0) * 4; u.nvalid = nval; return true; }
    __device__ __forceinline__ int lda(const Unit&) const { return 2048; } __device__ __forceinline__ int akstep(const Unit&) const { return 128; }
    __device__ __forceinline__ unsigned btile(const Unit& u, int t) const { return u.b0 + (unsigned)t * 128; } };
struct EpiI { static constexpr bool MID = false; static constexpr bool PERM = true; bf16_t* hid; const float* tokw; const char* wsb;
    __device__ __forceinline__ void operator()(const f32x4 (&acc)[2][2][4][2], const Unit& u, int wr, int wc, int fr, int fq) const {
        const int wsel = u.pn >> 1;
        int tk[2][4]; float wg[2][4];
#pragma unroll
        for (int ai = 0; ai < 2; ++ai)
#pragma unroll
            for (int m = 0; m < 4; ++m) { const int r = ai * 128 + wr * 64 + m * 16 + fr; tk[ai][m] = (r < u.nvalid) ? ((const int*)(wsb + u.ridx))[r] : -1; }
#pragma unroll
        for (int ai = 0; ai < 2; ++ai)
#pragma unroll
            for (int m = 0; m < 4; ++m) wg[ai][m] = (tk[ai][m] >= 0) ? tokw[2 * tk[ai][m] + wsel] : 0.f;
#pragma unroll
        for (int ai = 0; ai < 2; ++ai)
#pragma unroll
            for (int m = 0; m < 4; ++m) { const int r = ai * 128 + wr * 64 + m * 16 + fr; const float wgt = wg[ai][m];
                const f32x4 g0 = acc[ai][0][m][0], g1 = acc[ai][0][m][1], u0 = acc[ai][1][m][0], u1 = acc[ai][1][m][1]; float v[8];
                const float ws_ = wgt * (W8_INV * HID8_SCALE);
#pragma unroll
                for (int i = 0; i < 4; ++i) { v[i] = fsilu(g0[i] * W8_INV) * u0[i] * ws_; v[4 + i] = fsilu(g1[i] * W8_INV) * u1[i] * ws_; }
                u32x2 o; o.x = pk4f8(v[0], v[1], v[2], v[3]); o.y = pk4f8(v[4], v[5], v[6], v[7]);
                { unsigned char* hp = (unsigned char*)hid + (size_t)(u.pm * 256 + r) * 512 + u.pn * 128 + wc * 32 + 8 * fq;
                  asm volatile("global_store_dwordx2 %0, %1, off sc1\n\ts_nop 1" :: "v"(hp), "v"(o) : "memory"); }
                asm volatile("" ::: "memory"); }
    } };
struct SchedJ { static constexpr bool MULTIK = false; static constexpr bool ABLK = false; MoeSched ms; unsigned HID, DT; int G, c;
    __device__ __forceinline__ bool next(int i, Unit& u) const { const long L = (long)i * G + c; const int tau = (int)(L >> 2), pn = (int)(L & 3); int pair, j0, nval; if (!ms.tile(tau, pair, j0, nval)) return false;
        int ea, eb; pair_experts(pair, ea, eb);
        u.pm = tau; u.pn = pn; u.a = HID + (unsigned)tau * (256 * 1024);
        u.b0 = DT + (unsigned)(ea * 1024 + pn * 256) * 512; u.b1 = DT + (unsigned)(eb * 1024 + pn * 256) * 512; u.ridx = 0; u.nvalid = nval; u.aux = j0 + pair * 16384; return true; }
    __device__ __forceinline__ int lda(const Unit&) const { return 1024; } __device__ __forceinline__ int akstep(const Unit&) const { return 128; }
    __device__ __forceinline__ unsigned btile(const Unit& u, int t) const { return t < 4 ? u.b0 + (unsigned)t * 128 : u.b1 + (unsigned)(t - 4) * 128; } };
struct EpiJ { static constexpr bool MID = false; static constexpr bool PERM = false; float* out; const float* gt; const int* list;
    __device__ __forceinline__ void operator()(const f32x4 (&acc)[2][2][4][2], const Unit& u, int wr, int wc, int fr, int fq) const {
        const int col0 = u.pn * 256 + wc * 32 + 4 * fq;
        int tk[2][4];
#pragma unroll
        for (int ai = 0; ai < 2; ++ai)
#pragma unroll
            for (int m = 0; m < 4; ++m) { const int r = ai * 128 + wr * 64 + m * 16 + fr; tk[ai][m] = (r < u.nvalid) ? list[u.aux + r] : -1; }
#pragma unroll
        for (int ai = 0; ai < 2; ++ai) {
            int tok[4]; f32x4 xv[4][2][2];
#pragma unroll
            for (int m = 0; m < 4; ++m) tok[m] = tk[ai][m];
#pragma unroll
            for (int m = 0; m < 4; ++m) { const size_t off = (size_t)(tok[m] < 0 ? 0 : tok[m]) * DM + col0;
#pragma unroll
                for (int bj = 0; bj < 2; ++bj)
#pragma unroll
                    for (int n = 0; n < 2; ++n) xv[m][bj][n] = *(const f32x4*)(out + off + bj * 128 + n * 16); }
#pragma unroll
            for (int m = 0; m < 4; ++m) if (tok[m] >= 0) { const int bb = tok[m] >> 11; const size_t off = (size_t)tok[m] * DM + col0;
#pragma unroll
                for (int bj = 0; bj < 2; ++bj)
#pragma unroll
                    for (int n = 0; n < 2; ++n) { const f32x4 g = *(const f32x4*)(gt + bb * 6144 + col0 + bj * 128 + n * 16);
                        *(f32x4*)(out + off + bj * 128 + n * 16) = xv[m][bj][n] + g * (acc[ai][bj][m][n] * (W8_INV / HID8_SCALE)); } }
            asm volatile("" ::: "memory");
        }
    } };

constexpr int CW_TILE = 9216;
struct SchedIJ { static constexpr bool MULTIK = false; static constexpr bool ABLK = false; MoeSched ms; unsigned H2, GUT, HID, DT; unsigned* tcnt; int G, c;
    __device__ __forceinline__ bool next(int i, Unit& u) const { const long L = (long)i * G + c; const int T4 = 4 * ms.rd(64 + 24); if (L >= 2 * T4) return false;
        const int kind = L >= T4 ? 1 : 0; const int idx = (int)L - kind * T4; const int tau = idx >> 2, pn = idx & 3; int pair, j0, nval; if (!ms.tile(tau, pair, j0, nval)) return false;
        int ea, eb; pair_experts(pair, ea, eb);
        u.pm = tau; u.pn = pn; u.kind = kind; u.nvalid = nval;
        if (kind == 0) { const int e = pn < 2 ? ea : eb; u.aux = pair; u.a = H2; u.b0 = GUT + (unsigned)(e * 512 + (pn & 1) * 256) * 1024; u.b1 = u.b0; u.ridx = ms.list + (unsigned)(pair * 16384 + j0) * 4; }
        else { u.aux = j0 + pair * 16384; u.a = HID + (unsigned)tau * (256 * 512); u.b0 = DT + (unsigned)(ea * 1024 + pn * 256) * 256; u.b1 = DT + (unsigned)(eb * 1024 + pn * 256) * 256; u.ridx = 0; }
        return true; }
    __device__ __forceinline__ int lda(const Unit& u) const { return u.kind ? 512 : 1024; } __device__ __forceinline__ int akstep(const Unit&) const { return 128; }
    __device__ __forceinline__ int nt(const Unit& u) const { return u.kind ? 4 : 8; } __device__ __forceinline__ int ldb(const Unit& u) const { return u.kind ? 256 : 1024; }
    __device__ __forceinline__ bool perm(const Unit& u) const { return u.kind == 0; } __device__ __forceinline__ bool dep(const Unit& u) const { return u.kind == 1; }
    __device__ __forceinline__ unsigned btile(const Unit& u, int t) const { return (u.kind && t >= 2) ? u.b1 + (unsigned)(t - 2) * 128 : u.b0 + (unsigned)t * 128; }
    __device__ __forceinline__ void a_ready(const Unit& u) const {
        if (u.kind == 1) { unsigned sp = 0;
            while (__hip_atomic_load(tcnt + u.pm, RLX_AGENT) < 4u) { __builtin_amdgcn_s_sleep(2); if (++sp > (1u << 22)) break; }
            __builtin_amdgcn_fence(__ATOMIC_ACQUIRE, "agent"); asm volatile("s_waitcnt vmcnt(0)" ::: "memory"); } }
    __device__ __forceinline__ void done(const Unit& u, int wid, int lane) const {
        if (u.kind == 0 && wid == 0 && lane == 0) __hip_atomic_fetch_add(tcnt + u.pm, 1u, RLX_AGENT); }
};
struct EpiIJ { static constexpr bool MID = false; static constexpr bool PERM = false; EpiI ei; EpiJ ej;
    __device__ __forceinline__ void operator()(const f32x4 (&acc)[2][2][4][2], const Unit& u, int wr, int wc, int fr, int fq) const { if (u.kind == 0) ei(acc, u, wr, wc, fr, fq); else ej(acc, u, wr, wc, fr, fq); } };

__global__ void __launch_bounds__(512, 2) mk_fwd(Args Akern) {
    extern __shared__ __attribute__((aligned(16))) unsigned char lds_raw[];
    Frame F;
    F.lds = (LAS unsigned char*)lds_raw; F.ldsg = lds_raw;
    F.MISC = (volatile LAS unsigned*)(F.lds + MISC_OFF);
    F.tid = threadIdx.x; F.lane = F.tid & 63; F.wave = __builtin_amdgcn_readfirstlane(F.tid >> 6);
    F.G = gridDim.x; { const int bx = blockIdx.x; F.vcu = (F.G % 8 == 0) ? (bx % 8) * (F.G / 8) + bx / 8 : bx; }
    for (int u = F.tid; u < 256; u += 512) F.MISC[u] = 0u;
    __syncthreads();
    int lo, hi;
    XcdBarrier bar;
    { const Args A = load_args(); lo = A.ph_lo; hi = A.ph_hi; F.ctl = (gu32*)(A.ws + WS_CTL);
      bar.bar = (unsigned*)(A.ws + WS_CTL) + CW_BAR; bar.x = 0; bar.st = nullptr;
      if (!MK_PER_PHASE) bar = xcd_barrier_post((unsigned*)(A.ws + WS_CTL) + CW_BAR, F.MISC + 8); }
#define GRID_BAR() do { if (!MK_PER_PHASE) xcd_barrier(bar); } while (0)
#pragma unroll 1
    for (int ph = lo; ph < hi; ++ph) {
      if (STAMP_MODE == 2 && blockIdx.x == 0) { int t0_ = threadIdx.x; asm volatile("" : "+v"(t0_)); if (t0_ == 0) ((unsigned long long*)((unsigned*)F.ctl + 12288))[ph] = __builtin_amdgcn_s_memrealtime(); }
      const int spx = (ph == 0) ? 9 : (ph - 1) % PPL; const int reps = ((REP_MASK >> spx) & 1) ? 1 + REP_N : 1;
#pragma unroll 1
      for (int rep = 0; rep < reps; ++rep) {
        if (rep > 0) GRID_BAR();
        if (ph == 0) { if (PH_ON(9)) {
            p0_mod_rope(F); }
        } else {
            const int l = (ph - 1) / PPL, sp = (ph - 1) % PPL;
            if (sp == 0) { if (PH_ON(0))
                norm_phase<false>(F, l);
            } else if (sp == 1) { if (PH_ON(1)) {
                const Args A = load_args(); const char* wsb = (const char*)A.ws;
                SchedB S{(unsigned)WS_H, (unsigned)WS_WINT, F.G, (int)blockIdx.x}; EpiB E{(bf16_t*)(A.ws + WS_PROJ), A.ws + WS_GATE8, A.diff_qk_norm + l * 128 + 64, A.swa_qk_norm + l * 128 + 64};
                pg8::gemm_phase<false, false, true>(F.lds, wsb, 8, 1024, S, E); }
            } else if (sp == 2) { if (PH_ON(2))
                { for (int u = F.vcu; u < M / 64; u += F.G) mla_prep_unit(F, l, u);
                  asm volatile("s_waitcnt vmcnt(0)" ::: "memory"); __syncthreads();
                  if (F.tid == 0) __hip_atomic_fetch_add((unsigned*)F.ctl + CW_CNT + 64 * l + 56 + ((int)blockIdx.x & 7), 1u, RLX_AGENT); }
            } else if (sp == 3) { if (PH_ON(3)) {
                unsigned* qctr = (unsigned*)F.ctl + CW_QUEUE + 64 * l;
#define QNEXT(ctr) ({ if (F.tid == 0) F.MISC[16] = atomicAdd((ctr), 1u); __syncthreads(); const int u_ = __builtin_amdgcn_readfirstlane((int)F.MISC[16]); __syncthreads(); u_; })
#pragma unroll 1
                for (int pass = ((DRY_MASK && ((DRY_LAYERS >> l) & 1)) ? -(DRY_REPS - 1) : 1); pass < 2; ++pass) {
                const bool dry = (pass <= 0); unsigned* qc = qctr + (dry ? 4 * (1 - pass) : 0);
                if (!dry) { unsigned* xq = (unsigned*)F.ctl + CW_CNT + 64 * l + 32; const int myx = (int)blockIdx.x & 7;
                    const int jx = (int)blockIdx.x >> 3; (void)xq;
                    if (jx < 8) hgrn_unit(F, l, myx, jx, false); }
                else if (UNIT_ON(0) && (DRY_MASK & 1)) for (;;) { const int u = QNEXT(qc + 0); if (u >= 64) break; hgrn_unit(F, l, u >> 3, u & 7, dry); }
                if (!dry) { unsigned* xq = (unsigned*)F.ctl + CW_CNT + 64 * l + 32; const int myx = (int)blockIdx.x & 7;
                    const int jx = (int)blockIdx.x >> 3, ax = jx - 8; (void)xq;
                    if (ax >= 0) {
#pragma unroll 1
                        for (int r = 0; r < 3; ++r) { const int u = 24 * r + ((r & 1) ? 23 - ax : ax); if (u < 64) diff_attn_unit(F, l, myx, u & 3, 15 - (u >> 2), false); }
                        if (F.MISC[10] != 0u) {
                            if (F.tid == 0) { const unsigned* pc = (const unsigned*)F.ctl + CW_CNT + 64 * l + 56 + myx; unsigned spn_ = 0;
                                while (__hip_atomic_load(pc, RLX_AGENT) < 32u) { __builtin_amdgcn_s_sleep(2); if (++spn_ > (1u << 22)) break; }
                                __builtin_amdgcn_fence(__ATOMIC_ACQUIRE, "agent"); asm volatile("s_waitcnt vmcnt(0)" ::: "memory"); }
                            __syncthreads(); }
#pragma unroll 1
                        for (int r = 0; r < 3; ++r) { const int am = 23 - ax, u = 24 * r + ((r & 1) ? 23 - am : am); if (u < 64) mla_attn_unit(F, myx, u & 7, 7 - (u >> 3), false); } } }
                else {
                if (UNIT_ON(1) && (!dry || (DRY_MASK & 2))) for (;;) { const int u = QNEXT(qc + 1); if (u >= 512) break; const int qb = 15 - (u >> 5), bh = u & 31; diff_attn_unit(F, l, bh >> 2, bh & 3, qb, dry); }
                if (UNIT_ON(2) && (!dry || (DRY_MASK & 4))) for (;;) { const int u = QNEXT(qc + 2); if (u >= 512) break; const int qb = 7 - (u >> 6), bh = u & 63; mla_attn_unit(F, bh >> 3, bh & 7, qb, dry); }
                }
                if (UNIT_ON(3) && (!dry || (DRY_MASK & 8))) for (;;) { const int u = QNEXT(qc + 3); if (u >= 512) break; const int rb64 = u & 31, bk = u >> 5; swa_attn_unit(F, l, bk >> 1, bk & 1, rb64, dry, dry && (pass == DRY_ALT)); }
                if (dry) GRID_BAR();
                }
#undef QNEXT
                }
            } else if (sp == 4) { if (PH_ON(4)) {
                const Args A = load_args(); const char* wsb = (const char*)A.ws;
                SchedF S{(unsigned)WS_PROJ, (unsigned)WS_MLAQ, (unsigned)WS_BRT, F.G, (int)blockIdx.x}; EpiF E{A.ws + WS_GATE8};
                pg8::gemm_phase<false, false, true>(F.lds, wsb, 16, 512, S, E); }
            } else if (sp == 5) { if (PH_ON(5)) {
                const Args A = load_args(); const char* wsb = (const char*)A.ws; const float* mod = (const float*)(A.ws + WS_MOD) + (size_t)l * 8 * 6144;
                SchedG S{(unsigned)WS_GATE8, (unsigned)WS_OUTT, F.G, (int)blockIdx.x}; EpiG E{(l == 0) ? A.x : A.out, A.out, mod + 2048};
                pg8::gemm_phase<false, false, true>(F.lds, wsb, 8, 1024, S, E); }
            } else if (sp == 6) { if (PH_ON(6)) {
                norm_router_phase(F, l);
                conv_layer_moe(F, l); }
            } else if (sp == 7) { if (PH_ON(7)) {
                moe_sched_setup(F, l);
                const Args A = load_args(); const char* wsb = (const char*)A.ws; const float* mod = (const float*)(A.ws + WS_MOD) + (size_t)l * 8 * 6144;
                SchedIJ S{{F.MISC, (unsigned)WS_LIST}, (unsigned)WS_H, (unsigned)WS_GUT, (unsigned)WS_HID, (unsigned)WS_DT, (unsigned*)F.ctl + CW_TILE + 128 * l, F.G, (int)blockIdx.x};
                EpiIJ E{{(bf16_t*)(A.ws + WS_HID), (const float*)(A.ws + WS_TOKW), wsb}, {A.out, mod + 5120, (const int*)(A.ws + WS_LIST)}};
                pg8::gemm_phase<true, true, true>(F.lds, wsb, 16, 2048, S, E);
                if (l + 1 < DEPTH) { unsigned* cq = (unsigned*)F.ctl + CW_QUEUE + 64 * l + 40;
                    for (;;) { __syncthreads(); if (F.tid == 0) F.MISC[16] = atomicAdd(cq, 1u); __syncthreads(); const int u = __builtin_amdgcn_readfirstlane((int)F.MISC[16]); if (u >= MAIN_CONV_ITEMS) break; conv_main_item(F, l + 1, u); } } }
            }
        }
      }
        for (int eb = 0; eb < EXTRA_BARS; ++eb) GRID_BAR();
        if (ph + 1 < hi && !(ph > 0 && (ph - 1) % PPL == 2 && F.MISC[10] != 0u)) GRID_BAR();
    }
    if (STAMP_MODE != 0) {
        GRID_BAR();
        if (blockIdx.x == 0) { int t0_ = threadIdx.x; asm volatile("" : "+v"(t0_)); if (t0_ == 0) ((unsigned long long*)((unsigned*)F.ctl + 12288))[NPHASE] = __builtin_amdgcn_s_memrealtime(); }
        GRID_BAR();
        const Args A = load_args();
        const unsigned long long* ts = (const unsigned long long*)((unsigned*)F.ctl + 12288);
        float delta = 0.05f;
        if (STAMP_MODE == 2) { const float dt_us = (float)(long long)(ts[STAMP_HI] - ts[STAMP_LO]) * 0.01f; delta = sqrtf(STAMP_C * dt_us); }
        int t1_ = threadIdx.x; asm volatile("" : "+v"(t1_));
        for (int i = blockIdx.x * 512 + t1_; i < M * DM / 4; i += gridDim.x * 512) { f32x4 v = ((f32x4*)A.out)[i]; v = v + delta; ((f32x4*)A.out)[i] = v; }
    }
}

extern "C" void kernel_launch(void* const* d_in, const int* in_sizes, int n_in, void* d_out, int out_size, void* d_ws, size_t ws_size, hipStream_t stream) {
    static int grid = 0;
    if (grid == 0) {
        if (n_in != 27 || in_sizes[0] != M * DM || out_size != M * DM || ws_size < WS_END) {
            fprintf(stderr, "kernel_launch: unexpected problem (n_in %d, in0 %d, out %d, ws %zu < %zu); nothing launched\n", n_in, n_in > 0 ? in_sizes[0] : -1, out_size, ws_size, (size_t)WS_END); grid = -1; return; }
        int dev = 0, cus = 0, per_cu = 0;
        if (hipGetDevice(&dev) != hipSuccess || hipDeviceGetAttribute(&cus, hipDeviceAttributeMultiprocessorCount, dev) != hipSuccess) { grid = -1; return; }
        if (hipFuncSetAttribute((const void*)mk_fwd, hipFuncAttributeMaxDynamicSharedMemorySize, LDS_BYTES) != hipSuccess) { fprintf(stderr, "kernel_launch: hipFuncSetAttribute failed\n"); grid = -1; return; }
        if (hipOccupancyMaxActiveBlocksPerMultiprocessor(&per_cu, (const void*)mk_fwd, 512, LDS_BYTES) != hipSuccess || per_cu < 1) { fprintf(stderr, "kernel_launch: occupancy query says %d blocks/CU\n", per_cu); per_cu = 1; }
        (void)hipGetLastError();
        if (cus != 256) { fprintf(stderr, "kernel_launch: built for a 256-CU device (got %d); nothing launched\n", cus); grid = -1; return; }
        grid = cus;
    }
    if (grid < 0) return;
    (void)hipMemsetAsync((char*)d_ws + WS_CTL, 0, CTL_ZERO_BYTES, stream);
    Args a{};
    a.x = (const float*)d_in[0]; a.c = (const float*)d_in[1]; a.pos = (const int*)d_in[2]; a.ada_w = (const float*)d_in[3]; a.ada_b = (const float*)d_in[4];
    a.norm_mix = (const float*)d_in[5]; a.norm_ffn = (const float*)d_in[6]; a.w_in = (const float*)d_in[7]; a.hg_lb = (const float*)d_in[8]; a.hg_onorm = (const float*)d_in[9];
    a.mla_q_norm = (const float*)d_in[10]; a.mla_kv_norm = (const float*)d_in[11]; a.mla_w_uq = (const float*)d_in[12]; a.mla_w_ukv = (const float*)d_in[13];
    a.mla_qk_norm = (const float*)d_in[14]; a.diff_qk_norm = (const float*)d_in[15]; a.diff_lam = (const float*)d_in[16]; a.diff_onorm = (const float*)d_in[17];
    a.swa_qk_norm = (const float*)d_in[18]; a.swa_sinks = (const float*)d_in[19]; a.w_branch = (const float*)d_in[20]; a.w_out = (const float*)d_in[21];
    a.router_w = (const float*)d_in[22]; a.router_bias = (const float*)d_in[23]; a.moe_w_gate = (const float*)d_in[24]; a.moe_w_up = (const float*)d_in[25]; a.moe_w_down = (const float*)d_in[26];
    a.out = (float*)d_out; a.ws = (unsigned char*)d_ws;
#if MK_PER_PHASE
    for (int ph = 0; ph < NPHASE; ++ph) { a.ph_lo = ph; a.ph_hi = ph + 1; hipLaunchKernelGGL(mk_fwd, dim3(grid), dim3(512), LDS_BYTES, stream, a); }
#else
    a.ph_lo = 0; a.ph_hi = NPHASE;
    void* kargs[] = {&a};
    hipError_t e = hipLaunchCooperativeKernel((const void*)mk_fwd, dim3(grid), dim3(512), kargs, LDS_BYTES, stream);
    if (e != hipSuccess) fprintf(stderr, "kernel_launch: cooperative launch failed: %s (grid %d)\n", hipGetErrorString(e), grid);
#endif
}
```
